# Optimizing an MI355X kernel written in HIP

```python
import math
import jax, jax.numpy as jnp
from jax import lax
import numpy as np

D_MODEL = 1024
BATCH = 8
SEQ = 4096
DEPTH = 1

MIX_WIDTH = D_MODEL
DIFF_HEADS = 4
DIFF_V_DIM = MIX_WIDTH // 2 // DIFF_HEADS
DIFF_QK_DIM = DIFF_V_DIM // 2
RET_HEADS = 4
RET_V_DIM = MIX_WIDTH // 2 // RET_HEADS
RET_QK_DIM = RET_V_DIM // 2
Q_BLOCK = 128
RET_CHUNK = 128
ROPE_BASE = 10000.0
T5_BUCKETS = 32
T5_MAX_EXACT = 16
T5_MAX_DISTANCE = 128
PEER_HEADS = 8
PEER_N_KEYS = 128
PEER_N_EXPERTS = PEER_N_KEYS * PEER_N_KEYS
PEER_TOPK = 16
PEER_QUERY_DIM = 256
PEER_KEY_DIM = PEER_QUERY_DIM // 2
PEER_CHUNK = 128
PLE_DIM = 256

kernel_name = "hymba_diffattn_retnet_peer_block"

_SPLIT_SIZES = [
    2 * DIFF_HEADS * DIFF_QK_DIM,
    2 * DIFF_HEADS * DIFF_QK_DIM,
    DIFF_HEADS * DIFF_V_DIM,
    RET_HEADS * RET_QK_DIM,
    RET_HEADS * RET_QK_DIM,
    RET_HEADS * RET_V_DIM,
    RET_HEADS * RET_V_DIM,
]
IN_WIDTH = sum(_SPLIT_SIZES)


def rmsnorm(x, gain=None, eps=1e-6):
    xf = x.astype(jnp.float32)
    y = xf * lax.rsqrt(jnp.mean(xf * xf, axis=-1, keepdims=True) + eps)
    if gain is not None:
        y = y * gain.astype(jnp.float32)
    return y.astype(x.dtype)


def t5_bucket(n):
    exact = n < T5_MAX_EXACT
    nf = jnp.maximum(n, 1).astype(jnp.float32)
    large = T5_MAX_EXACT + (jnp.log(nf / T5_MAX_EXACT)
                            / math.log(T5_MAX_DISTANCE / T5_MAX_EXACT)
                            * (T5_BUCKETS - T5_MAX_EXACT)).astype(jnp.int32)
    large = jnp.minimum(large, T5_BUCKETS - 1)
    return jnp.where(exact, n, large)


def rotary(x, pos):
    half = x.shape[-1] // 2
    freqs = 1.0 / (ROPE_BASE ** (jnp.arange(half, dtype=jnp.float32) / half))
    ang = pos[:, None] * freqs[None, :]
    cos, sin = jnp.cos(ang), jnp.sin(ang)
    xf = x.astype(jnp.float32)
    x1, x2 = xf[..., :half], xf[..., half:]
    return jnp.concatenate([x1 * cos - x2 * sin, x1 * sin + x2 * cos], axis=-1).astype(x.dtype)


def diff_attention(q, k, v, lam, rel_bias):
    S = q.shape[3]
    scale = DIFF_QK_DIM ** -0.5
    outs = []
    for blk in range(S // Q_BLOCK):
        start = blk * Q_BLOCK
        end = start + Q_BLOCK
        qb = q[:, :, :, start:end]
        kb = k[:, :, :, :end]
        vb = v[:, :, :end]
        dist = (start + jnp.arange(Q_BLOCK, dtype=jnp.int32))[:, None] - jnp.arange(end, dtype=jnp.int32)[None, :]
        bias = jnp.transpose(rel_bias[t5_bucket(jnp.maximum(dist, 0))], (2, 0, 1)).astype(jnp.float32)
        logits = jnp.einsum('bmhqd,bmhkd->bmhqk', qb, kb).astype(jnp.float32) * scale + bias
        logits = jnp.where(dist >= 0, logits, -jnp.inf)
        probs = jax.nn.softmax(logits, axis=-1)
        attn = probs[:, 0] - lam * probs[:, 1]
        outs.append(jnp.einsum('bhqk,bhkd->bhqd', attn.astype(v.dtype), vb))
    return jnp.concatenate(outs, axis=2)


def retention(q, k, v, log_gamma):
    B, H, S, dk = q.shape
    dv = v.shape[-1]
    C = RET_CHUNK
    N = S // C
    qc = q.reshape(B, H, N, C, dk)
    kc = k.reshape(B, H, N, C, dk)
    vc = v.reshape(B, H, N, C, dv)
    i = jnp.arange(C, dtype=jnp.float32)
    rel = i[:, None] - i[None, :]
    decay = jnp.where(rel >= 0, jnp.exp(jnp.maximum(rel, 0.0)[None] * log_gamma[:, None, None]), 0.0)
    zeta = jnp.exp((C - 1 - i)[None, :] * log_gamma[:, None])
    xi = jnp.exp((i + 1)[None, :] * log_gamma[:, None])
    chunk_decay = jnp.exp(C * log_gamma)
    scores = jnp.einsum('bhnid,bhnjd->bhnij', qc, kc) * decay[None, :, None]
    inner = jnp.einsum('bhnij,bhnje->bhnie', scores, vc)
    kv = jnp.einsum('bhnjd,bhnje->nbhde', kc * zeta[None, :, None, :, None], vc)

    def step(state, kv_n):
        return chunk_decay[None, :, None, None] * state + kv_n, state

    _, state_prev = lax.scan(step, jnp.zeros(kv.shape[1:], kv.dtype), kv)
    cross = jnp.einsum('bhnid,nbhde->bhnie', qc * xi[None, :, None, :, None], state_prev)
    return (inner + cross).reshape(B, H, S, dv).astype(v.dtype)


def peer(m, w_query, sub_keys, u, v):
    B, S, D = m.shape
    qry = (m @ w_query).reshape(B, S, PEER_HEADS, 2, PEER_KEY_DIM)
    scores = jnp.einsum('bshcd,hckd->bshck', qry, sub_keys).astype(jnp.float32)
    vals, idx = lax.top_k(scores, PEER_TOPK)
    cand = vals[..., 0, :, None] + vals[..., 1, None, :]
    cand_idx = idx[..., 0, :, None] * PEER_N_KEYS + idx[..., 1, None, :]
    cand = cand.reshape(B, S, PEER_HEADS, PEER_TOPK * PEER_TOPK)
    cand_idx = cand_idx.reshape(B, S, PEER_HEADS, PEER_TOPK * PEER_TOPK)
    top_s, top_pos = lax.top_k(cand, PEER_TOPK)
    expert = jnp.take_along_axis(cand_idx, top_pos, axis=-1)
    gates = jax.nn.softmax(top_s, axis=-1)
    T = B * S
    n_sel = PEER_HEADS * PEER_TOPK
    tokens = m.reshape(T // PEER_CHUNK, PEER_CHUNK, D)
    expert = expert.reshape(T // PEER_CHUNK, PEER_CHUNK, n_sel)
    gates = gates.reshape(T // PEER_CHUNK, PEER_CHUNK, n_sel)

    def chunk(args):
        xt, e, g = args
        u_sel = jnp.take(u, e, axis=0)
        act = jax.nn.gelu(jnp.einsum('cd,ced->ce', xt, u_sel).astype(jnp.float32), approximate=False) * g
        v_sel = jnp.take(v, e, axis=0)
        return jnp.einsum('ce,ced->cd', act.astype(xt.dtype), v_sel)

    out = lax.map(chunk, (tokens, expert, gates))
    return out.reshape(B, S, D)


def setup_inputs(seed: int = 0) -> dict:
    key = jax.random.key(seed)
    ks = jax.random.split(key, 24)
    f32 = jnp.float32
    nrm = lambda k, shape, s: (jax.random.normal(k, shape, f32) * s)
    return {
        "x": nrm(ks[0], (BATCH, SEQ, D_MODEL), 1.0),
        "p": nrm(ks[1], (DEPTH, BATCH, SEQ, PLE_DIM), 1.0),
        "attn_norm": 1.0 + nrm(ks[2], (DEPTH, D_MODEL), 0.02),
        "w_in": nrm(ks[3], (DEPTH, D_MODEL, IN_WIDTH), D_MODEL ** -0.5),
        "lam_q1": nrm(ks[4], (DEPTH, DIFF_QK_DIM), 0.1),
        "lam_k1": nrm(ks[5], (DEPTH, DIFF_QK_DIM), 0.1),
        "lam_q2": nrm(ks[6], (DEPTH, DIFF_QK_DIM), 0.1),
        "lam_k2": nrm(ks[7], (DEPTH, DIFF_QK_DIM), 0.1),
        "subln_gain": 1.0 + nrm(ks[8], (DEPTH, DIFF_V_DIM), 0.02),
        "w_out": nrm(ks[9], (DEPTH, MIX_WIDTH, D_MODEL), MIX_WIDTH ** -0.5),
        "rel_bias": nrm(ks[10], (T5_BUCKETS, DIFF_HEADS), 0.2),
        "ffn_norm": 1.0 + nrm(ks[11], (DEPTH, D_MODEL), 0.02),
        "peer_query": nrm(ks[12], (DEPTH, D_MODEL, PEER_HEADS * PEER_QUERY_DIM), D_MODEL ** -0.5),
        "peer_subkeys": nrm(ks[13], (DEPTH, PEER_HEADS, 2, PEER_N_KEYS, PEER_KEY_DIM), PEER_KEY_DIM ** -0.5),
        "peer_u": nrm(ks[14], (DEPTH, PEER_N_EXPERTS, D_MODEL), D_MODEL ** -0.5),
        "peer_v": nrm(ks[15], (DEPTH, PEER_N_EXPERTS, D_MODEL), (PEER_HEADS * PEER_TOPK) ** -0.5),
        "ple_norm": 1.0 + nrm(ks[16], (DEPTH, D_MODEL), 0.02),
        "ple_gate_w": nrm(ks[17], (DEPTH, D_MODEL, D_MODEL), D_MODEL ** -0.5),
        "ple_gate_b": nrm(ks[18], (DEPTH, D_MODEL), 0.01),
        "ple_proj": nrm(ks[19], (DEPTH, PLE_DIM, D_MODEL), PLE_DIM ** -0.5),
        "final_norm": 1.0 + nrm(ks[20], (D_MODEL,), 0.02),
    }


def reference(x, p, attn_norm, w_in, lam_q1, lam_k1, lam_q2, lam_k2, subln_gain, w_out,
              rel_bias, ffn_norm, peer_query, peer_subkeys, peer_u, peer_v,
              ple_norm, ple_gate_w, ple_gate_b, ple_proj, final_norm):
    B, S, D = x.shape
    pos = jnp.arange(S, dtype=jnp.float32)
    gamma = 1.0 - jnp.exp2(-5.0 - jnp.arange(RET_HEADS, dtype=jnp.float32))
    log_gamma = jnp.log(gamma)
    split_at = [int(s) for s in np.cumsum(_SPLIT_SIZES)[:-1]]
    h = x
    for layer in range(DEPTH):
        a = rmsnorm(h, attn_norm[layer])
        proj = a @ w_in[layer]
        dq, dk, dv, rq, rk, rv, rg = jnp.split(proj, split_at, axis=-1)

        dq = dq.reshape(B, S, 2, DIFF_HEADS, DIFF_QK_DIM).transpose(0, 2, 3, 1, 4)
        dk = dk.reshape(B, S, 2, DIFF_HEADS, DIFF_QK_DIM).transpose(0, 2, 3, 1, 4)
        dv = dv.reshape(B, S, DIFF_HEADS, DIFF_V_DIM).transpose(0, 2, 1, 3)
        lambda_init = 0.8 - 0.6 * math.exp(-0.3 * layer)
        lam = (jnp.exp(jnp.sum(lam_q1[layer].astype(jnp.float32) * lam_k1[layer].astype(jnp.float32)))
               - jnp.exp(jnp.sum(lam_q2[layer].astype(jnp.float32) * lam_k2[layer].astype(jnp.float32)))
               + lambda_init)
        o = diff_attention(dq, dk, dv, lam, rel_bias)
        o = rmsnorm(o, subln_gain[layer], eps=1e-5) * (1.0 - lambda_init)
        diff_out = o.transpose(0, 2, 1, 3).reshape(B, S, DIFF_HEADS * DIFF_V_DIM)

        rq = rotary(rq.reshape(B, S, RET_HEADS, RET_QK_DIM).transpose(0, 2, 1, 3), pos)
        rk = rotary(rk.reshape(B, S, RET_HEADS, RET_QK_DIM).transpose(0, 2, 1, 3), pos) * (RET_QK_DIM ** -0.5)
        rv = rv.reshape(B, S, RET_HEADS, RET_V_DIM).transpose(0, 2, 1, 3)
        r = rmsnorm(retention(rq, rk, rv, log_gamma))
        ret_out = r.transpose(0, 2, 1, 3).reshape(B, S, RET_HEADS * RET_V_DIM) * jax.nn.silu(rg)

        h = h + jnp.concatenate([diff_out, ret_out], axis=-1) @ w_out[layer]

        m = rmsnorm(h, ffn_norm[layer])
        h = h + peer(m, peer_query[layer], peer_subkeys[layer], peer_u[layer], peer_v[layer])

        n = rmsnorm(h, ple_norm[layer])
        gate = jax.nn.sigmoid(n @ ple_gate_w[layer] + ple_gate_b[layer])
        h = h + gate * (p[layer] @ ple_proj[layer])
    return rmsnorm(h, final_norm)
```

```cpp
#include <hip/hip_runtime.h>
#include <cstdint>
#include <cstdio>

typedef unsigned short bf16_t;
typedef unsigned int u32;

constexpr int BATCH = 8, SEQ = 4096, DM = 1024, M = BATCH * SEQ;
constexpr int INW = 3072;
constexpr int NEXP = 16384;
constexpr float LOG2E = 1.4426950408889634f;
constexpr float QSCALE = 0.125f * LOG2E;

constexpr size_t MiB = 1u << 20;
constexpr size_t WS_CTL = 0;
constexpr size_t WS_RSS = 1 * MiB;
constexpr size_t WS_CS = 2 * MiB;
constexpr size_t WS_WIN = 4 * MiB;
constexpr size_t WS_WOUT = 10 * MiB;
constexpr size_t WS_WQ = 12 * MiB;
constexpr size_t WS_WG = 16 * MiB;
constexpr size_t WS_WP = 18 * MiB;
constexpr size_t WS_SUBK = 18 * MiB + 512 * 1024;
constexpr size_t WS_U = 20 * MiB;
constexpr size_t WS_V = 52 * MiB;
constexpr size_t WS_XN = 84 * MiB;
constexpr size_t WS_PB = 148 * MiB;
constexpr size_t WS_BIG = 164 * MiB;
constexpr size_t WS_Q = WS_BIG, WS_K = WS_BIG + 32 * MiB, WS_VV = WS_BIG + 64 * MiB;
constexpr size_t WS_RQ = WS_BIG + 96 * MiB, WS_RK = WS_BIG + 112 * MiB, WS_RV = WS_BIG + 128 * MiB, WS_RG = WS_BIG + 160 * MiB;
constexpr size_t WS_QRY = WS_BIG;
constexpr size_t WS_IDX = WS_BIG + 128 * MiB;
constexpr size_t WS_GATE = WS_BIG + 144 * MiB;
constexpr size_t WS_MIX = 356 * MiB;

__device__ __forceinline__ float bf2f(bf16_t v) { return __uint_as_float(((u32)v) << 16); }
__device__ __forceinline__ bf16_t f2bf(float f) { u32 u = __float_as_uint(f); return (bf16_t)((u + 0x7fffu + ((u >> 16) & 1u)) >> 16); }

__device__ __forceinline__ float wave_sum(float v) {
#pragma unroll
    for (int o = 1; o < 64; o <<= 1) v += __shfl_xor(v, o);
    return v;
}
__device__ __forceinline__ float wave_max(float v) {
#pragma unroll
    for (int o = 1; o < 64; o <<= 1) v = fmaxf(v, __shfl_xor(v, o));
    return v;
}

__global__ void __launch_bounds__(256) k_transpose_w(const float* __restrict__ W, int K, int N, bf16_t* __restrict__ WT, const float* __restrict__ gain) {
    __shared__ float t[32][33];
    const int k0 = blockIdx.y * 32, n0 = blockIdx.x * 32, tx = threadIdx.x & 31, ty = threadIdx.x >> 5;
    for (int i = ty; i < 32; i += 8) { float g = gain ? gain[k0 + i] : 1.f; t[i][tx] = W[(size_t)(k0 + i) * N + n0 + tx] * g; }
    __syncthreads();
    for (int i = ty; i < 32; i += 8) WT[(size_t)(n0 + i) * K + k0 + tx] = f2bf(t[tx][i]);
}
__global__ void __launch_bounds__(256) k_convert(const float* __restrict__ in, bf16_t* __restrict__ out, size_t n4, const float* __restrict__ gain, int period) {
    for (size_t i = (size_t)blockIdx.x * 256 + threadIdx.x; i < n4; i += (size_t)gridDim.x * 256) {
        float4 v = ((const float4*)in)[i];
        if (gain) { const int c = (int)((i * 4) % period); v.x *= gain[c]; v.y *= gain[c + 1]; v.z *= gain[c + 2]; v.w *= gain[c + 3]; }
        ushort4 o; o.x = f2bf(v.x); o.y = f2bf(v.y); o.z = f2bf(v.z); o.w = f2bf(v.w);
        ((ushort4*)out)[i] = o;
    }
}
__global__ void __launch_bounds__(256) k_rmsnorm_bf16(const float* __restrict__ x, const float* __restrict__ gain, bf16_t* __restrict__ out, float eps) {
    const int row = blockIdx.x * 4 + (threadIdx.x >> 6), lane = threadIdx.x & 63;
    const float4* xr = (const float4*)(x + (size_t)row * DM);
    float4 v[4]; float s = 0.f;
#pragma unroll
    for (int j = 0; j < 4; ++j) { v[j] = xr[lane + 64 * j]; s += v[j].x * v[j].x + v[j].y * v[j].y + v[j].z * v[j].z + v[j].w * v[j].w; }
    s = wave_sum(s);
    const float r = rsqrtf(s * (1.f / DM) + eps);
#pragma unroll
    for (int j = 0; j < 4; ++j) {
        const float4 g = ((const float4*)gain)[lane + 64 * j];
        ushort4 o; o.x = f2bf(v[j].x * r * g.x); o.y = f2bf(v[j].y * r * g.y); o.z = f2bf(v[j].z * r * g.z); o.w = f2bf(v[j].w * r * g.w);
        ((ushort4*)(out + (size_t)row * DM))[lane + 64 * j] = o;
    }
}
__device__ __forceinline__ void sincos_acc(float ang, float& s, float& c) {
    const double x = (double)ang;
    const double k = rint(x * 0.63661977236758134308);
    double r = fma(-k, 1.57079632679489655800, x); r = fma(-k, 6.12323399573676603587e-17, r);
    const double r2 = r * r;
    double sp = r * (1.0 + r2 * (-1.0 / 6 + r2 * (1.0 / 120 + r2 * (-1.0 / 5040 + r2 * (1.0 / 362880 + r2 * (-1.0 / 39916800 + r2 * (1.0 / 6227020800.0)))))));
    double cp = 1.0 + r2 * (-0.5 + r2 * (1.0 / 24 + r2 * (-1.0 / 720 + r2 * (1.0 / 40320 + r2 * (-1.0 / 3628800 + r2 * (1.0 / 479001600.0 + r2 * (-1.0 / 87178291200.0)))))));
    const int q = ((int)(long long)k) & 3;
    double ss, cc;
    if (q == 0) { ss = sp; cc = cp; } else if (q == 1) { ss = cp; cc = -sp; } else if (q == 2) { ss = -sp; cc = -cp; } else { ss = -cp; cc = sp; }
    s = (float)ss; c = (float)cc;
}
__global__ void __launch_bounds__(256) k_tables(const float* lq1, const float* lk1, const float* lq2, const float* lk2, const float* __restrict__ rel_bias,
                                                float* __restrict__ ctl, float* __restrict__ cs) {
    const int gid = blockIdx.x * 256 + threadIdx.x;
    if (gid == 0) {
        float a = 0.f, b = 0.f;
        for (int i = 0; i < 64; ++i) { a += lq1[i] * lk1[i]; b += lq2[i] * lk2[i]; }
        ctl[0] = expf(a) - expf(b) + 0.2f;
    }
    if (gid < 512) {
        const int h = gid >> 7, n = gid & 127;
        int bucket;
        if (n < 16) bucket = n;
        else { const float nf = (float)n; int lg = 16 + (int)(logf(nf / 16.0f) / 2.0794415416798357f * 16.0f); bucket = lg < 31 ? lg : 31; }
        ctl[64 + h * 128 + n] = rel_bias[bucket * 4 + h] * LOG2E;
    }
    if (gid < 4096 * 32) {
        const int pos = gid >> 5, i = gid & 31;
        const float freq = 1.0f / powf(10000.0f, (float)i / 32.0f);
        const float ang = (float)pos * freq;
        float s, c; sincos_acc(ang, s, c);
        cs[gid] = c; cs[4096 * 32 + gid] = s;
    }
}

template <class Epi>
__global__ void __launch_bounds__(256) k_gemm(const bf16_t* __restrict__ A, const bf16_t* __restrict__ Bt, int K, Epi epi) {
    __shared__ float As[16][132];
    __shared__ float Bs[16][132];
    const int tid = threadIdx.x, tx = tid & 15, ty = tid >> 4;
    const int row0 = blockIdx.y * 128, col0 = blockIdx.x * 128;
    const int lr = tid >> 1, lk = (tid & 1) * 8;
    const bf16_t* ap = A + (size_t)(row0 + lr) * K + lk;
    const bf16_t* bp = Bt + (size_t)(col0 + lr) * K + lk;
    float acc[8][8];
#pragma unroll
    for (int i = 0; i < 8; ++i)
#pragma unroll
        for (int j = 0; j < 8; ++j) acc[i][j] = 0.f;
    for (int k0 = 0; k0 < K; k0 += 16) {
        const uint4 av = *(const uint4*)(ap + k0), bv = *(const uint4*)(bp + k0);
        __syncthreads();
        const u32 aw[4] = {av.x, av.y, av.z, av.w}, bw[4] = {bv.x, bv.y, bv.z, bv.w};
#pragma unroll
        for (int j = 0; j < 4; ++j) {
            As[lk + 2 * j][lr] = __uint_as_float(aw[j] << 16); As[lk + 2 * j + 1][lr] = __uint_as_float(aw[j] & 0xffff0000u);
            Bs[lk + 2 * j][lr] = __uint_as_float(bw[j] << 16); Bs[lk + 2 * j + 1][lr] = __uint_as_float(bw[j] & 0xffff0000u);
        }
        __syncthreads();
#pragma unroll
        for (int k = 0; k < 16; ++k) {
            float a[8], b[8];
            const float4 a0 = *(const float4*)&As[k][ty * 8], a1 = *(const float4*)&As[k][ty * 8 + 4];
            const float4 b0 = *(const float4*)&Bs[k][tx * 8], b1 = *(const float4*)&Bs[k][tx * 8 + 4];
            a[0] = a0.x; a[1] = a0.y; a[2] = a0.z; a[3] = a0.w; a[4] = a1.x; a[5] = a1.y; a[6] = a1.z; a[7] = a1.w;
            b[0] = b0.x; b[1] = b0.y; b[2] = b0.z; b[3] = b0.w; b[4] = b1.x; b[5] = b1.y; b[6] = b1.z; b[7] = b1.w;
#pragma unroll
            for (int i = 0; i < 8; ++i)
#pragma unroll
                for (int j = 0; j < 8; ++j) acc[i][j] = fmaf(a[i], b[j], acc[i][j]);
        }
    }
#pragma unroll
    for (int i = 0; i < 8; ++i) epi.row8(row0 + ty * 8 + i, col0 + tx * 8, acc[i]);
}

struct EpiInProj {
    bf16_t *Q, *Kb, *V, *RQ, *RK, *RV, *RG; const float* cs;
    __device__ __forceinline__ void row8(int row, int col, const float* v) const {
        bf16_t* dst; float sc = 1.f; int c = col; bool silu = false;
        if (col < 512) { dst = Q + (size_t)row * 512; sc = QSCALE; }
        else if (col < 1024) { dst = Kb + (size_t)row * 512; c = col - 512; }
        else if (col < 1536) { dst = V + (size_t)row * 512; c = col - 1024; }
        else if (col < 1792) { dst = RQ + (size_t)row * 256; c = col - 1536; }
        else if (col < 2048) { dst = RK + (size_t)row * 256; c = col - 1792; }
        else if (col < 2560) { dst = RV + (size_t)row * 512; c = col - 2048; }
        else { dst = RG + (size_t)row * 512; c = col - 2560; silu = true; }
        const bool rot = (col >= 1536 && col < 2048);
        if (rot) {
            float* raw = rawrot + (size_t)row * 512 + (col - 1536);
#pragma unroll
            for (int j = 0; j < 8; ++j) raw[j] = v[j];
            return;
        }
        ushort4 o0, o1; float w[8];
#pragma unroll
        for (int j = 0; j < 8; ++j) { float x = v[j] * sc; if (silu) x = x / (1.f + __expf(-x)); w[j] = x; }
        o0.x = f2bf(w[0]); o0.y = f2bf(w[1]); o0.z = f2bf(w[2]); o0.w = f2bf(w[3]); o1.x = f2bf(w[4]); o1.y = f2bf(w[5]); o1.z = f2bf(w[6]); o1.w = f2bf(w[7]);
        *(ushort4*)(dst + c) = o0; *(ushort4*)(dst + c + 4) = o1;
    }
    float* rawrot;
};
__global__ void __launch_bounds__(256) k_rotary(const float* __restrict__ raw, const float* __restrict__ cs, bf16_t* __restrict__ RQ, bf16_t* __restrict__ RK) {
    const size_t gid = (size_t)blockIdx.x * 256 + threadIdx.x;
    const int row = (int)(gid >> 9), c = (int)(gid & 511);
    const int which = c >> 8, cc = c & 255, d = cc & 63, i = d & 31, pos = row & (SEQ - 1);
    const float co = cs[pos * 32 + i], si = cs[4096 * 32 + pos * 32 + i];
    const float* r = raw + (size_t)row * 512 + which * 256 + (cc & ~63);
    const float x1 = r[i], x2 = r[i + 32];
    float o = (d < 32) ? (x1 * co - x2 * si) : (x1 * si + x2 * co);
    if (which) { o *= 0.125f; RK[(size_t)row * 256 + cc] = f2bf(o); } else RQ[(size_t)row * 256 + cc] = f2bf(o);
}

__global__ void __launch_bounds__(256) k_mix_naive(const bf16_t* __restrict__ Q, const bf16_t* __restrict__ Kb, const bf16_t* __restrict__ V,
                                                   const bf16_t* __restrict__ RQ, const bf16_t* __restrict__ RK, const bf16_t* __restrict__ RV, const bf16_t* __restrict__ RG,
                                                   const float* __restrict__ ctl, const float* __restrict__ subln, bf16_t* __restrict__ MIX, int mode) {
    __shared__ float q1[64], q2[64];
    __shared__ float w[SEQ];
    __shared__ float w2[SEQ];
    __shared__ float red[8];
    __shared__ float part[128];
    const int tid = threadIdx.x, lane = tid & 63, wid = tid >> 6;
    const int h = blockIdx.x & 3, row = blockIdx.x >> 2, t = row & (SEQ - 1), rb = row - t;
    if (mode == 0) { if (tid < 64) { q1[tid] = bf2f(Q[(size_t)row * 512 + h * 64 + tid]); q2[tid] = bf2f(Q[(size_t)row * 512 + 256 + h * 64 + tid]); } }
    else { if (tid < 64) q1[tid] = bf2f(RQ[(size_t)row * 256 + h * 64 + tid]); }
    __syncthreads();
    float m1 = -INFINITY, m2 = -INFINITY;
    const float lg = (mode == 1) ? log2f(1.0f - exp2f(-5.0f - (float)h)) : 0.f;
    for (int j = tid; j <= t; j += 256) {
        if (mode == 0) {
            const bf16_t* k1 = Kb + (size_t)(rb + j) * 512 + h * 64; const bf16_t* k2 = k1 + 256;
            float s1 = 0.f, s2 = 0.f;
            for (int d = 0; d < 64; d += 8) {
                const uint4 a = *(const uint4*)(k1 + d), b2 = *(const uint4*)(k2 + d);
                const u32 aw[4] = {a.x, a.y, a.z, a.w}, bw[4] = {b2.x, b2.y, b2.z, b2.w};
#pragma unroll
                for (int e = 0; e < 4; ++e) {
                    s1 += q1[d + 2 * e] * __uint_as_float(aw[e] << 16) + q1[d + 2 * e + 1] * __uint_as_float(aw[e] & 0xffff0000u);
                    s2 += q2[d + 2 * e] * __uint_as_float(bw[e] << 16) + q2[d + 2 * e + 1] * __uint_as_float(bw[e] & 0xffff0000u);
                }
            }
            int dist = t - j; if (dist > 127) dist = 127;
            const float b = ctl[64 + h * 128 + dist];
            s1 += b; s2 += b; w[j] = s1; w2[j] = s2; m1 = fmaxf(m1, s1); m2 = fmaxf(m2, s2);
        } else {
            const bf16_t* k1 = RK + (size_t)(rb + j) * 256 + h * 64;
            float s1 = 0.f;
            for (int d = 0; d < 64; d += 8) {
                const uint4 a = *(const uint4*)(k1 + d);
                const u32 aw[4] = {a.x, a.y, a.z, a.w};
#pragma unroll
                for (int e = 0; e < 4; ++e) s1 += q1[d + 2 * e] * __uint_as_float(aw[e] << 16) + q1[d + 2 * e + 1] * __uint_as_float(aw[e] & 0xffff0000u);
            }
            w[j] = s1 * exp2f((float)(t - j) * lg);
        }
    }
    if (mode == 0) {
        m1 = wave_max(m1); m2 = wave_max(m2);
        if (lane == 0) { red[wid] = m1; red[4 + wid] = m2; }
        __syncthreads();
        m1 = fmaxf(fmaxf(red[0], red[1]), fmaxf(red[2], red[3])); m2 = fmaxf(fmaxf(red[4], red[5]), fmaxf(red[6], red[7]));
        __syncthreads();
        float l1 = 0.f, l2 = 0.f;
        for (int j = tid; j <= t; j += 256) { const float e1 = exp2f(w[j] - m1), e2 = exp2f(w2[j] - m2); w[j] = e1; w2[j] = e2; l1 += e1; l2 += e2; }
        l1 = wave_sum(l1); l2 = wave_sum(l2);
        if (lane == 0) { red[wid] = l1; red[4 + wid] = l2; }
        __syncthreads();
        l1 = red[0] + red[1] + red[2] + red[3]; l2 = red[4] + red[5] + red[6] + red[7];
        const float lam = ctl[0];
        const float i1 = 1.f / l1, i2 = lam / l2;
        for (int j = tid; j <= t; j += 256) w[j] = w[j] * i1 - w2[j] * i2;
    }
    __syncthreads();
    const bf16_t* vs = (mode == 0 ? V : RV) + (size_t)rb * 512 + h * 128 + (tid & 127);
    float acc = 0.f;
    for (int j = (tid >> 7); j <= t; j += 2) acc += w[j] * bf2f(vs[(size_t)j * 512]);
    if (tid >= 128) part[tid - 128] = acc;
    __syncthreads();
    float o = 0.f, ss = 0.f;
    if (tid < 128) { o = acc + part[tid]; ss = o * o; }
    ss = wave_sum(ss);
    if (lane == 0) red[wid] = ss;
    __syncthreads();
    if (tid < 128) {
        const float tot = red[0] + red[1];
        float r;
        if (mode == 0) { r = o * rsqrtf(tot * (1.f / 128) + 1e-5f) * subln[tid] * 0.8f; MIX[(size_t)row * DM + h * 128 + tid] = f2bf(r); }
        else { r = o * rsqrtf(tot * (1.f / 128) + 1e-6f) * bf2f(RG[(size_t)row * 512 + h * 128 + tid]); MIX[(size_t)row * DM + 512 + h * 128 + tid] = f2bf(r); }
    }
}

struct EpiOutProj {
    const float* x; float* H; bf16_t* HB; float* rss;
    __device__ __forceinline__ void row8(int row, int col, const float* v) const {
        const float4 x0 = *(const float4*)(x + (size_t)row * DM + col), x1 = *(const float4*)(x + (size_t)row * DM + col + 4);
        float hh[8] = {x0.x + v[0], x0.y + v[1], x0.z + v[2], x0.w + v[3], x1.x + v[4], x1.y + v[5], x1.z + v[6], x1.w + v[7]};
        *(float4*)(H + (size_t)row * DM + col) = make_float4(hh[0], hh[1], hh[2], hh[3]);
        *(float4*)(H + (size_t)row * DM + col + 4) = make_float4(hh[4], hh[5], hh[6], hh[7]);
        ushort4 o0, o1; o0.x = f2bf(hh[0]); o0.y = f2bf(hh[1]); o0.z = f2bf(hh[2]); o0.w = f2bf(hh[3]); o1.x = f2bf(hh[4]); o1.y = f2bf(hh[5]); o1.z = f2bf(hh[6]); o1.w = f2bf(hh[7]);
        *(ushort4*)(HB + (size_t)row * DM + col) = o0; *(ushort4*)(HB + (size_t)row * DM + col + 4) = o1;
        float s = 0.f;
#pragma unroll
        for (int j = 0; j < 8; ++j) s += hh[j] * hh[j];
        atomicAdd(rss + row, s);
    }
};
struct EpiQry {
    bf16_t* QRY; const float* rss;
    __device__ __forceinline__ void row8(int row, int col, const float* v) const {
        const float r = rsqrtf(rss[row] * (1.f / DM) + 1e-6f);
        ushort4 o0, o1; o0.x = f2bf(v[0] * r); o0.y = f2bf(v[1] * r); o0.z = f2bf(v[2] * r); o0.w = f2bf(v[3] * r); o1.x = f2bf(v[4] * r); o1.y = f2bf(v[5] * r); o1.z = f2bf(v[6] * r); o1.w = f2bf(v[7] * r);
        *(ushort4*)(QRY + (size_t)row * 2048 + col) = o0; *(ushort4*)(QRY + (size_t)row * 2048 + col + 4) = o1;
    }
};
struct EpiPP {
    bf16_t* PP;
    __device__ __forceinline__ void row8(int row, int col, const float* v) const {
        ushort4 o0, o1; o0.x = f2bf(v[0]); o0.y = f2bf(v[1]); o0.z = f2bf(v[2]); o0.w = f2bf(v[3]); o1.x = f2bf(v[4]); o1.y = f2bf(v[5]); o1.z = f2bf(v[6]); o1.w = f2bf(v[7]);
        *(ushort4*)(PP + (size_t)row * DM + col) = o0; *(ushort4*)(PP + (size_t)row * DM + col + 4) = o1;
    }
};
struct EpiGate {
    float* H; const bf16_t* PP; const float* bg; const float* rss2; float* rss3;
    __device__ __forceinline__ void row8(int row, int col, const float* v) const {
        const float r = rsqrtf(rss2[row] * (1.f / DM) + 1e-6f);
        float* hp = H + (size_t)row * DM + col; const bf16_t* pp = PP + (size_t)row * DM + col;
        float s = 0.f;
#pragma unroll
        for (int j = 0; j < 8; ++j) { const float g = 1.f / (1.f + __expf(-(v[j] * r + bg[col + j]))); const float h3 = hp[j] + g * bf2f(pp[j]); hp[j] = h3; s += h3 * h3; }
        atomicAdd(rss3 + row, s);
    }
};

__global__ void __launch_bounds__(256) k_peer_topk(const bf16_t* __restrict__ QRY, const bf16_t* __restrict__ SUBK, int* __restrict__ IDX, float* __restrict__ GATE) {
    __shared__ float q[2048];
    __shared__ float sc[2048];
    __shared__ float tv[16][16];
    __shared__ int ti[16][16];
    const int tid = threadIdx.x, tok = blockIdx.x;
    for (int i = tid; i < 2048; i += 256) q[i] = bf2f(QRY[(size_t)tok * 2048 + i]);
    __syncthreads();
    for (int s = tid; s < 2048; s += 256) {
        const int hc = s >> 7;
        const bf16_t* kr = SUBK + (size_t)s * 128; const float* qq = q + hc * 128;
        float a = 0.f;
        for (int d = 0; d < 128; ++d) a += qq[d] * bf2f(kr[d]);
        sc[s] = a;
    }
    __syncthreads();
    if (tid < 16) {
        float* s = sc + tid * 128;
        for (int r = 0; r < 16; ++r) {
            float best = -INFINITY; int bi = 0;
            for (int k = 0; k < 128; ++k) { const float x = s[k]; if (x > best) { best = x; bi = k; } }
            tv[tid][r] = best; ti[tid][r] = bi; s[bi] = -INFINITY;
        }
    }
    __syncthreads();
    if (tid < 8) {
        const int h = tid;
        unsigned used[8] = {0, 0, 0, 0, 0, 0, 0, 0};
        float ts[16]; int te[16];
        for (int r = 0; r < 16; ++r) {
            float best = -INFINITY; int bc = 0;
            for (int c = 0; c < 256; ++c) {
                if (used[c >> 5] & (1u << (c & 31))) continue;
                const float x = tv[2 * h][c >> 4] + tv[2 * h + 1][c & 15];
                if (x > best) { best = x; bc = c; }
            }
            used[bc >> 5] |= 1u << (bc & 31);
            ts[r] = best; te[r] = ti[2 * h][bc >> 4] * 128 + ti[2 * h + 1][bc & 15];
        }
        float mx = ts[0], sum = 0.f;
        for (int r = 0; r < 16; ++r) { ts[r] = __expf(ts[r] - mx); sum += ts[r]; }
        for (int r = 0; r < 16; ++r) { IDX[(size_t)tok * 128 + h * 16 + r] = te[r]; GATE[(size_t)tok * 128 + h * 16 + r] = ts[r] / sum; }
    }
}
__global__ void __launch_bounds__(256) k_peer_gather(const bf16_t* __restrict__ U, const bf16_t* __restrict__ Vt, const int* __restrict__ IDX, const float* __restrict__ GATE,
                                                     float* __restrict__ H, bf16_t* __restrict__ HB, const float* __restrict__ rss1, float* __restrict__ rss2) {
    __shared__ float hrow[1024];
    __shared__ float a[128];
    __shared__ int ex[128];
    __shared__ float red[4];
    const int tid = threadIdx.x, lane = tid & 63, wid = tid >> 6, tok = blockIdx.x;
    for (int i = tid; i < 1024; i += 256) hrow[i] = bf2f(HB[(size_t)tok * DM + i]);
    if (tid < 128) ex[tid] = IDX[(size_t)tok * 128 + tid];
    __syncthreads();
    const float r1 = rsqrtf(rss1[tok] * (1.f / DM) + 1e-6f);
    for (int e = wid * 32; e < wid * 32 + 32; ++e) {
        const bf16_t* ur = U + (size_t)ex[e] * DM + lane * 16;
        float d = 0.f;
#pragma unroll
        for (int j = 0; j < 16; ++j) d += bf2f(ur[j]) * hrow[lane * 16 + j];
        d = wave_sum(d);
        if (lane == 0) { const float z = d * r1; a[e] = 0.5f * z * (1.f + erff(z * 0.70710678118654752f)) * GATE[(size_t)tok * 128 + e]; }
    }
    __syncthreads();
    float acc[4] = {0.f, 0.f, 0.f, 0.f};
    for (int e = 0; e < 128; ++e) {
        const ushort4 v = *(const ushort4*)(Vt + (size_t)ex[e] * DM + tid * 4);
        const float ae = a[e];
        acc[0] += ae * bf2f(v.x); acc[1] += ae * bf2f(v.y); acc[2] += ae * bf2f(v.z); acc[3] += ae * bf2f(v.w);
    }
    float4 hv = *(float4*)(H + (size_t)tok * DM + tid * 4);
    hv.x += acc[0]; hv.y += acc[1]; hv.z += acc[2]; hv.w += acc[3];
    *(float4*)(H + (size_t)tok * DM + tid * 4) = hv;
    ushort4 o; o.x = f2bf(hv.x); o.y = f2bf(hv.y); o.z = f2bf(hv.z); o.w = f2bf(hv.w);
    __syncthreads();
    *(ushort4*)(HB + (size_t)tok * DM + tid * 4) = o;
    float s = hv.x * hv.x + hv.y * hv.y + hv.z * hv.z + hv.w * hv.w;
    s = wave_sum(s);
    if (lane == 0) red[wid] = s;
    __syncthreads();
    if (tid == 0) rss2[tok] = red[0] + red[1] + red[2] + red[3];
}
__global__ void __launch_bounds__(256) k_final(float* __restrict__ H, const float* __restrict__ rss3, const float* __restrict__ gain) {
    const size_t i = (size_t)blockIdx.x * 256 + threadIdx.x;
    const int row = (int)(i >> 8), c = (int)(i & 255) * 4;
    const float r = rsqrtf(rss3[row] * (1.f / DM) + 1e-6f);
    float4 v = ((float4*)H)[i]; const float4 g = *(const float4*)(gain + c);
    v.x *= r * g.x; v.y *= r * g.y; v.z *= r * g.z; v.w *= r * g.w;
    ((float4*)H)[i] = v;
}

extern "C" void kernel_launch(void* const* d_in, const int* in_sizes, int n_in, void* d_out, int out_size, void* d_ws, size_t ws_size, hipStream_t stream) {
    const float* x = (const float*)d_in[0]; const float* p = (const float*)d_in[1]; const float* attn_norm = (const float*)d_in[2]; const float* w_in = (const float*)d_in[3];
    const float* lq1 = (const float*)d_in[4]; const float* lk1 = (const float*)d_in[5]; const float* lq2 = (const float*)d_in[6]; const float* lk2 = (const float*)d_in[7];
    const float* subln = (const float*)d_in[8]; const float* w_out = (const float*)d_in[9]; const float* rel_bias = (const float*)d_in[10]; const float* ffn_norm = (const float*)d_in[11];
    const float* peer_query = (const float*)d_in[12]; const float* peer_subkeys = (const float*)d_in[13]; const float* peer_u = (const float*)d_in[14]; const float* peer_v = (const float*)d_in[15];
    const float* ple_norm = (const float*)d_in[16]; const float* ple_gate_w = (const float*)d_in[17]; const float* ple_gate_b = (const float*)d_in[18]; const float* ple_proj = (const float*)d_in[19];
    const float* final_norm = (const float*)d_in[20];
    unsigned char* ws = (unsigned char*)d_ws;
    float* H = (float*)d_out;
    float* ctl = (float*)(ws + WS_CTL); float* rss = (float*)(ws + WS_RSS); float* cs = (float*)(ws + WS_CS);
    float* rss1 = rss, *rss2 = rss + 32768, *rss3 = rss + 65536;
    bf16_t* WIN = (bf16_t*)(ws + WS_WIN); bf16_t* WOUT = (bf16_t*)(ws + WS_WOUT); bf16_t* WQ = (bf16_t*)(ws + WS_WQ); bf16_t* WG = (bf16_t*)(ws + WS_WG); bf16_t* WP = (bf16_t*)(ws + WS_WP);
    bf16_t* SUBK = (bf16_t*)(ws + WS_SUBK); bf16_t* U = (bf16_t*)(ws + WS_U); bf16_t* Vt = (bf16_t*)(ws + WS_V);
    bf16_t* XN = (bf16_t*)(ws + WS_XN); bf16_t* HB = XN; bf16_t* PB = (bf16_t*)(ws + WS_PB);
    bf16_t* Q = (bf16_t*)(ws + WS_Q); bf16_t* Kb = (bf16_t*)(ws + WS_K); bf16_t* VV = (bf16_t*)(ws + WS_VV);
    bf16_t* RQ = (bf16_t*)(ws + WS_RQ); bf16_t* RK = (bf16_t*)(ws + WS_RK); bf16_t* RV = (bf16_t*)(ws + WS_RV); bf16_t* RG = (bf16_t*)(ws + WS_RG);
    bf16_t* QRY = (bf16_t*)(ws + WS_QRY); int* IDX = (int*)(ws + WS_IDX); float* GATE = (float*)(ws + WS_GATE);
    bf16_t* MIX = (bf16_t*)(ws + WS_MIX); bf16_t* PP = MIX;
    float* RAWROT = (float*)(ws + WS_MIX);

    hipMemsetAsync(ws + WS_RSS, 0, 3 * 32768 * 4, stream);
    k_tables<<<512, 256, 0, stream>>>(lq1, lk1, lq2, lk2, rel_bias, ctl, cs);
    k_transpose_w<<<dim3(INW / 32, DM / 32), 256, 0, stream>>>(w_in, DM, INW, WIN, nullptr);
    k_transpose_w<<<dim3(DM / 32, DM / 32), 256, 0, stream>>>(w_out, DM, DM, WOUT, nullptr);
    k_transpose_w<<<dim3(2048 / 32, DM / 32), 256, 0, stream>>>(peer_query, DM, 2048, WQ, ffn_norm);
    k_transpose_w<<<dim3(DM / 32, DM / 32), 256, 0, stream>>>(ple_gate_w, DM, DM, WG, ple_norm);
    k_transpose_w<<<dim3(DM / 32, 256 / 32), 256, 0, stream>>>(ple_proj, 256, DM, WP, nullptr);
    k_convert<<<1024, 256, 0, stream>>>(peer_subkeys, SUBK, (size_t)16 * 128 * 128 / 4, nullptr, 1024);
    k_convert<<<4096, 256, 0, stream>>>(peer_u, U, (size_t)NEXP * DM / 4, ffn_norm, DM);
    k_convert<<<4096, 256, 0, stream>>>(peer_v, Vt, (size_t)NEXP * DM / 4, nullptr, DM);
    k_convert<<<4096, 256, 0, stream>>>(p, PB, (size_t)M * 256 / 4, nullptr, 256);
    k_rmsnorm_bf16<<<M / 4, 256, 0, stream>>>(x, attn_norm, XN, 1e-6f);
    { EpiInProj e{Q, Kb, VV, RQ, RK, RV, RG, cs, RAWROT}; k_gemm<EpiInProj><<<dim3(INW / 128, M / 128), 256, 0, stream>>>(XN, WIN, DM, e); }
    k_rotary<<<(M * 512) / 256, 256, 0, stream>>>(RAWROT, cs, RQ, RK);
    k_mix_naive<<<M * 4, 256, 0, stream>>>(Q, Kb, VV, RQ, RK, RV, RG, ctl, subln, MIX, 0);
    k_mix_naive<<<M * 4, 256, 0, stream>>>(Q, Kb, VV, RQ, RK, RV, RG, ctl, subln, MIX, 1);
    { EpiOutProj e{x, H, HB, rss1}; k_gemm<EpiOutProj><<<dim3(DM / 128, M / 128), 256, 0, stream>>>(MIX, WOUT, DM, e); }
    { EpiQry e{QRY, rss1}; k_gemm<EpiQry><<<dim3(2048 / 128, M / 128), 256, 0, stream>>>(HB, WQ, DM, e); }
    k_peer_topk<<<M, 256, 0, stream>>>(QRY, SUBK, IDX, GATE);
    k_peer_gather<<<M, 256, 0, stream>>>(U, Vt, IDX, GATE, H, HB, rss1, rss2);
    { EpiPP e{PP}; k_gemm<EpiPP><<<dim3(DM / 128, M / 128), 256, 0, stream>>>(PB, WP, 256, e); }
    { EpiGate e{H, PP, ple_gate_b, rss2, rss3}; k_gemm<EpiGate><<<dim3(DM / 128, M / 128), 256, 0, stream>>>(HB, WG, DM, e); }
    k_final<<<(M * DM / 4) / 256, 256, 0, stream>>>(H, rss3, final_norm);
}
```

```cpp
#include <hip/hip_runtime.h>
#include <cstdint>
#include <cstdio>

typedef unsigned short bf16_t;
typedef unsigned int u32;
#define LAS __attribute__((address_space(3)))

constexpr int BATCH = 8, SEQ = 4096, DM = 1024, M = BATCH * SEQ;
constexpr int INW = 3072;
constexpr int NEXP = 16384;
constexpr float LOG2E = 1.4426950408889634f;
constexpr float QSCALE = 0.125f * LOG2E;

constexpr size_t MiB = 1u << 20;
constexpr size_t WS_CTL = 0;
constexpr size_t WS_RSS = 1 * MiB;
constexpr size_t WS_CS = 2 * MiB;
constexpr size_t WS_WIN = 4 * MiB;
constexpr size_t WS_WOUT = 10 * MiB;
constexpr size_t WS_WQ = 12 * MiB;
constexpr size_t WS_WG = 16 * MiB;
constexpr size_t WS_WP = 18 * MiB;
constexpr size_t WS_SUBK = 18 * MiB + 512 * 1024;
constexpr size_t WS_U = 20 * MiB;
constexpr size_t WS_V = 52 * MiB;
constexpr size_t WS_XN = 84 * MiB;
constexpr size_t WS_PB = 148 * MiB;
constexpr size_t WS_BIG = 164 * MiB;
constexpr size_t WS_Q = WS_BIG, WS_K = WS_BIG + 32 * MiB, WS_VV = WS_BIG + 64 * MiB;
constexpr size_t WS_RQ = WS_BIG + 96 * MiB, WS_RK = WS_BIG + 112 * MiB, WS_RV = WS_BIG + 128 * MiB, WS_RG = WS_BIG + 160 * MiB;
constexpr size_t WS_QRY = WS_BIG;
constexpr size_t WS_IDX = WS_BIG + 128 * MiB;
constexpr size_t WS_GATE = WS_BIG + 144 * MiB;
constexpr size_t WS_MIX = 356 * MiB;
constexpr size_t WS_RKT = 420 * MiB;
constexpr size_t WS_KVT = 436 * MiB;
constexpr size_t WS_ST = 468 * MiB;
constexpr size_t WS_END = 484 * MiB;
constexpr size_t WS_HB8 = WS_MIX, WS_SH = WS_MIX + 32 * MiB;
constexpr size_t WS_SU = WS_U + 16 * MiB, WS_SV = WS_U + 16 * MiB + 65536;

__device__ __forceinline__ float bf2f(bf16_t v) { return __uint_as_float(((u32)v) << 16); }
__device__ __forceinline__ bf16_t f2bf(float f) { u32 u = __float_as_uint(f); return (bf16_t)((u + 0x7fffu + ((u >> 16) & 1u)) >> 16); }

__device__ __forceinline__ int lane_id() { int l; asm volatile("v_mbcnt_lo_u32_b32 %0, -1, 0\n\tv_mbcnt_hi_u32_b32 %0, -1, %0" : "=v"(l)); return l; }
__device__ __forceinline__ float wave_sum(float v) {
#pragma unroll
    for (int o = 1; o < 64; o <<= 1) v += __shfl_xor(v, o);
    return v;
}
__device__ __forceinline__ float wave_max(float v) {
#pragma unroll
    for (int o = 1; o < 64; o <<= 1) v = fmaxf(v, __shfl_xor(v, o));
    return v;
}

__host__ __device__ __forceinline__ int rot_dst_row(int n);
template <bool ROT> __device__ __forceinline__ void b_transpose_wt(int bid, int tid, char* sm, const float* __restrict__ W, int K, int N, bf16_t* __restrict__ WT, const float* __restrict__ gain) {
    float (*t)[33] = (float (*)[33])sm;
    const int nbx = N / 32; const int k0 = (bid / nbx) * 32, n0 = (bid % nbx) * 32, tx = tid & 31, ty = tid >> 5;
    __syncthreads();
    for (int i = ty; i < 32; i += 8) { float g = gain ? gain[k0 + i] : 1.f; t[i][tx] = W[(size_t)(k0 + i) * N + n0 + tx] * g; }
    __syncthreads();
    for (int i = ty; i < 32; i += 8) WT[(size_t)(ROT ? rot_dst_row(n0 + i) : (n0 + i)) * K + k0 + tx] = f2bf(t[tx][i]);
}
__device__ __forceinline__ void b_transpose_w(int bid, int tid, char* sm, const float* __restrict__ W, int K, int N, bf16_t* __restrict__ WT, const float* __restrict__ gain) {
    float (*t)[33] = (float (*)[33])sm;
    const int nbx = N / 32; const int k0 = (bid / nbx) * 32, n0 = (bid % nbx) * 32, tx = tid & 31, ty = tid >> 5;
    __syncthreads();
    for (int i = ty; i < 32; i += 8) { float g = gain ? gain[k0 + i] : 1.f; t[i][tx] = W[(size_t)(k0 + i) * N + n0 + tx] * g; }
    __syncthreads();
    for (int i = ty; i < 32; i += 8) WT[(size_t)(n0 + i) * K + k0 + tx] = f2bf(t[tx][i]);
}
__device__ __forceinline__ void b_convert(int gtid, int gn, const float* __restrict__ in, bf16_t* __restrict__ out, size_t n4, const float* __restrict__ gain, int period) {
    for (size_t i = (size_t)gtid; i < n4; i += (size_t)gn) {
        float4 v = ((const float4*)in)[i];
        if (gain) { const int c = (int)((i * 4) % period); v.x *= gain[c]; v.y *= gain[c + 1]; v.z *= gain[c + 2]; v.w *= gain[c + 3]; }
        ushort4 o; o.x = f2bf(v.x); o.y = f2bf(v.y); o.z = f2bf(v.z); o.w = f2bf(v.w);
        ((ushort4*)out)[i] = o;
    }
}
__device__ __forceinline__ void b_rmsnorm_bf16(int row, int lane, const float* __restrict__ x, const float* __restrict__ gain, bf16_t* __restrict__ out, float eps) {
    const float4* xr = (const float4*)(x + (size_t)row * DM);
    float4 v[4]; float s = 0.f;
#pragma unroll
    for (int j = 0; j < 4; ++j) { v[j] = xr[lane + 64 * j]; s += v[j].x * v[j].x + v[j].y * v[j].y + v[j].z * v[j].z + v[j].w * v[j].w; }
    s = wave_sum(s);
    const float r = rsqrtf(s * (1.f / DM) + eps);
#pragma unroll
    for (int j = 0; j < 4; ++j) {
        const float4 g = ((const float4*)gain)[lane + 64 * j];
        ushort4 o; o.x = f2bf(v[j].x * r * g.x); o.y = f2bf(v[j].y * r * g.y); o.z = f2bf(v[j].z * r * g.z); o.w = f2bf(v[j].w * r * g.w);
        ((ushort4*)(out + (size_t)row * DM))[lane + 64 * j] = o;
    }
}
__device__ __forceinline__ void sincos_acc(float ang, float& s, float& c) {
    const double x = (double)ang;
    const double k = rint(x * 0.63661977236758134308);
    double r = fma(-k, 1.57079632679489655800, x); r = fma(-k, 6.12323399573676603587e-17, r);
    const double r2 = r * r;
    double sp = r * (1.0 + r2 * (-1.0 / 6 + r2 * (1.0 / 120 + r2 * (-1.0 / 5040 + r2 * (1.0 / 362880 + r2 * (-1.0 / 39916800 + r2 * (1.0 / 6227020800.0)))))));
    double cp = 1.0 + r2 * (-0.5 + r2 * (1.0 / 24 + r2 * (-1.0 / 720 + r2 * (1.0 / 40320 + r2 * (-1.0 / 3628800 + r2 * (1.0 / 479001600.0 + r2 * (-1.0 / 87178291200.0)))))));
    const int q = ((int)(long long)k) & 3;
    double ss, cc;
    if (q == 0) { ss = sp; cc = cp; } else if (q == 1) { ss = cp; cc = -sp; } else if (q == 2) { ss = -sp; cc = -cp; } else { ss = -cp; cc = sp; }
    s = (float)ss; c = (float)cc;
}
__device__ __forceinline__ void b_tables(int gid, const float* lq1, const float* lk1, const float* lq2, const float* lk2, const float* __restrict__ rel_bias,
                                                float* __restrict__ ctl, float* __restrict__ cs) {
    if (gid == 0) {
        float a = 0.f, b = 0.f;
        for (int i = 0; i < 64; ++i) { a += lq1[i] * lk1[i]; b += lq2[i] * lk2[i]; }
        ctl[0] = expf(a) - expf(b) + 0.2f;
    }
    if (gid < 512) {
        const int h = gid >> 7, n = gid & 127;
        int bucket;
        if (n < 16) bucket = n;
        else { const float nf = (float)n; int lg = 16 + (int)(logf(nf / 16.0f) / 2.0794415416798357f * 16.0f); bucket = lg < 31 ? lg : 31; }
        ctl[64 + h * 128 + n] = rel_bias[bucket * 4 + h] * LOG2E;
    }
    if (gid < 4096 * 32) {
        const int pos = gid >> 5, i = gid & 31;
        const float freq = 1.0f / powf(10000.0f, (float)i / 32.0f);
        const float ang = (float)pos * freq;
        float s, c; sincos_acc(ang, s, c);
        cs[gid] = c; cs[4096 * 32 + gid] = s;
    }
}

namespace pg8 {
#define PG8_LAS __attribute__((address_space(3)))
typedef unsigned short bf16_t;
typedef short bf16x8 __attribute__((ext_vector_type(8)));
typedef float f32x4 __attribute__((ext_vector_type(4)));
typedef unsigned u32x4 __attribute__((ext_vector_type(4)));
constexpr int BM = 256, BK = 64, HALF = 128, HTB = HALF * BK * 2  , STAGE_BYTES = 8 * HTB, NXCD = 8, WGM = 8;

__host__ __device__ __forceinline__ int lds_byte(int r, int c) { const int st = (r >> 4) * 2 + (c >> 5), rr = r & 15, cc = c & 31, ob = rr * 64 + cc * 2; return st * 1024 + (ob ^ (((ob >> 9) & 1) << 5)); }
__host__ __device__ __forceinline__ void stage_rc(int b, int& R, int& C) { const int st = b / 1024, sb = b % 1024, swz = sb ^ (((sb >> 9) & 1) << 5); R = (st >> 1) * 16 + swz / 64; C = (st & 1) * 32 + (swz % 64) / 2; }
__host__ __device__ __forceinline__ int perm32(int rho) { const int n = rho >> 4, i = rho & 15; return 8 * (i >> 2) + 4 * n + (i & 3); }

struct Unit { int pm, pn; };
struct Gemm { const bf16_t* A; const bf16_t* Bt; int M, N, K; };

struct StaticOrder {
    int nM, nN, nwg, G, c;
    __host__ __device__ void init(int M, int N, int G_, int c_) { nM = M / BM; nN = N / BM; nwg = nM * nN; G = G_; c = c_; }
    __host__ __device__ bool next(int i, Unit& u) const {
        const long L = (long)i * G + c; if (L >= nwg) return false;
        int wgid = (int)L; { const int q = nwg / NXCD, r = nwg % NXCD, xcd = wgid % NXCD, off = wgid / NXCD; wgid = (xcd < r ? xcd * (q + 1) : r * (q + 1) + (xcd - r) * q) + off; }
        const int nig = WGM * nN, gid = wgid / nig, fm = gid * WGM, gsz = (nM - fm) < WGM ? (nM - fm) : WGM;
        u.pm = fm + ((wgid % nig) % gsz); u.pn = (wgid % nig) / gsz; return true;
    }
    __device__ __forceinline__ void a_ready(const Unit&) const {}
    __device__ __forceinline__ void done(const Unit&) const {}
};

__device__ __forceinline__ unsigned cvt_pk_bf16(float lo, float hi) { unsigned r; asm volatile("v_cvt_pk_bf16_f32 %0, %1, %2" : "=v"(r) : "v"(lo), "v"(hi)); return r; }
typedef float f32x2 __attribute__((ext_vector_type(2)));
template <class Epi, class Sched, bool ALIGN_EPI = false, bool SP2 = false>
__device__ __forceinline__ void gemm_phase(PG8_LAS unsigned char* lds, const Gemm g, const Sched& S, const Epi& E, const int tid) {
    const int wid = __builtin_amdgcn_readfirstlane(tid >> 6), lane = tid & 63, wr = wid >> 2, wc = wid & 3, fr = lane & 15, fq = lane >> 4;
    const int K = g.K, nt = K / BK;
    unsigned voffA[2], voffB[2];
#pragma unroll
    for (int i = 0; i < 2; ++i) { int R, C; stage_rc(tid * 16 + i * 8192, R, C); const int Rb = Epi::PERM ? ((R & ~31) + perm32(R & 31)) : R;
        voffA[i] = (unsigned)(R * K + C) * 2u; voffB[i] = (unsigned)(Rb * K + C) * 2u; }
    const size_t kstep = (size_t)(BK * 2);
    const size_t hstep = (size_t)HALF * K * 2;
    const size_t tstep = 2 * hstep;
    const unsigned ldsw = (unsigned)wid * 1024u;
    const int aoff = lds_byte(wr * 64 + fr, fq * 8), boff = lds_byte(wc * 32 + fr, fq * 8);
#define PG8_SA(b, h) (((b) * 2 + (h)) * HTB)
#define PG8_SB(b, h) ((4 + (b) * 2 + (h)) * HTB)
#define PG8_STAGE(bufoff, gbase, voff) do { _Pragma("unroll") for (int _i = 0; _i < 2; ++_i) \
        __builtin_amdgcn_global_load_lds((const unsigned*)((const char*)(gbase) + (voff)[_i]), (PG8_LAS unsigned*)(lds + (bufoff) + ldsw + _i * 8192), 16, 0, 0); } while (0)
#define PG8_LDA(dst, b, h) do { _Pragma("unroll") for (int m = 0; m < 4; ++m) _Pragma("unroll") for (int k = 0; k < 2; ++k) dst[m][k] = *(const PG8_LAS bf16x8*)(lds + PG8_SA(b, h) + aoff + m * 2048 + k * 1024); } while (0)
#define PG8_LDB(dst, b, h) do { _Pragma("unroll") for (int n = 0; n < 2; ++n) _Pragma("unroll") for (int k = 0; k < 2; ++k) dst[n][k] = *(const PG8_LAS bf16x8*)(lds + PG8_SB(b, h) + boff + n * 2048 + k * 1024); } while (0)
#define PG8_MMA(ai, bj, At, Bt) do { __builtin_amdgcn_s_setprio(1); _Pragma("unroll") for (int m = 0; m < 4; ++m) _Pragma("unroll") for (int n = 0; n < 2; ++n) _Pragma("unroll") for (int k = 0; k < 2; ++k) \
        acc[ai][bj][m][n] = __builtin_amdgcn_mfma_f32_16x16x32_bf16(Bt[n][k], At[m][k], acc[ai][bj][m][n], 0, 0, 0); __builtin_amdgcn_s_setprio(0); } while (0)
#define PG8_WAIT_V(n) asm volatile("s_waitcnt vmcnt(" #n ")" ::: "memory")
#define PG8_WAIT_L(n) asm volatile("s_waitcnt lgkmcnt(" #n ")" ::: "memory")
#define PG8_BAR __builtin_amdgcn_s_barrier()
#define PG8_SCHED __builtin_amdgcn_sched_barrier(0)
    Unit cur, nxt; int ui = 0;
    if (!S.next(0, cur)) return;
    f32x4 acc[2][2][4][2];
#pragma unroll
    for (int a = 0; a < 2; ++a)
#pragma unroll
        for (int b = 0; b < 2; ++b)
#pragma unroll
            for (int m = 0; m < 4; ++m)
#pragma unroll
                for (int n = 0; n < 2; ++n) acc[a][b][m][n] = (f32x4){0.f, 0.f, 0.f, 0.f};
    bf16x8 At[4][2], B0[2][2], B1[2][2];
    const char* cA = (const char*)g.A + (size_t)cur.pm * tstep; const char* cB = (const char*)g.Bt + (size_t)cur.pn * tstep;
    S.a_ready(cur);
    if constexpr (SP2) {
        PG8_STAGE(PG8_SB(0, 0), cB, voffB); PG8_STAGE(PG8_SB(0, 1), cB + hstep, voffB); PG8_STAGE(PG8_SA(0, 0), cA, voffA); PG8_STAGE(PG8_SA(0, 1), cA + hstep, voffA);
        if (wr == 1) PG8_BAR;
        PG8_WAIT_V(2); PG8_BAR;
        PG8_STAGE(PG8_SB(1, 0), cB + kstep, voffB); PG8_STAGE(PG8_SA(1, 0), cA + kstep, voffA); PG8_STAGE(PG8_SB(1, 1), cB + hstep + kstep, voffB);
        PG8_WAIT_V(6); PG8_BAR;
    } else {
        PG8_STAGE(PG8_SB(0, 0), cB, voffB); PG8_STAGE(PG8_SA(0, 0), cA, voffA); PG8_STAGE(PG8_SB(0, 1), cB + hstep, voffB); PG8_STAGE(PG8_SA(0, 1), cA + hstep, voffA);
        if (wr == 1) PG8_BAR;
        PG8_WAIT_V(4); PG8_BAR;
        PG8_STAGE(PG8_SB(1, 0), cB + kstep, voffB); PG8_STAGE(PG8_SA(1, 0), cA + kstep, voffA); PG8_STAGE(PG8_SB(1, 1), cB + hstep + kstep, voffB);
        PG8_WAIT_V(6); PG8_BAR;
    }
    for (;;) {
        const bool has_next = S.next(ui + 1, nxt);
        const char* nA = has_next ? (const char*)g.A + (size_t)nxt.pm * tstep : cA; const char* nB = has_next ? (const char*)g.Bt + (size_t)nxt.pn * tstep : cB;
        for (int t = 0; t < nt; t += 2) {
            const bool last = (t == nt - 2);
            const char* a1 = cA + (size_t)(t + 1) * kstep;
            const char* a2 = last ? nA : cA + (size_t)(t + 2) * kstep; const char* b2 = last ? nB : cB + (size_t)(t + 2) * kstep;
            const char* a3 = a2 + kstep; const char* b3 = b2 + kstep;
            if (last && has_next) S.a_ready(nxt);
            if constexpr (SP2) {
            PG8_LDB(B0, 0, 0); PG8_LDB(B1, 0, 1); PG8_SCHED; PG8_LDA(At, 0, 0); PG8_STAGE(PG8_SA(1, 1), a1 + hstep, voffA);
            PG8_WAIT_V(8); PG8_WAIT_L(0); PG8_BAR; PG8_MMA(0, 0, At, B0); PG8_MMA(0, 1, At, B1); PG8_BAR; PG8_SCHED;
            PG8_LDA(At, 0, 1); PG8_STAGE(PG8_SB(0, 0), b2, voffB); PG8_STAGE(PG8_SB(0, 1), b2 + hstep, voffB); PG8_STAGE(PG8_SA(0, 0), a2, voffA);
            PG8_WAIT_V(8); PG8_WAIT_L(0); PG8_BAR; PG8_MMA(1, 0, At, B0); PG8_MMA(1, 1, At, B1); PG8_BAR; PG8_SCHED;
            PG8_LDB(B0, 1, 0); PG8_LDB(B1, 1, 1); PG8_SCHED; PG8_LDA(At, 1, 0); PG8_STAGE(PG8_SA(0, 1), a2 + hstep, voffA);
            PG8_WAIT_V(8); PG8_WAIT_L(0); PG8_BAR; PG8_MMA(0, 0, At, B0); PG8_MMA(0, 1, At, B1); PG8_BAR; PG8_SCHED;
            PG8_LDA(At, 1, 1); PG8_STAGE(PG8_SB(1, 0), b3, voffB); PG8_STAGE(PG8_SB(1, 1), b3 + hstep, voffB); PG8_STAGE(PG8_SA(1, 0), a3, voffA);
            PG8_WAIT_V(8); PG8_WAIT_L(0); PG8_BAR; PG8_MMA(1, 0, At, B0); PG8_MMA(1, 1, At, B1); PG8_BAR; PG8_SCHED;
            } else {
            PG8_LDB(B0, 0, 0); PG8_SCHED; PG8_LDA(At, 0, 0); PG8_STAGE(PG8_SA(1, 1), a1 + hstep, voffA);
            PG8_WAIT_L(8); PG8_BAR; PG8_WAIT_L(0); PG8_MMA(0, 0, At, B0); PG8_BAR; PG8_SCHED;
            PG8_LDB(B1, 0, 1); PG8_STAGE(PG8_SB(0, 0), b2, voffB);
            PG8_BAR; PG8_WAIT_L(0); PG8_MMA(0, 1, At, B1); PG8_BAR;
            PG8_LDA(At, 0, 1); PG8_STAGE(PG8_SA(0, 0), a2, voffA);
            PG8_BAR; PG8_WAIT_L(0); PG8_MMA(1, 0, At, B0); PG8_BAR; PG8_SCHED;
            PG8_STAGE(PG8_SB(0, 1), b2 + hstep, voffB);
            PG8_WAIT_V(6); PG8_BAR; PG8_MMA(1, 1, At, B1); PG8_BAR;
            PG8_LDB(B0, 1, 0); PG8_SCHED; PG8_LDA(At, 1, 0); PG8_STAGE(PG8_SA(0, 1), a2 + hstep, voffA);
            PG8_WAIT_L(8); PG8_BAR; PG8_WAIT_L(0); PG8_MMA(0, 0, At, B0); PG8_BAR; PG8_SCHED;
            PG8_LDB(B1, 1, 1); PG8_STAGE(PG8_SB(1, 0), b3, voffB);
            PG8_BAR; PG8_WAIT_L(0); PG8_MMA(0, 1, At, B1); PG8_BAR;
            PG8_LDA(At, 1, 1); PG8_STAGE(PG8_SA(1, 0), a3, voffA);
            PG8_BAR; PG8_WAIT_L(0); PG8_MMA(1, 0, At, B0); PG8_BAR; PG8_SCHED;
            PG8_STAGE(PG8_SB(1, 1), b3 + hstep, voffB);
            PG8_WAIT_V(6); PG8_BAR; PG8_MMA(1, 1, At, B1); PG8_BAR;
            }
        }
        if constexpr (ALIGN_EPI) { if (wr == 0) PG8_BAR; }
        if constexpr (!Epi::AFTER_DRAIN) { E(acc, cur, wr, wc, fr, fq); S.done(cur); }
        if (!has_next) break;
#pragma unroll
        for (int a = 0; a < 2; ++a)
#pragma unroll
            for (int b = 0; b < 2; ++b)
#pragma unroll
                for (int m = 0; m < 4; ++m)
#pragma unroll
                    for (int n = 0; n < 2; ++n) acc[a][b][m][n] = (f32x4){0.f, 0.f, 0.f, 0.f};
        cur = nxt; cA = nA; cB = nB; ++ui;
        if constexpr (ALIGN_EPI) { if (wr == 1) PG8_BAR; }
    }
    PG8_WAIT_V(0);
    if constexpr (!ALIGN_EPI) { if (wr == 0) PG8_BAR; }
    PG8_BAR;
    if constexpr (Epi::AFTER_DRAIN) { E.fused(acc, cur, wr, wc, fr, fq, lds, wid, lane); S.done(cur); }
#undef PG8_SA
#undef PG8_SB
#undef PG8_STAGE
#undef PG8_LDA
#undef PG8_LDB
#undef PG8_MMA
#undef PG8_WAIT_V
#undef PG8_WAIT_L
#undef PG8_BAR
#undef PG8_SCHED
}
}

template <class E> struct EpiRow8 {
    static constexpr bool PERM = true, AFTER_DRAIN = false;
    E e;
    __device__ __forceinline__ void operator()(const pg8::f32x4 (&acc)[2][2][4][2], const pg8::Unit& u, int wr, int wc, int fr, int fq) const {
        const int row0 = u.pm * 256 + wr * 64 + fr, col0 = u.pn * 256 + wc * 32 + 8 * fq;
#pragma unroll
        for (int ai = 0; ai < 2; ++ai)
#pragma unroll
            for (int m = 0; m < 4; ++m) {
                const int row = row0 + ai * 128 + m * 16; float s = 0.f;
#pragma unroll
                for (int bj = 0; bj < 2; ++bj) {
                    const float v[8] = {acc[ai][bj][m][0][0], acc[ai][bj][m][0][1], acc[ai][bj][m][0][2], acc[ai][bj][m][0][3], acc[ai][bj][m][1][0], acc[ai][bj][m][1][1], acc[ai][bj][m][1][2], acc[ai][bj][m][1][3]};
                    s += e.row8(row, col0 + bj * 128, v);
                }
                if (E::ROWSUM) { s += __shfl_xor(s, 16); s += __shfl_xor(s, 32); if (fq == 0) e.rowsum(row, s); }
            }
    }
};
__device__ __forceinline__ uint4 pack8_asm(const float* w) { uint4 o; o.x = pg8::cvt_pk_bf16(w[0], w[1]); o.y = pg8::cvt_pk_bf16(w[2], w[3]); o.z = pg8::cvt_pk_bf16(w[4], w[5]); o.w = pg8::cvt_pk_bf16(w[6], w[7]); return o; }

template <class Epi>
__device__ __forceinline__ void b_gemm(int bid, int tid, char* sm, int nbx, const bf16_t* __restrict__ A, const bf16_t* __restrict__ Bt, int K, const Epi& epi) {
    float (*As)[132] = (float (*)[132])sm;
    float (*Bs)[132] = (float (*)[132])(sm + 16 * 132 * 4);
    const int tx = tid & 15, ty = tid >> 4;
    const int row0 = (bid / nbx) * 128, col0 = (bid % nbx) * 128;
    const int lr = tid >> 1, lk = (tid & 1) * 8;
    const bf16_t* ap = A + (size_t)(row0 + lr) * K + lk;
    const bf16_t* bp = Bt + (size_t)(col0 + lr) * K + lk;
    float acc[8][8];
#pragma unroll
    for (int i = 0; i < 8; ++i)
#pragma unroll
        for (int j = 0; j < 8; ++j) acc[i][j] = 0.f;
    for (int k0 = 0; k0 < K; k0 += 16) {
        const uint4 av = *(const uint4*)(ap + k0), bv = *(const uint4*)(bp + k0);
        __syncthreads();
        const u32 aw[4] = {av.x, av.y, av.z, av.w}, bw[4] = {bv.x, bv.y, bv.z, bv.w};
#pragma unroll
        for (int j = 0; j < 4; ++j) {
            As[lk + 2 * j][lr] = __uint_as_float(aw[j] << 16); As[lk + 2 * j + 1][lr] = __uint_as_float(aw[j] & 0xffff0000u);
            Bs[lk + 2 * j][lr] = __uint_as_float(bw[j] << 16); Bs[lk + 2 * j + 1][lr] = __uint_as_float(bw[j] & 0xffff0000u);
        }
        __syncthreads();
#pragma unroll 2
        for (int k = 0; k < 16; ++k) {
            float a[8], b[8];
            const float4 a0 = *(const float4*)&As[k][ty * 8], a1 = *(const float4*)&As[k][ty * 8 + 4];
            const float4 b0 = *(const float4*)&Bs[k][tx * 8], b1 = *(const float4*)&Bs[k][tx * 8 + 4];
            a[0] = a0.x; a[1] = a0.y; a[2] = a0.z; a[3] = a0.w; a[4] = a1.x; a[5] = a1.y; a[6] = a1.z; a[7] = a1.w;
            b[0] = b0.x; b[1] = b0.y; b[2] = b0.z; b[3] = b0.w; b[4] = b1.x; b[5] = b1.y; b[6] = b1.z; b[7] = b1.w;
#pragma unroll
            for (int i = 0; i < 8; ++i)
#pragma unroll
                for (int j = 0; j < 8; ++j) acc[i][j] = fmaf(a[i], b[j], acc[i][j]);
        }
    }
#pragma unroll
    for (int i = 0; i < 8; ++i) { const float s_ = epi.row8(row0 + ty * 8 + i, col0 + tx * 8, acc[i]); if (Epi::ROWSUM) epi.rowsum(row0 + ty * 8 + i, s_); }
}

struct EpiInProj {
    static constexpr bool ROWSUM = false;
    __device__ __forceinline__ void rowsum(int, float) const {}
    bf16_t *Q, *Kb, *V, *RQ, *RK, *RV, *RG; const float* cs;
    __device__ __forceinline__ float row8(int row, int col, const float* v) const {
        bf16_t* dst; float sc = 1.f; int c = col; bool silu = false;
        if (col < 512) { dst = Q + (size_t)row * 512; sc = QSCALE; }
        else if (col < 1024) { dst = Kb + (size_t)row * 512; c = col - 512; }
        else if (col < 1536) { dst = V + (size_t)row * 512; c = col - 1024; }
        else if (col < 1792) { dst = RQ + (size_t)row * 256; c = col - 1536; }
        else if (col < 2048) { dst = RK + (size_t)row * 256; c = col - 1792; }
        else if (col < 2560) { dst = RV + (size_t)row * 512; c = col - 2048; }
        else { dst = RG + (size_t)row * 512; c = col - 2560; silu = true; }
        const bool rot = (col >= 1536 && col < 2048);
        if (rot) {
            float* raw = rawrot + (size_t)row * 512 + (col - 1536);
#pragma unroll
            for (int j = 0; j < 8; ++j) raw[j] = v[j];
            return 0.f;
        }
        ushort4 o0, o1; float w[8];
#pragma unroll
        for (int j = 0; j < 8; ++j) { float x = v[j] * sc; if (silu) x = x / (1.f + __expf(-x)); w[j] = x; }
        o0.x = f2bf(w[0]); o0.y = f2bf(w[1]); o0.z = f2bf(w[2]); o0.w = f2bf(w[3]); o1.x = f2bf(w[4]); o1.y = f2bf(w[5]); o1.z = f2bf(w[6]); o1.w = f2bf(w[7]);
        *(ushort4*)(dst + c) = o0; *(ushort4*)(dst + c + 4) = o1;
        return 0.f;
    }
    float* rawrot;
};
__device__ __forceinline__ void b_rotary(size_t gid, const float* __restrict__ raw, const float* __restrict__ cs, bf16_t* __restrict__ RQ, bf16_t* __restrict__ RK) {
    const int row = (int)(gid >> 9), c = (int)(gid & 511);
    const int which = c >> 8, cc = c & 255, d = cc & 63, i = d & 31, pos = row & (SEQ - 1);
    const float co = cs[pos * 32 + i], si = cs[4096 * 32 + pos * 32 + i];
    const float* r = raw + (size_t)row * 512 + which * 256 + (cc & ~63);
    const float x1 = r[i], x2 = r[i + 32];
    float o = (d < 32) ? (x1 * co - x2 * si) : (x1 * si + x2 * co);
    if (which) { o *= 0.125f; RK[(size_t)row * 256 + cc] = f2bf(o); } else RQ[(size_t)row * 256 + cc] = f2bf(o);
}

__device__ __forceinline__ void b_mix_naive(int bid, int tid, char* sm, const bf16_t* __restrict__ Q, const bf16_t* __restrict__ Kb, const bf16_t* __restrict__ V,
                                                   const bf16_t* __restrict__ RQ, const bf16_t* __restrict__ RK, const bf16_t* __restrict__ RV, const bf16_t* __restrict__ RG,
                                                   const float* __restrict__ ctl, const float* __restrict__ subln, bf16_t* __restrict__ MIX, int mode) {
    float* q1 = (float*)sm; float* q2 = q1 + 64; float* w = q2 + 64; float* w2 = w + SEQ; float* red = w2 + SEQ; float* part = red + 8;
    const int lane = tid & 63, wid = (tid >> 6) & 3;
    __syncthreads();
    const int h = bid & 3, row = bid >> 2, t = row & (SEQ - 1), rb = row - t;
    if (mode == 0) { if (tid < 64) { q1[tid] = bf2f(Q[(size_t)row * 512 + h * 64 + tid]); q2[tid] = bf2f(Q[(size_t)row * 512 + 256 + h * 64 + tid]); } }
    else { if (tid < 64) q1[tid] = bf2f(RQ[(size_t)row * 256 + h * 64 + tid]); }
    __syncthreads();
    float m1 = -INFINITY, m2 = -INFINITY;
    const float lg = (mode == 1) ? log2f(1.0f - exp2f(-5.0f - (float)h)) : 0.f;
    for (int j = tid; j <= t; j += 256) {
        if (mode == 0) {
            const bf16_t* k1 = Kb + (size_t)(rb + j) * 512 + h * 64; const bf16_t* k2 = k1 + 256;
            float s1 = 0.f, s2 = 0.f;
            for (int d = 0; d < 64; d += 8) {
                const uint4 a = *(const uint4*)(k1 + d), b2 = *(const uint4*)(k2 + d);
                const u32 aw[4] = {a.x, a.y, a.z, a.w}, bw[4] = {b2.x, b2.y, b2.z, b2.w};
#pragma unroll
                for (int e = 0; e < 4; ++e) {
                    s1 += q1[d + 2 * e] * __uint_as_float(aw[e] << 16) + q1[d + 2 * e + 1] * __uint_as_float(aw[e] & 0xffff0000u);
                    s2 += q2[d + 2 * e] * __uint_as_float(bw[e] << 16) + q2[d + 2 * e + 1] * __uint_as_float(bw[e] & 0xffff0000u);
                }
            }
            int dist = t - j; if (dist > 127) dist = 127;
            const float b = ctl[64 + h * 128 + dist];
            s1 += b; s2 += b; w[j] = s1; w2[j] = s2; m1 = fmaxf(m1, s1); m2 = fmaxf(m2, s2);
        } else {
            const bf16_t* k1 = RK + (size_t)(rb + j) * 256 + h * 64;
            float s1 = 0.f;
            for (int d = 0; d < 64; d += 8) {
                const uint4 a = *(const uint4*)(k1 + d);
                const u32 aw[4] = {a.x, a.y, a.z, a.w};
#pragma unroll
                for (int e = 0; e < 4; ++e) s1 += q1[d + 2 * e] * __uint_as_float(aw[e] << 16) + q1[d + 2 * e + 1] * __uint_as_float(aw[e] & 0xffff0000u);
            }
            w[j] = s1 * exp2f((float)(t - j) * lg);
        }
    }
    if (mode == 0) {
        m1 = wave_max(m1); m2 = wave_max(m2);
        if (lane == 0) { red[wid] = m1; red[4 + wid] = m2; }
        __syncthreads();
        m1 = fmaxf(fmaxf(red[0], red[1]), fmaxf(red[2], red[3])); m2 = fmaxf(fmaxf(red[4], red[5]), fmaxf(red[6], red[7]));
        __syncthreads();
        float l1 = 0.f, l2 = 0.f;
        for (int j = tid; j <= t; j += 256) { const float e1 = exp2f(w[j] - m1), e2 = exp2f(w2[j] - m2); w[j] = e1; w2[j] = e2; l1 += e1; l2 += e2; }
        l1 = wave_sum(l1); l2 = wave_sum(l2);
        if (lane == 0) { red[wid] = l1; red[4 + wid] = l2; }
        __syncthreads();
        l1 = red[0] + red[1] + red[2] + red[3]; l2 = red[4] + red[5] + red[6] + red[7];
        const float lam = ctl[0];
        const float i1 = 1.f / l1, i2 = lam / l2;
        for (int j = tid; j <= t; j += 256) w[j] = w[j] * i1 - w2[j] * i2;
    }
    __syncthreads();
    const bf16_t* vs = (mode == 0 ? V : RV) + (size_t)rb * 512 + h * 128 + (tid & 127);
    float acc = 0.f;
    for (int j = (tid >> 7); j <= t; j += 2) acc += w[j] * bf2f(vs[(size_t)j * 512]);
    if (tid >= 128) part[tid - 128] = acc;
    __syncthreads();
    float o = 0.f, ss = 0.f;
    if (tid < 128) { o = acc + part[tid]; ss = o * o; }
    ss = wave_sum(ss);
    if (lane == 0) red[wid] = ss;
    __syncthreads();
    if (tid < 128) {
        const float tot = red[0] + red[1];
        float r;
        if (mode == 0) { r = o * rsqrtf(tot * (1.f / 128) + 1e-5f) * subln[tid] * 0.8f; MIX[(size_t)row * DM + h * 128 + tid] = f2bf(r); }
        else { r = o * rsqrtf(tot * (1.f / 128) + 1e-6f) * bf2f(RG[(size_t)row * 512 + h * 128 + tid]); MIX[(size_t)row * DM + 512 + h * 128 + tid] = f2bf(r); }
    }
}

typedef float f32x2c_t __attribute__((ext_vector_type(2)));
typedef __bf16 bf16x2c_t __attribute__((ext_vector_type(2)));
__device__ __forceinline__ u32 pk2f(float lo, float hi) { const f32x2c_t v = {lo, hi}; return __builtin_bit_cast(u32, __builtin_convertvector(v, bf16x2c_t)); }
__device__ __forceinline__ uint4 pack8(const float* w) { uint4 o; o.x = pk2f(w[0], w[1]); o.y = pk2f(w[2], w[3]); o.z = pk2f(w[4], w[5]); o.w = pk2f(w[6], w[7]); return o; }
template <bool ROT> __device__ __forceinline__ void wave_transpose_item(const float* __restrict__ W, int K, int N, bf16_t* __restrict__ WT, const float* __restrict__ gain, LAS float* scr, int item, int lane) {
    const int nblk = N / 32, kb = item / nblk, nb = item % nblk, k0 = 64 * kb, n0 = 32 * nb;
#pragma unroll 8
    for (int i = 0; i < 32; ++i) { const int kk = 2 * i + (lane >> 5); const float g = gain ? gain[k0 + kk] : 1.f; scr[kk * 33 + (lane & 31)] = W[(size_t)(k0 + kk) * N + n0 + (lane & 31)] * g; }
    asm volatile("s_waitcnt lgkmcnt(0)" ::: "memory");
    const int c = lane & 7;
#pragma unroll
    for (int j = 0; j < 4; ++j) { const int n = (lane >> 3) + 8 * j; const LAS float* sp = scr + (8 * c) * 33 + n;
        uint4 o; o.x = pk2f(sp[0 * 33], sp[1 * 33]); o.y = pk2f(sp[2 * 33], sp[3 * 33]); o.z = pk2f(sp[4 * 33], sp[5 * 33]); o.w = pk2f(sp[6 * 33], sp[7 * 33]);
        *(uint4*)(WT + (size_t)(ROT ? rot_dst_row(n0 + n) : (n0 + n)) * K + k0 + 8 * c) = o; }
    asm volatile("s_waitcnt lgkmcnt(0)" ::: "memory");
}
typedef short bf16x8_t __attribute__((ext_vector_type(8)));
typedef float f32x16_t __attribute__((ext_vector_type(16)));
typedef unsigned u32x4_t __attribute__((ext_vector_type(4)));
typedef unsigned u32x2_t __attribute__((ext_vector_type(2)));
typedef float f32x4_t __attribute__((ext_vector_type(4)));
#define MFMA32(a, b, c) __builtin_amdgcn_mfma_f32_32x32x16_bf16((a), (b), (c), 0, 0, 0)
__device__ __forceinline__ int crow(int r, int hi) { return (r & 3) + 8 * (r >> 2) + 4 * hi; }
__device__ __forceinline__ bf16x8_t pack_p(const f32x16_t& p, int s) {
    u32x4_t w; w.x = pk2f(p[8 * s + 0], p[8 * s + 1]); w.y = pk2f(p[8 * s + 2], p[8 * s + 3]); w.z = pk2f(p[8 * s + 4], p[8 * s + 5]); w.w = pk2f(p[8 * s + 6], p[8 * s + 7]);
    return __builtin_bit_cast(bf16x8_t, w);
}
constexpr int KROW = 144;
constexpr int VROW = 144;
constexpr int AL_K = 0;
constexpr int AL_V = AL_K + 2 * 2 * 64 * KROW;
constexpr int AL_X = 0;
constexpr int AL_ALS = AL_V + 2 * 128 * VROW;
constexpr int AL_TAB = AL_ALS + 8 * 32 * 4;
constexpr int AL_Q = AL_TAB + 1536;
constexpr int AL_END = AL_Q + 8 * 32 * KROW;
static_assert(AL_ALS >= 65536 && AL_END <= 131072, "attention LDS map");

template <int MODE>
__device__ __forceinline__ void attn_unit(LAS unsigned char* lds, int tid, int b, int h, int qb, const bf16_t* __restrict__ Q, const bf16_t* __restrict__ Kb, const bf16_t* __restrict__ VT,
                                          const float* __restrict__ ctl, const float* __restrict__ subln, bf16_t* __restrict__ MIX) {
    asm volatile("" : "+v"(tid));
    const int lane = tid & 63, wave = __builtin_amdgcn_readfirstlane(tid >> 6), map = wave >> 2, qs = wave & 3, ql = lane & 31, hi = lane >> 5;
    const int q0 = qb * 128, q0w = q0 + 32 * qs, nt = 2 * (qb + 1);
    const size_t rowbase = (size_t)b * SEQ;
    LAS float* als = (LAS float*)(lds + AL_ALS) + wave * 32;
    LAS float* tab = (LAS float*)(lds + AL_TAB);
    if (tid < 384) { const int d_ = tid - 128; tab[tid] = d_ < 0 ? 0.f : ctl[64 + h * 128 + (d_ > 127 ? 127 : d_)] - ctl[64 + h * 128 + 127]; }
    LAS unsigned char* qlds = lds + AL_Q + wave * (32 * KROW) + ql * KROW + 16 * hi;
    {
        const bf16_t* qp = Q + (rowbase + q0w + ql) * 512 + map * 256 + h * 64 + 8 * hi;
        bf16x8_t qtmp[4];
#pragma unroll
        for (int ks = 0; ks < 4; ++ks) qtmp[ks] = *(const bf16x8_t*)(qp + 16 * ks);
#pragma unroll
        for (int ks = 0; ks < 4; ++ks) *(LAS bf16x8_t*)(qlds + 32 * ks) = qtmp[ks];
    }
    const int kkey = (tid >> 3) & 63, kc = tid & 7;
    const bf16_t* kg = Kb + (rowbase + kkey) * 512 + h * 64 + 8 * kc;
    const bf16_t* vg = VT + ((size_t)(b * 4 + h) * 128 + (tid >> 3)) * SEQ + 8 * kc;
    const int klds = AL_K + kkey * KROW + 16 * kc, vlds = AL_V + (tid >> 3) * VROW + 16 * kc;
    u32x4_t sk0, sk1, sv0, sv1;
#define ATT_LOADK(t) do { sk0 = *(const u32x4_t*)(kg + (size_t)(t) * 64 * 512); sk1 = *(const u32x4_t*)(kg + (size_t)(t) * 64 * 512 + 256); } while (0)
#define ATT_LOADV(t) do { sv0 = *(const u32x4_t*)(vg + (t) * 64); sv1 = *(const u32x4_t*)(vg + (size_t)64 * SEQ + (t) * 64); } while (0)
#define ATT_STOREK(buf) do { *(LAS u32x4_t*)(lds + klds + (buf) * (2 * 64 * KROW)) = sk0; *(LAS u32x4_t*)(lds + klds + (buf) * (2 * 64 * KROW) + 64 * KROW) = sk1; } while (0)
#define ATT_STOREV(buf) do { *(LAS u32x4_t*)(lds + vlds + (buf) * (128 * VROW)) = sv0; *(LAS u32x4_t*)(lds + vlds + (buf) * (128 * VROW) + 64 * VROW) = sv1; } while (0)
#define ATT_QK(P_, KB_, C0_) do { const LAS unsigned char* kb_ = lds + AL_K + (KB_) * (2 * 64 * KROW) + map * (64 * KROW) + ql * KROW + 16 * hi; \
        _Pragma("unroll") for (int blk = 0; blk < 2; ++blk) { \
            _Pragma("unroll") for (int ks = 0; ks < 4; ++ks) { const bf16x8_t a_ = *(const LAS bf16x8_t*)(kb_ + blk * 32 * KROW + 32 * ks); const bf16x8_t q_ = *(const LAS bf16x8_t*)(qlds + 32 * ks); \
                if (ks == 0) P_[blk] = MFMA32(a_, q_, C0_); else P_[blk] = MFMA32(a_, q_, P_[blk]); } } } while (0)
#define ATT_VLD(W_, VB_, G_) do { const LAS unsigned char* vq_ = lds + AL_V + (VB_) * (128 * VROW) + ql * VROW + 16 * hi + 32 * (G_); \
        _Pragma("unroll") for (int cb = 0; cb < 4; ++cb) W_[cb] = *(const LAS u32x4_t*)(vq_ + cb * 32 * VROW); } while (0)
#define ATT_EXPC(P_, G_, C_, W_) do { const float x0_ = P_[(G_) >> 1][8 * ((G_) & 1) + 2 * (C_)], x1_ = P_[(G_) >> 1][8 * ((G_) & 1) + 2 * (C_) + 1]; \
        const float a_ = (MODE & 4) ? x0_ : __builtin_amdgcn_exp2f(x0_), b_ = (MODE & 4) ? x1_ : __builtin_amdgcn_exp2f(x1_); \
        W_[C_] = pk2f(a_, b_); ls0_ += a_; ls1_ += b_; } while (0)
#define ATT_SLOT(P_, G_, CB_, WC_, VC_, WN_) do { \
        if (!(MODE & 16)) o[CB_] = MFMA32(__builtin_bit_cast(bf16x8_t, WC_), __builtin_bit_cast(bf16x8_t, VC_[CB_]), o[CB_]); \
        if ((G_) < 3) { ATT_EXPC(P_, ((G_) + 1) & 3, CB_, WN_); asm volatile("" : "+v"(ls0_), "+v"(ls1_)); }        \
        __builtin_amdgcn_sched_barrier(0); } while (0)
#define ATT_SMPV(P_, PN_, KT_, VB_) do { \
        u32x4_t vA_[4], vB_[4]; \
        ATT_VLD(vA_, VB_, 0); \
        if ((KT_) + 4 >= nt) { const int db_ = q0w + ql - 64 * (KT_) - 4 * hi;        \
            const LAS float* tp_ = tab + (128 - 59) + db_; \
            _Pragma("unroll") for (int blk = 0; blk < 2; ++blk) { float bs_[16]; \
                _Pragma("unroll") for (int r = 0; r < 16; ++r) bs_[r] = tp_[59 - (32 * blk + (r & 3) + 8 * (r >> 2))]; \
                _Pragma("unroll") for (int r = 0; r < 16; ++r) asm volatile("" : "+v"(bs_[r])); \
                _Pragma("unroll") for (int r = 0; r < 16; ++r) P_[blk][r] = db_ < (32 * blk + (r & 3) + 8 * (r >> 2)) ? -INFINITY : P_[blk][r] + bs_[r]; } } \
        float rm_ = P_[0][0]; \
        _Pragma("unroll") for (int r = 1; r < 16; ++r) rm_ = fmaxf(rm_, P_[0][r]); \
        _Pragma("unroll") for (int r = 0; r < 16; ++r) rm_ = fmaxf(rm_, P_[1][r]); \
        rm_ = fmaxf(rm_, __shfl_xor(rm_, 32)); \
          \
          \
        if (__any(rm_ > 8.0f || ((KT_) == 0 && rm_ < -8.0f))) { \
            const float dl_ = (KT_) == 0 ? rm_ : fmaxf(rm_, 0.f); \
            const float alpha_ = __builtin_amdgcn_exp2f(-dl_); \
            l *= alpha_; \
            if (hi == 0) als[ql] = alpha_; \
            asm volatile("s_waitcnt lgkmcnt(0)" ::: "memory"); \
            float al_[16]; \
            _Pragma("unroll") for (int r = 0; r < 16; ++r) al_[r] = als[crow(r, hi)]; \
            _Pragma("unroll") for (int cb = 0; cb < 4; ++cb) _Pragma("unroll") for (int r = 0; r < 16; ++r) o[cb][r] *= al_[r]; \
            _Pragma("unroll") for (int blk = 0; blk < 2; ++blk) _Pragma("unroll") for (int r = 0; r < 16; ++r) { P_[blk][r] -= dl_; PN_[blk][r] -= dl_; } \
            _Pragma("unroll") for (int r = 0; r < 16; ++r) negm[r] -= dl_; } \
        float ls0_ = 0.f, ls1_ = 0.f; \
        u32x4_t wE_, wO_;        \
        ATT_EXPC(P_, 0, 0, wE_); ATT_EXPC(P_, 0, 1, wE_); ATT_EXPC(P_, 0, 2, wE_); ATT_EXPC(P_, 0, 3, wE_); ATT_VLD(vB_, VB_, 1); \
        __builtin_amdgcn_sched_barrier(0); \
        ATT_SLOT(P_, 0, 0, wE_, vA_, wO_); ATT_SLOT(P_, 0, 1, wE_, vA_, wO_); ATT_SLOT(P_, 0, 2, wE_, vA_, wO_); ATT_SLOT(P_, 0, 3, wE_, vA_, wO_); \
        ATT_VLD(vA_, VB_, 2); \
        ATT_SLOT(P_, 1, 0, wO_, vB_, wE_); ATT_SLOT(P_, 1, 1, wO_, vB_, wE_); ATT_SLOT(P_, 1, 2, wO_, vB_, wE_); ATT_SLOT(P_, 1, 3, wO_, vB_, wE_); \
        ATT_VLD(vB_, VB_, 3); \
        ATT_SLOT(P_, 2, 0, wE_, vA_, wO_); ATT_SLOT(P_, 2, 1, wE_, vA_, wO_); ATT_SLOT(P_, 2, 2, wE_, vA_, wO_); ATT_SLOT(P_, 2, 3, wE_, vA_, wO_); \
        ATT_SLOT(P_, 3, 0, wO_, vB_, wE_); ATT_SLOT(P_, 3, 1, wO_, vB_, wE_); ATT_SLOT(P_, 3, 2, wO_, vB_, wE_); ATT_SLOT(P_, 3, 3, wO_, vB_, wE_); \
        l += ls0_ + ls1_; } while (0)
#define ATT_ITER(PC_, PN_, KT_) do { \
        { const int tk_ = (KT_) + 2 < nt ? (KT_) + 2 : nt - 1, tv_ = (KT_) + 1 < nt ? (KT_) + 1 : nt - 1;     \
          if (!(MODE & 8)) { ATT_LOADK(tk_); ATT_LOADV(tv_); } }                                                                  \
        if (!(MODE & 32)) ATT_QK(PN_, ((KT_) + 1) & 1, negm); \
        __builtin_amdgcn_sched_barrier(0); \
        ATT_SMPV(PC_, PN_, (KT_), (KT_) & 1); \
        if (!(MODE & 8)) { ATT_STOREK((KT_) & 1); ATT_STOREV(((KT_) + 1) & 1); } \
        if (!(MODE & 2)) __syncthreads(); } while (0)
    ATT_LOADK(0); ATT_LOADV(0);
    __syncthreads();
    ATT_STOREK(0); ATT_STOREV(0);
    ATT_LOADK(1);
    ATT_STOREK(1);
    __syncthreads();
    f32x16_t o[4];
#pragma unroll
    for (int cb = 0; cb < 4; ++cb) o[cb] = (f32x16_t){0.f, 0.f, 0.f, 0.f, 0.f, 0.f, 0.f, 0.f, 0.f, 0.f, 0.f, 0.f, 0.f, 0.f, 0.f, 0.f};
    float l = 0.f;
    f32x16_t pA[2], pB[2];
    f32x16_t negm;
    {
        const f32x16_t zero16 = (f32x16_t){0.f, 0.f, 0.f, 0.f, 0.f, 0.f, 0.f, 0.f, 0.f, 0.f, 0.f, 0.f, 0.f, 0.f, 0.f, 0.f};
        ATT_QK(pA, 0, zero16);
        float m0 = pA[0][0];
#pragma unroll
        for (int r = 1; r < 16; ++r) m0 = fmaxf(m0, pA[0][r]);
#pragma unroll
        for (int r = 0; r < 16; ++r) m0 = fmaxf(m0, pA[1][r]);
        m0 = fmaxf(m0, __shfl_xor(m0, 32));
#pragma unroll
        for (int r = 0; r < 16; ++r) { pA[0][r] -= m0; pA[1][r] -= m0; negm[r] = -m0; }
    }
#pragma unroll 1
    for (int kt = 0; kt < nt; kt += 2) {
        ATT_ITER(pA, pB, kt);
        ATT_ITER(pB, pA, kt + 1);
    }
#undef ATT_LOADK
#undef ATT_LOADV
#undef ATT_STOREK
#undef ATT_STOREV
#undef ATT_QK
#undef ATT_SMPV
#undef ATT_VLD
#undef ATT_EXPC
#undef ATT_SLOT
#undef ATT_ITER
    l += __shfl_xor(l, 32);
    if (hi == 0) als[ql] = 1.0f / l;
    asm volatile("s_waitcnt lgkmcnt(0)" ::: "memory");
    float il[16];
#pragma unroll
    for (int r = 0; r < 16; ++r) il[r] = als[crow(r, hi)];
    LAS float* xo = (LAS float*)(lds + AL_X) + qs * (32 * 128);
    if (map == 1) {
#pragma unroll
        for (int cb = 0; cb < 4; ++cb)
#pragma unroll
            for (int r = 0; r < 16; ++r) xo[crow(r, hi) * 128 + 32 * cb + ql] = o[cb][r] * il[r];
    }
    __syncthreads();
    if (map == 0) {
        const float lam = ctl[0];
        float ss[16];
#pragma unroll
        for (int r = 0; r < 16; ++r) ss[r] = 0.f;
#pragma unroll
        for (int cb = 0; cb < 4; ++cb)
#pragma unroll
            for (int r = 0; r < 16; ++r) { const float d = o[cb][r] * il[r] - lam * xo[crow(r, hi) * 128 + 32 * cb + ql]; o[cb][r] = d; ss[r] += d * d; }
#pragma unroll
        for (int r = 0; r < 16; ++r) {
            float s = ss[r];
            s += __shfl_xor(s, 1); s += __shfl_xor(s, 2); s += __shfl_xor(s, 4); s += __shfl_xor(s, 8); s += __shfl_xor(s, 16);
            ss[r] = rsqrtf(s * (1.f / 128) + 1e-5f) * 0.8f;
        }
#pragma unroll
        for (int cb = 0; cb < 4; ++cb) {
            const float g = subln[32 * cb + ql];
#pragma unroll
            for (int r = 0; r < 16; ++r) if (!(MODE & 1)) MIX[(rowbase + q0w + crow(r, hi)) * DM + h * 128 + 32 * cb + ql] = f2bf(o[cb][r] * ss[r] * g);
        }
    }
    __syncthreads();
}

__device__ __forceinline__ void ret_kv_unit(int tid, int bh, int n, const bf16_t* __restrict__ RVT, const bf16_t* __restrict__ RKT, float* __restrict__ KVT) {
    const int lane = tid & 63, wave = tid >> 6, rb = wave & 3, cbk = wave >> 2, ql = lane & 31, hi = lane >> 5, h = bh & 3;
    const float lg = log2f(1.0f - exp2f(-5.0f - (float)h));
    const bf16_t* ap = RVT + ((size_t)bh * 128 + 32 * rb + ql) * SEQ + 128 * n + 8 * hi;
    const bf16_t* bp = RKT + ((size_t)bh * 64 + 32 * cbk + ql) * SEQ + 128 * n + 8 * hi;
    f32x16_t acc = (f32x16_t){0.f, 0.f, 0.f, 0.f, 0.f, 0.f, 0.f, 0.f, 0.f, 0.f, 0.f, 0.f, 0.f, 0.f, 0.f, 0.f};
#pragma unroll
    for (int s = 0; s < 8; ++s) {
        const bf16x8_t a = *(const bf16x8_t*)(ap + 16 * s);
        const uint4 kw = *(const uint4*)(bp + 16 * s);
        const u32 kk[4] = {kw.x, kw.y, kw.z, kw.w};
        u32x4_t w;
        u32 ww[4];
#pragma unroll
        for (int e = 0; e < 4; ++e) {
            const int key = 16 * s + 8 * hi + 2 * e;
            const float z0 = exp2f((float)(127 - key) * lg), z1 = exp2f((float)(126 - key) * lg);
            ww[e] = pk2f(__uint_as_float(kk[e] << 16) * z0, __uint_as_float(kk[e] & 0xffff0000u) * z1);
        }
        w.x = ww[0]; w.y = ww[1]; w.z = ww[2]; w.w = ww[3];
        acc = MFMA32(a, __builtin_bit_cast(bf16x8_t, w), acc);
    }
    float* out = KVT + ((size_t)(bh * 32 + n) * 128 + 32 * rb) * 64 + 32 * cbk + ql;
#pragma unroll
    for (int r = 0; r < 16; ++r) out[crow(r, hi) * 64] = acc[r];
}
__device__ __forceinline__ void ret_scan(int e, const float* __restrict__ KVT, bf16_t* __restrict__ ST) {
    const int bh = e >> 13, idx = e & 8191, h = bh & 3;
    const float cd = exp2f(128.0f * log2f(1.0f - exp2f(-5.0f - (float)h)));
    float s = 0.f;
    for (int n = 0; n < 32; ++n) {
        ST[((size_t)(bh * 32 + n) << 13) + idx] = f2bf(s);
        s = s * cd + KVT[((size_t)(bh * 32 + n) << 13) + idx];
    }
}
constexpr int RVROW = 272;
constexpr int RL_K = 0;
constexpr int RL_V = RL_K + 128 * KROW;
constexpr int RL_S = RL_V + 128 * RVROW;
constexpr int RL_DT = RL_S + 128 * KROW;
constexpr int RL_BUF = RL_DT + 512;
constexpr int RL_SS = 2 * RL_BUF;
constexpr int RL_END = RL_SS + 4 * 2 * 32 * 4;
static_assert(RL_END <= 147456 - 256, "retention LDS map");
__device__ __forceinline__ void ret_out_units(LAS unsigned char* lds0, int tid, int u0, int ustep, int nunits, const bf16_t* __restrict__ RQ, const bf16_t* __restrict__ RK, const bf16_t* __restrict__ RVT,
                                              const bf16_t* __restrict__ ST, const bf16_t* __restrict__ RG, bf16_t* __restrict__ MIX) {
    asm volatile("" : "+v"(tid));
    const int lane = tid & 63, wave = __builtin_amdgcn_readfirstlane(tid >> 6), qs = wave & 3, dvh = wave >> 2, ql = lane & 31, hi = lane >> 5;
    u32x4_t rk[2], rv[4], rs[2];
#define RL_LOAD(U_) do { const int bh_ = (U_) >> 5, n_ = (U_) & 31; const size_t r0_ = (size_t)(bh_ >> 2) * SEQ + 128 * n_; \
        _Pragma("unroll") for (int q = 0; q < 2; ++q) { const int i_ = tid + 512 * q, key = i_ >> 3, c = i_ & 7; rk[q] = *(const u32x4_t*)(RK + (r0_ + key) * 256 + (bh_ & 3) * 64 + 8 * c); } \
        _Pragma("unroll") for (int q = 0; q < 4; ++q) { const int i_ = tid + 512 * q, dv = i_ >> 4, c = i_ & 15; rv[q] = *(const u32x4_t*)(RVT + ((size_t)bh_ * 128 + dv) * SEQ + 128 * n_ + 8 * c); } \
        _Pragma("unroll") for (int q = 0; q < 2; ++q) { const int i_ = tid + 512 * q, dv = i_ >> 3, c = i_ & 7; rs[q] = *(const u32x4_t*)(ST + ((size_t)(U_) << 13) + dv * 64 + 8 * c); } } while (0)
#define RL_STORE(L_) do { \
        _Pragma("unroll") for (int q = 0; q < 2; ++q) { const int i_ = tid + 512 * q, key = i_ >> 3, c = i_ & 7; *(LAS u32x4_t*)((L_) + RL_K + key * KROW + 16 * c) = rk[q]; } \
        _Pragma("unroll") for (int q = 0; q < 4; ++q) { const int i_ = tid + 512 * q, dv = i_ >> 4, c = i_ & 15; *(LAS u32x4_t*)((L_) + RL_V + dv * RVROW + 16 * c) = rv[q]; } \
        _Pragma("unroll") for (int q = 0; q < 2; ++q) { const int i_ = tid + 512 * q, dv = i_ >> 3, c = i_ & 7; *(LAS u32x4_t*)((L_) + RL_S + dv * KROW + 16 * c) = rs[q]; } } while (0)
    RL_LOAD(u0 < nunits ? u0 : 0);
    int it = 0;
#pragma unroll 1
  for (int u = u0; u < nunits; u += ustep, ++it) {
    LAS unsigned char* lds = lds0 + (it & 1) * RL_BUF;
    const int bh = u >> 5, n = u & 31, b = bh >> 2, h = bh & 3;
    const size_t row0 = (size_t)b * SEQ + 128 * n;
    const float lg = log2f(1.0f - exp2f(-5.0f - (float)h));
    __syncthreads();
    RL_STORE(lds);
    if (tid < 128) ((LAS float*)(lds + RL_DT))[tid] = exp2f((float)tid * lg);
    bf16x8_t qf[4];
    {
        const bf16_t* qp = RQ + (row0 + 32 * qs + ql) * 256 + h * 64 + 8 * hi;
#pragma unroll
        for (int ks = 0; ks < 4; ++ks) qf[ks] = *(const bf16x8_t*)(qp + 16 * ks);
    }
    __syncthreads();
    { const int un_ = u + ustep < nunits ? u + ustep : u; RL_LOAD(un_); }
    const LAS float* dt = (const LAS float*)(lds + RL_DT);
    f32x16_t o[2];
    o[0] = (f32x16_t){0.f, 0.f, 0.f, 0.f, 0.f, 0.f, 0.f, 0.f, 0.f, 0.f, 0.f, 0.f, 0.f, 0.f, 0.f, 0.f}; o[1] = o[0];
    const int qloc = 32 * qs + ql;
    for (int kb = 0; kb <= qs; ++kb) {
        f32x16_t p = (f32x16_t){0.f, 0.f, 0.f, 0.f, 0.f, 0.f, 0.f, 0.f, 0.f, 0.f, 0.f, 0.f, 0.f, 0.f, 0.f, 0.f};
        const LAS unsigned char* kp = lds + RL_K + (32 * kb + ql) * KROW + 16 * hi;
#pragma unroll
        for (int ks = 0; ks < 4; ++ks) { const bf16x8_t a = *(const LAS bf16x8_t*)(kp + 32 * ks); p = MFMA32(a, qf[ks], p); }
#pragma unroll
        for (int r = 0; r < 16; ++r) { const int dist = qloc - (32 * kb + crow(r, hi)); p[r] = dist < 0 ? 0.f : p[r] * dt[dist < 0 ? 0 : dist]; }
#pragma unroll
        for (int s = 0; s < 2; ++s) {
            const bf16x8_t pa = pack_p(p, s);
#pragma unroll
            for (int cbl = 0; cbl < 2; ++cbl) {
                const LAS unsigned char* vp = lds + RL_V + (64 * dvh + 32 * cbl + ql) * RVROW + (32 * kb + 16 * s) * 2 + 8 * hi;
                const u32x2_t lo = *(const LAS u32x2_t*)vp, hi2 = *(const LAS u32x2_t*)(vp + 16);
                u32x4_t w; w.x = lo.x; w.y = lo.y; w.z = hi2.x; w.w = hi2.y;
                o[cbl] = MFMA32(pa, __builtin_bit_cast(bf16x8_t, w), o[cbl]);
            }
        }
    }
    if (n > 0) {
        const float xi = exp2f((float)(qloc + 1) * lg);
#pragma unroll
        for (int ks = 0; ks < 4; ++ks) {
            u32x4_t qw = __builtin_bit_cast(u32x4_t, qf[ks]);
            u32 qq[4] = {qw.x, qw.y, qw.z, qw.w};
#pragma unroll
            for (int e = 0; e < 4; ++e) qq[e] = pk2f(__uint_as_float(qq[e] << 16) * xi, __uint_as_float(qq[e] & 0xffff0000u) * xi);
            qw.x = qq[0]; qw.y = qq[1]; qw.z = qq[2]; qw.w = qq[3];
            const bf16x8_t qx = __builtin_bit_cast(bf16x8_t, qw);
#pragma unroll
            for (int cbl = 0; cbl < 2; ++cbl) {
                const bf16x8_t bs = *(const LAS bf16x8_t*)(lds + RL_S + (64 * dvh + 32 * cbl + ql) * KROW + 32 * ks + 16 * hi);
                o[cbl] = MFMA32(qx, bs, o[cbl]);
            }
        }
    }
    float ss[16];
#pragma unroll
    for (int r = 0; r < 16; ++r) {
        float s = o[0][r] * o[0][r] + o[1][r] * o[1][r];
        s += __shfl_xor(s, 1); s += __shfl_xor(s, 2); s += __shfl_xor(s, 4); s += __shfl_xor(s, 8); s += __shfl_xor(s, 16);
        ss[r] = s;
    }
    LAS float* sx = (LAS float*)(lds0 + RL_SS);
    if (ql == 0) {
#pragma unroll
        for (int r = 0; r < 16; ++r) sx[(qs * 2 + dvh) * 32 + crow(r, hi)] = ss[r];
    }
    __syncthreads();
#pragma unroll
    for (int r = 0; r < 16; ++r) ss[r] = rsqrtf((sx[(qs * 2) * 32 + crow(r, hi)] + sx[(qs * 2 + 1) * 32 + crow(r, hi)]) * (1.f / 128) + 1e-6f);
    {
        LAS float* wt = (LAS float*)(lds + wave * 8704);
#pragma unroll
        for (int cbl = 0; cbl < 2; ++cbl)
#pragma unroll
            for (int r = 0; r < 16; ++r) wt[crow(r, hi) * 68 + 32 * cbl + ql] = o[cbl][r] * ss[r];
#pragma unroll
        for (int ps = 0; ps < 4; ++ps) {
            const int rr = 8 * ps + (lane >> 3), c8 = 8 * (lane & 7);
            const f32x4_t a0 = *(const LAS f32x4_t*)(wt + rr * 68 + c8), a1 = *(const LAS f32x4_t*)(wt + rr * 68 + c8 + 4);
            const size_t row = row0 + 32 * qs + rr; const int col = h * 128 + 64 * dvh + c8;
            const uint4 gw = *(const uint4*)(RG + row * 512 + col);
            const float w8[8] = {a0[0] * __uint_as_float(gw.x << 16), a0[1] * __uint_as_float(gw.x & 0xffff0000u), a0[2] * __uint_as_float(gw.y << 16), a0[3] * __uint_as_float(gw.y & 0xffff0000u),
                                 a1[0] * __uint_as_float(gw.z << 16), a1[1] * __uint_as_float(gw.z & 0xffff0000u), a1[2] * __uint_as_float(gw.w << 16), a1[3] * __uint_as_float(gw.w & 0xffff0000u)};
            *(uint4*)(MIX + row * DM + 512 + col) = pack8(w8);
        }
    }
  }
#undef RL_LOAD
#undef RL_STORE
}
__host__ __device__ __forceinline__ int rot_dst_row(int n) {
    if (n < 1536 || n >= 2048) return n;
    const int o = (n - 1536) & 255, base = n - o, head = o >> 6, d = o & 63, half = d >> 5, p = d & 31;
    return base + 8 * (head * 8 + (p >> 2)) + (p & 3) + 4 * half;
}
struct EpiInProjT {
    static constexpr bool PERM = true, AFTER_DRAIN = false;
    unsigned char* ws; const float* cs;
#define EPI_FOREACH(...) _Pragma("unroll") for (int ai = 0; ai < 2; ++ai) _Pragma("unroll") for (int m = 0; m < 4; ++m) { const int row = row0 + ai * 128 + m * 16; \
        _Pragma("unroll") for (int bj = 0; bj < 2; ++bj) { const int lc = lc0 + bj * 128; \
            const float v[8] = {acc[ai][bj][m][0][0], acc[ai][bj][m][0][1], acc[ai][bj][m][0][2], acc[ai][bj][m][0][3], acc[ai][bj][m][1][0], acc[ai][bj][m][1][1], acc[ai][bj][m][1][2], acc[ai][bj][m][1][3]}; __VA_ARGS__ } \
        asm volatile("" ::: "memory"); }
    __device__ __forceinline__ void operator()(const pg8::f32x4 (&acc)[2][2][4][2], const pg8::Unit& u, int wr, int wc, int fr, int fq) const {
        const int pn = __builtin_amdgcn_readfirstlane(u.pn);
        const int row0 = u.pm * 256 + wr * 64 + fr, lc0 = wc * 32 + 8 * fq;
        if (pn < 4) {
            const float sc = pn < 2 ? QSCALE : 1.f;
            bf16_t* base = (bf16_t*)(ws + (pn < 2 ? WS_Q : WS_K)) + (pn & 1) * 256;
            EPI_FOREACH({ const float w[8] = {v[0] * sc, v[1] * sc, v[2] * sc, v[3] * sc, v[4] * sc, v[5] * sc, v[6] * sc, v[7] * sc}; *(uint4*)(base + (size_t)row * 512 + lc) = pack8(w); })
        } else if (pn == 6 || pn == 7) {
            const bool isk = pn == 7; const float sc = isk ? 0.125f : 1.f;
            bf16_t* base = (bf16_t*)(ws + (isk ? WS_RK : WS_RQ));
            EPI_FOREACH({ const int j = lc >> 3, head = j >> 3, p = 4 * (j & 7), pos = row & (SEQ - 1);
                const float4 co = *(const float4*)(cs + pos * 32 + p), si = *(const float4*)(cs + 4096 * 32 + pos * 32 + p);
                uint2 a, b;
                a.x = pk2f((v[0] * co.x - v[4] * si.x) * sc, (v[1] * co.y - v[5] * si.y) * sc); a.y = pk2f((v[2] * co.z - v[6] * si.z) * sc, (v[3] * co.w - v[7] * si.w) * sc);
                b.x = pk2f((v[0] * si.x + v[4] * co.x) * sc, (v[1] * si.y + v[5] * co.y) * sc); b.y = pk2f((v[2] * si.z + v[6] * co.z) * sc, (v[3] * si.w + v[7] * co.w) * sc);
                bf16_t* dst = base + (size_t)row * 256 + head * 64 + p;
                *(uint2*)dst = a; *(uint2*)(dst + 32) = b;
                if (isk) {
                    bf16_t* kt = (bf16_t*)(ws + WS_RKT) + ((size_t)((row >> 12) * 4 + head) * 64 + p) * SEQ + pos;
                    const u32 wv[4] = {a.x, a.y, b.x, b.y};
                    _Pragma("unroll") for (int q = 0; q < 4; ++q) { *kt = (bf16_t)wv[q]; kt += SEQ; asm volatile("" : "+v"(kt)); *kt = (bf16_t)(wv[q] >> 16); kt += (q == 1 ? (size_t)29 * SEQ : (size_t)SEQ); asm volatile("" : "+v"(kt)); }
                } })
        } else if (pn >= 10) {
            bf16_t* base = (bf16_t*)(ws + WS_RG) + (pn - 10) * 256;
            EPI_FOREACH({ float w[8]; _Pragma("unroll") for (int q = 0; q < 8; ++q) w[q] = v[q] / (1.f + __expf(-v[q])); *(uint4*)(base + (size_t)row * 512 + lc) = pack8(w); })
        } else {
            bf16_t* base = (bf16_t*)(ws + (pn >= 8 ? WS_RV : WS_VV));
            const int cb = (pn & 1) * 256;
            EPI_FOREACH({ const int c = cb + lc, tp = row & (SEQ - 1), tq = pn >= 8 ? tp : ((tp & ~12) | ((tp & 4) << 1) | ((tp & 8) >> 1));
                bf16_t* vt = base + ((size_t)((row >> 12) * 4 + (c >> 7)) * 128 + (c & 127)) * SEQ + tq;
                _Pragma("unroll") for (int q = 0; q < 8; q += 2) { const u32 w = pk2f(v[q], v[q + 1]); *vt = (bf16_t)w; vt += SEQ; asm volatile("" : "+v"(vt)); *vt = (bf16_t)(w >> 16); vt += SEQ; asm volatile("" : "+v"(vt)); } })
        }
    }
#undef EPI_FOREACH
};

struct EpiOutProj {
    static constexpr bool ROWSUM = true;
    const float* x; float* H; bf16_t* HB; float* rss;
    __device__ __forceinline__ void rowsum(int row, float s) const { atomicAdd(rss + row, s); }
    __device__ __forceinline__ float row8(int row, int col, const float* v) const {
        const float4 x0 = *(const float4*)(x + (size_t)row * DM + col), x1 = *(const float4*)(x + (size_t)row * DM + col + 4);
        const float hh[8] = {x0.x + v[0], x0.y + v[1], x0.z + v[2], x0.w + v[3], x1.x + v[4], x1.y + v[5], x1.z + v[6], x1.w + v[7]};
        *(uint4*)(HB + (size_t)row * DM + col) = pack8(hh);
        float s = 0.f;
#pragma unroll
        for (int j = 0; j < 8; ++j) s += hh[j] * hh[j];
        return s;
    }
};
struct EpiQry {
    static constexpr bool ROWSUM = false;
    bf16_t* QRY; const float* rss;
    __device__ __forceinline__ void rowsum(int, float) const {}
    __device__ __forceinline__ float row8(int row, int col, const float* v) const {
        const float r = rsqrtf(rss[row] * (1.f / DM) + 1e-6f);
        const float w[8] = {v[0] * r, v[1] * r, v[2] * r, v[3] * r, v[4] * r, v[5] * r, v[6] * r, v[7] * r};
        *(uint4*)(QRY + (size_t)row * 2048 + col) = pack8(w);
        return 0.f;
    }
};
struct EpiPP {
    static constexpr bool ROWSUM = false;
    bf16_t* PP;
    __device__ __forceinline__ void rowsum(int, float) const {}
    __device__ __forceinline__ float row8(int row, int col, const float* v) const { *(uint4*)(PP + (size_t)row * DM + col) = pack8(v); return 0.f; }
};
struct EpiGate {
    static constexpr bool ROWSUM = true;
    const bf16_t* HBr; const bf16_t* PP; const float* bg; const float* rss2; float* rss3; bf16_t* H3B;
    __device__ __forceinline__ void rowsum(int row, float s) const { atomicAdd(rss3 + row, s); }
    __device__ __forceinline__ float row8(int row, int col, const float* v) const {
        const float r = rsqrtf(rss2[row] * (1.f / DM) + 1e-6f);
        const uint4 pw = *(const uint4*)(PP + (size_t)row * DM + col), hw = *(const uint4*)(HBr + (size_t)row * DM + col);
        const float4 b0 = *(const float4*)(bg + col), b1 = *(const float4*)(bg + col + 4);
        const float hv[8] = {__uint_as_float(hw.x << 16), __uint_as_float(hw.x & 0xffff0000u), __uint_as_float(hw.y << 16), __uint_as_float(hw.y & 0xffff0000u),
                             __uint_as_float(hw.z << 16), __uint_as_float(hw.z & 0xffff0000u), __uint_as_float(hw.w << 16), __uint_as_float(hw.w & 0xffff0000u)};
        const float bb[8] = {b0.x, b0.y, b0.z, b0.w, b1.x, b1.y, b1.z, b1.w};
        const float pp[8] = {__uint_as_float(pw.x << 16), __uint_as_float(pw.x & 0xffff0000u), __uint_as_float(pw.y << 16), __uint_as_float(pw.y & 0xffff0000u),
                             __uint_as_float(pw.z << 16), __uint_as_float(pw.z & 0xffff0000u), __uint_as_float(pw.w << 16), __uint_as_float(pw.w & 0xffff0000u)};
        float o[8], s = 0.f;
#pragma unroll
        for (int j = 0; j < 8; ++j) { const float g = 1.f / (1.f + __expf(-(v[j] * r + bb[j]))); o[j] = hv[j] + g * pp[j]; s += o[j] * o[j]; }
        *(uint4*)(H3B + (size_t)row * DM + col) = pack8(o);
        return s;
    }
};

__device__ __forceinline__ void b_peer_topk(int tok, int tid, char* sm, const bf16_t* __restrict__ QRY, const bf16_t* __restrict__ SUBK, int* __restrict__ IDX, float* __restrict__ GATE) {
    float* q = (float*)sm; float* sc = q + 2048; float (*tv)[16] = (float (*)[16])(sc + 2048); int (*ti)[16] = (int (*)[16])(sc + 2048 + 256);
    __syncthreads();
    for (int i = tid; i < 2048; i += 256) q[i] = bf2f(QRY[(size_t)tok * 2048 + i]);
    __syncthreads();
    for (int s = tid; s < 2048; s += 256) {
        const int hc = s >> 7;
        const bf16_t* kr = SUBK + (size_t)s * 128; const float* qq = q + hc * 128;
        float a = 0.f;
        for (int d = 0; d < 128; ++d) a += qq[d] * bf2f(kr[d]);
        sc[s] = a;
    }
    __syncthreads();
    if (tid < 16) {
        float* s = sc + tid * 128;
        for (int r = 0; r < 16; ++r) {
            float best = -INFINITY; int bi = 0;
            for (int k = 0; k < 128; ++k) { const float x = s[k]; if (x > best) { best = x; bi = k; } }
            tv[tid][r] = best; ti[tid][r] = bi; s[bi] = -INFINITY;
        }
    }
    __syncthreads();
    if (tid < 8) {
        const int h = tid;
        unsigned used[8] = {0, 0, 0, 0, 0, 0, 0, 0};
        float ts[16]; int te[16];
        for (int r = 0; r < 16; ++r) {
            float best = -INFINITY; int bc = 0;
            for (int c = 0; c < 256; ++c) {
                if (used[c >> 5] & (1u << (c & 31))) continue;
                const float x = tv[2 * h][c >> 4] + tv[2 * h + 1][c & 15];
                if (x > best) { best = x; bc = c; }
            }
            used[bc >> 5] |= 1u << (bc & 31);
            ts[r] = best; te[r] = ti[2 * h][bc >> 4] * 128 + ti[2 * h + 1][bc & 15];
        }
        float mx = ts[0], sum = 0.f;
        for (int r = 0; r < 16; ++r) { ts[r] = __expf(ts[r] - mx); sum += ts[r]; }
        for (int r = 0; r < 16; ++r) { IDX[(size_t)tok * 128 + h * 16 + r] = te[r]; GATE[(size_t)tok * 128 + h * 16 + r] = ts[r] / sum; }
    }
}
__device__ __forceinline__ void b_peer_gather(int tok, int tid, char* sm, const bf16_t* __restrict__ U, const bf16_t* __restrict__ Vt, const int* __restrict__ IDX, const float* __restrict__ GATE,
                                                     float* __restrict__ H, bf16_t* __restrict__ HB, const float* __restrict__ rss1, float* __restrict__ rss2) {
    float* hrow = (float*)sm; float* a = hrow + 1024; int* ex = (int*)(a + 128); float* red = (float*)(ex + 128);
    const int lane = tid & 63, wid = (tid >> 6) & 3;
    __syncthreads();
    for (int i = tid; i < 1024; i += 256) hrow[i] = bf2f(HB[(size_t)tok * DM + i]);
    if (tid < 128) ex[tid] = IDX[(size_t)tok * 128 + tid];
    __syncthreads();
    const float r1 = rsqrtf(rss1[tok] * (1.f / DM) + 1e-6f);
    for (int e = wid * 32; e < wid * 32 + 32; ++e) {
        const bf16_t* ur = U + (size_t)ex[e] * DM + lane * 16;
        float d = 0.f;
#pragma unroll
        for (int j = 0; j < 16; ++j) d += bf2f(ur[j]) * hrow[lane * 16 + j];
        d = wave_sum(d);
        if (lane == 0) { const float z = d * r1; a[e] = 0.5f * z * (1.f + erff(z * 0.70710678118654752f)) * GATE[(size_t)tok * 128 + e]; }
    }
    __syncthreads();
    float acc[4] = {0.f, 0.f, 0.f, 0.f};
    for (int e = 0; e < 128; ++e) {
        const ushort4 v = *(const ushort4*)(Vt + (size_t)ex[e] * DM + tid * 4);
        const float ae = a[e];
        acc[0] += ae * bf2f(v.x); acc[1] += ae * bf2f(v.y); acc[2] += ae * bf2f(v.z); acc[3] += ae * bf2f(v.w);
    }
    float4 hv = *(float4*)(H + (size_t)tok * DM + tid * 4);
    hv.x += acc[0]; hv.y += acc[1]; hv.z += acc[2]; hv.w += acc[3];
    *(float4*)(H + (size_t)tok * DM + tid * 4) = hv;
    ushort4 o; o.x = f2bf(hv.x); o.y = f2bf(hv.y); o.z = f2bf(hv.z); o.w = f2bf(hv.w);
    __syncthreads();
    *(ushort4*)(HB + (size_t)tok * DM + tid * 4) = o;
    float s = hv.x * hv.x + hv.y * hv.y + hv.z * hv.z + hv.w * hv.w;
    s = wave_sum(s);
    if (lane == 0) red[wid] = s;
    __syncthreads();
    if (tid == 0) rss2[tok] = red[0] + red[1] + red[2] + red[3];
}
__device__ __forceinline__ void b_final(size_t i, const bf16_t* __restrict__ H3B, float* __restrict__ OUT, const float* __restrict__ rss3, const float* __restrict__ gain) {
    const int row = (int)(i >> 7), c = (int)(i & 127) * 8;
    const float r = rsqrtf(rss3[row] * (1.f / DM) + 1e-6f);
    const uint4 w = ((const uint4*)H3B)[i]; const float4 g0 = *(const float4*)(gain + c), g1 = *(const float4*)(gain + c + 4);
    float4 a, b2;
    a.x = __uint_as_float(w.x << 16) * r * g0.x; a.y = __uint_as_float(w.x & 0xffff0000u) * r * g0.y; a.z = __uint_as_float(w.y << 16) * r * g0.z; a.w = __uint_as_float(w.y & 0xffff0000u) * r * g0.w;
    b2.x = __uint_as_float(w.z << 16) * r * g1.x; b2.y = __uint_as_float(w.z & 0xffff0000u) * r * g1.y; b2.z = __uint_as_float(w.w << 16) * r * g1.z; b2.w = __uint_as_float(w.w & 0xffff0000u) * r * g1.w;
    ((float4*)OUT)[2 * i] = a; ((float4*)OUT)[2 * i + 1] = b2;
}

__device__ __forceinline__ u32 f2ord(float x) { const u32 u = __float_as_uint(x); return (u & 0x80000000u) ? ~u : (u | 0x80000000u); }
__device__ __forceinline__ float ord2f(u32 o) { const u32 u = (o & 0x80000000u) ? (o & 0x7fffffffu) : ~o; return __uint_as_float(u); }
__device__ __forceinline__ u32 umax3(u32 a, u32 b, u32 c) { return max(max(a, b), c); }
#define CE_(a_, b_) do { const u32 hi_ = max(a_, b_), lo_ = min(a_, b_); a_ = hi_; b_ = lo_; } while (0)
#define TOPK_NET() do { CE_(k[0], k[13]); CE_(k[1], k[12]); CE_(k[2], k[15]); CE_(k[3], k[14]); CE_(k[4], k[8]); CE_(k[5], k[6]); CE_(k[7], k[11]); CE_(k[9], k[10]); CE_(k[16], k[29]); CE_(k[17], k[28]); CE_(k[18], k[31]); CE_(k[19], k[30]); CE_(k[20], k[24]); CE_(k[21], k[22]); CE_(k[23], k[27]); CE_(k[25], k[26]); CE_(k[32], k[45]); CE_(k[33], k[44]); CE_(k[34], k[47]); CE_(k[35], k[46]); CE_(k[36], k[40]); CE_(k[37], k[38]); CE_(k[39], k[43]); CE_(k[41], k[42]); CE_(k[48], k[61]); CE_(k[49], k[60]); CE_(k[50], k[63]); CE_(k[51], k[62]); CE_(k[52], k[56]); CE_(k[53], k[54]); CE_(k[55], k[59]); CE_(k[57], k[58]); CE_(k[0], k[5]); CE_(k[1], k[7]); CE_(k[2], k[9]); CE_(k[3], k[4]); CE_(k[6], k[13]); CE_(k[8], k[14]); CE_(k[10], k[15]); CE_(k[11], k[12]); CE_(k[16], k[21]); CE_(k[17], k[23]); CE_(k[18], k[25]); CE_(k[19], k[20]); CE_(k[22], k[29]); CE_(k[24], k[30]); CE_(k[26], k[31]); CE_(k[27], k[28]); CE_(k[32], k[37]); CE_(k[33], k[39]); CE_(k[34], k[41]); CE_(k[35], k[36]); CE_(k[38], k[45]); CE_(k[40], k[46]); CE_(k[42], k[47]); CE_(k[43], k[44]); CE_(k[48], k[53]); CE_(k[49], k[55]); CE_(k[50], k[57]); CE_(k[51], k[52]); CE_(k[54], k[61]); CE_(k[56], k[62]); CE_(k[58], k[63]); CE_(k[59], k[60]); CE_(k[0], k[1]); CE_(k[2], k[3]); CE_(k[4], k[5]); CE_(k[6], k[8]); CE_(k[7], k[9]); CE_(k[10], k[11]); CE_(k[12], k[13]); CE_(k[14], k[15]); CE_(k[16], k[17]); CE_(k[18], k[19]); CE_(k[20], k[21]); CE_(k[22], k[24]); CE_(k[23], k[25]); CE_(k[26], k[27]); CE_(k[28], k[29]); CE_(k[30], k[31]); CE_(k[32], k[33]); CE_(k[34], k[35]); CE_(k[36], k[37]); CE_(k[38], k[40]); CE_(k[39], k[41]); CE_(k[42], k[43]); CE_(k[44], k[45]); CE_(k[46], k[47]); CE_(k[48], k[49]); CE_(k[50], k[51]); CE_(k[52], k[53]); CE_(k[54], k[56]); CE_(k[55], k[57]); CE_(k[58], k[59]); CE_(k[60], k[61]); CE_(k[62], k[63]); CE_(k[0], k[2]); CE_(k[1], k[3]); CE_(k[4], k[10]); CE_(k[5], k[11]); CE_(k[6], k[7]); CE_(k[8], k[9]); CE_(k[12], k[14]); CE_(k[13], k[15]); CE_(k[16], k[18]); CE_(k[17], k[19]); CE_(k[20], k[26]); CE_(k[21], k[27]); CE_(k[22], k[23]); CE_(k[24], k[25]); CE_(k[28], k[30]); CE_(k[29], k[31]); CE_(k[32], k[34]); CE_(k[33], k[35]); CE_(k[36], k[42]); CE_(k[37], k[43]); CE_(k[38], k[39]); CE_(k[40], k[41]); CE_(k[44], k[46]); CE_(k[45], k[47]); CE_(k[48], k[50]); CE_(k[49], k[51]); CE_(k[52], k[58]); CE_(k[53], k[59]); CE_(k[54], k[55]); CE_(k[56], k[57]); CE_(k[60], k[62]); CE_(k[61], k[63]); CE_(k[1], k[2]); CE_(k[3], k[12]); CE_(k[4], k[6]); CE_(k[5], k[7]); CE_(k[8], k[10]); CE_(k[9], k[11]); CE_(k[13], k[14]); CE_(k[17], k[18]); CE_(k[19], k[28]); CE_(k[20], k[22]); CE_(k[21], k[23]); CE_(k[24], k[26]); CE_(k[25], k[27]); CE_(k[29], k[30]); CE_(k[33], k[34]); CE_(k[35], k[44]); CE_(k[36], k[38]); CE_(k[37], k[39]); CE_(k[40], k[42]); CE_(k[41], k[43]); CE_(k[45], k[46]); CE_(k[49], k[50]); CE_(k[51], k[60]); CE_(k[52], k[54]); CE_(k[53], k[55]); CE_(k[56], k[58]); CE_(k[57], k[59]); CE_(k[61], k[62]); CE_(k[1], k[4]); CE_(k[2], k[6]); CE_(k[5], k[8]); CE_(k[7], k[10]); CE_(k[9], k[13]); CE_(k[11], k[14]); CE_(k[17], k[20]); CE_(k[18], k[22]); CE_(k[21], k[24]); CE_(k[23], k[26]); CE_(k[25], k[29]); CE_(k[27], k[30]); CE_(k[33], k[36]); CE_(k[34], k[38]); CE_(k[37], k[40]); CE_(k[39], k[42]); CE_(k[41], k[45]); CE_(k[43], k[46]); CE_(k[49], k[52]); CE_(k[50], k[54]); CE_(k[53], k[56]); CE_(k[55], k[58]); CE_(k[57], k[61]); CE_(k[59], k[62]); CE_(k[2], k[4]); CE_(k[3], k[6]); CE_(k[9], k[12]); CE_(k[11], k[13]); CE_(k[18], k[20]); CE_(k[19], k[22]); CE_(k[25], k[28]); CE_(k[27], k[29]); CE_(k[34], k[36]); CE_(k[35], k[38]); CE_(k[41], k[44]); CE_(k[43], k[45]); CE_(k[50], k[52]); CE_(k[51], k[54]); CE_(k[57], k[60]); CE_(k[59], k[61]); CE_(k[3], k[5]); CE_(k[6], k[8]); CE_(k[7], k[9]); CE_(k[10], k[12]); CE_(k[19], k[21]); CE_(k[22], k[24]); CE_(k[23], k[25]); CE_(k[26], k[28]); CE_(k[35], k[37]); CE_(k[38], k[40]); CE_(k[39], k[41]); CE_(k[42], k[44]); CE_(k[51], k[53]); CE_(k[54], k[56]); CE_(k[55], k[57]); CE_(k[58], k[60]); CE_(k[3], k[4]); CE_(k[5], k[6]); CE_(k[7], k[8]); CE_(k[9], k[10]); CE_(k[11], k[12]); CE_(k[19], k[20]); CE_(k[21], k[22]); CE_(k[23], k[24]); CE_(k[25], k[26]); CE_(k[27], k[28]); CE_(k[35], k[36]); CE_(k[37], k[38]); CE_(k[39], k[40]); CE_(k[41], k[42]); CE_(k[43], k[44]); CE_(k[51], k[52]); CE_(k[53], k[54]); CE_(k[55], k[56]); CE_(k[57], k[58]); CE_(k[59], k[60]); CE_(k[6], k[7]); CE_(k[8], k[9]); CE_(k[22], k[23]); CE_(k[24], k[25]); CE_(k[38], k[39]); CE_(k[40], k[41]); CE_(k[54], k[55]); CE_(k[56], k[57]); k[0] = max(k[0], k[31]); k[1] = max(k[1], k[30]); k[2] = max(k[2], k[29]); k[3] = max(k[3], k[28]); k[4] = max(k[4], k[27]); k[5] = max(k[5], k[26]); k[6] = max(k[6], k[25]); k[7] = max(k[7], k[24]); k[8] = max(k[8], k[23]); k[9] = max(k[9], k[22]); k[10] = max(k[10], k[21]); k[11] = max(k[11], k[20]); k[12] = max(k[12], k[19]); k[13] = max(k[13], k[18]); k[14] = max(k[14], k[17]); k[15] = max(k[15], k[16]); CE_(k[0], k[8]); CE_(k[1], k[9]); CE_(k[2], k[10]); CE_(k[3], k[11]); CE_(k[4], k[12]); CE_(k[5], k[13]); CE_(k[6], k[14]); CE_(k[7], k[15]); CE_(k[0], k[4]); CE_(k[1], k[5]); CE_(k[2], k[6]); CE_(k[3], k[7]); CE_(k[8], k[12]); CE_(k[9], k[13]); CE_(k[10], k[14]); CE_(k[11], k[15]); CE_(k[0], k[2]); CE_(k[1], k[3]); CE_(k[4], k[6]); CE_(k[5], k[7]); CE_(k[8], k[10]); CE_(k[9], k[11]); CE_(k[12], k[14]); CE_(k[13], k[15]); CE_(k[0], k[1]); CE_(k[2], k[3]); CE_(k[4], k[5]); CE_(k[6], k[7]); CE_(k[8], k[9]); CE_(k[10], k[11]); CE_(k[12], k[13]); CE_(k[14], k[15]); k[32] = max(k[32], k[63]); k[33] = max(k[33], k[62]); k[34] = max(k[34], k[61]); k[35] = max(k[35], k[60]); k[36] = max(k[36], k[59]); k[37] = max(k[37], k[58]); k[38] = max(k[38], k[57]); k[39] = max(k[39], k[56]); k[40] = max(k[40], k[55]); k[41] = max(k[41], k[54]); k[42] = max(k[42], k[53]); k[43] = max(k[43], k[52]); k[44] = max(k[44], k[51]); k[45] = max(k[45], k[50]); k[46] = max(k[46], k[49]); k[47] = max(k[47], k[48]); CE_(k[32], k[40]); CE_(k[33], k[41]); CE_(k[34], k[42]); CE_(k[35], k[43]); CE_(k[36], k[44]); CE_(k[37], k[45]); CE_(k[38], k[46]); CE_(k[39], k[47]); CE_(k[32], k[36]); CE_(k[33], k[37]); CE_(k[34], k[38]); CE_(k[35], k[39]); CE_(k[40], k[44]); CE_(k[41], k[45]); CE_(k[42], k[46]); CE_(k[43], k[47]); CE_(k[32], k[34]); CE_(k[33], k[35]); CE_(k[36], k[38]); CE_(k[37], k[39]); CE_(k[40], k[42]); CE_(k[41], k[43]); CE_(k[44], k[46]); CE_(k[45], k[47]); CE_(k[32], k[33]); CE_(k[34], k[35]); CE_(k[36], k[37]); CE_(k[38], k[39]); CE_(k[40], k[41]); CE_(k[42], k[43]); CE_(k[44], k[45]); CE_(k[46], k[47]); k[0] = max(k[0], k[47]); k[1] = max(k[1], k[46]); k[2] = max(k[2], k[45]); k[3] = max(k[3], k[44]); k[4] = max(k[4], k[43]); k[5] = max(k[5], k[42]); k[6] = max(k[6], k[41]); k[7] = max(k[7], k[40]); k[8] = max(k[8], k[39]); k[9] = max(k[9], k[38]); k[10] = max(k[10], k[37]); k[11] = max(k[11], k[36]); k[12] = max(k[12], k[35]); k[13] = max(k[13], k[34]); k[14] = max(k[14], k[33]); k[15] = max(k[15], k[32]); CE_(k[0], k[8]); CE_(k[1], k[9]); CE_(k[2], k[10]); CE_(k[3], k[11]); CE_(k[4], k[12]); CE_(k[5], k[13]); CE_(k[6], k[14]); CE_(k[7], k[15]); CE_(k[0], k[4]); CE_(k[1], k[5]); CE_(k[2], k[6]); CE_(k[3], k[7]); CE_(k[8], k[12]); CE_(k[9], k[13]); CE_(k[10], k[14]); CE_(k[11], k[15]); CE_(k[0], k[2]); CE_(k[1], k[3]); CE_(k[4], k[6]); CE_(k[5], k[7]); CE_(k[8], k[10]); CE_(k[9], k[11]); CE_(k[12], k[14]); CE_(k[13], k[15]); CE_(k[0], k[1]); CE_(k[2], k[3]); CE_(k[4], k[5]); CE_(k[6], k[7]); CE_(k[8], k[9]); CE_(k[10], k[11]); CE_(k[12], k[13]); CE_(k[14], k[15]); } while (0)
#define TOPK_XMERGE(T_) do { u32 pp_[16]; _Pragma("unroll") for (int i_ = 0; i_ < 16; ++i_) pp_[i_] = (u32)__shfl_xor((int)k[i_], 32); T_[0] = max(k[0], pp_[15]); T_[1] = max(k[1], pp_[14]); T_[2] = max(k[2], pp_[13]); T_[3] = max(k[3], pp_[12]); T_[4] = max(k[4], pp_[11]); T_[5] = max(k[5], pp_[10]); T_[6] = max(k[6], pp_[9]); T_[7] = max(k[7], pp_[8]); T_[8] = max(k[8], pp_[7]); T_[9] = max(k[9], pp_[6]); T_[10] = max(k[10], pp_[5]); T_[11] = max(k[11], pp_[4]); T_[12] = max(k[12], pp_[3]); T_[13] = max(k[13], pp_[2]); T_[14] = max(k[14], pp_[1]); T_[15] = max(k[15], pp_[0]); CE_(T_[0], T_[8]); CE_(T_[1], T_[9]); CE_(T_[2], T_[10]); CE_(T_[3], T_[11]); CE_(T_[4], T_[12]); CE_(T_[5], T_[13]); CE_(T_[6], T_[14]); CE_(T_[7], T_[15]); CE_(T_[0], T_[4]); CE_(T_[1], T_[5]); CE_(T_[2], T_[6]); CE_(T_[3], T_[7]); CE_(T_[8], T_[12]); CE_(T_[9], T_[13]); CE_(T_[10], T_[14]); CE_(T_[11], T_[15]); CE_(T_[0], T_[2]); CE_(T_[1], T_[3]); CE_(T_[4], T_[6]); CE_(T_[5], T_[7]); CE_(T_[8], T_[10]); CE_(T_[9], T_[11]); CE_(T_[12], T_[14]); CE_(T_[13], T_[15]); CE_(T_[0], T_[1]); CE_(T_[2], T_[3]); CE_(T_[4], T_[5]); CE_(T_[6], T_[7]); CE_(T_[8], T_[9]); CE_(T_[10], T_[11]); CE_(T_[12], T_[13]); CE_(T_[14], T_[15]); } while (0)
constexpr int SKROW = 272;
__device__ __forceinline__ void peer_topk_unit(int lane, int tok0, int tokn, int head, const bf16_t* __restrict__ QRY, bf16x8_t (&qf)[8], const LAS unsigned char* sk, LAS unsigned char* tl, int* __restrict__ IDX, float* __restrict__ GATE) {
    const int ql = lane & 31, hi = lane >> 5;
    bool bad = false; (void)bad;
    u32 top[2][16];
#pragma unroll
    for (int c = 0; c < 2; ++c) {
        const LAS unsigned char* kp = sk + (c * 128 + ql) * SKROW + 16 * hi;
        f32x16_t sc[4];
#pragma unroll
        for (int kb = 0; kb < 4; ++kb) sc[kb] = (f32x16_t){0.f, 0.f, 0.f, 0.f, 0.f, 0.f, 0.f, 0.f, 0.f, 0.f, 0.f, 0.f, 0.f, 0.f, 0.f, 0.f};
#pragma unroll
        for (int ks = 0; ks < 8; ++ks) {
#pragma unroll
            for (int kb = 0; kb < 4; ++kb) { const bf16x8_t a = *(const LAS bf16x8_t*)(kp + kb * 32 * SKROW + 32 * ks); sc[kb] = MFMA32(a, qf[ks], sc[kb]); }
        }
        {
            const bf16_t* qn = QRY + (size_t)((c == 0 ? tok0 : tokn) + ql) * 2048 + head * 256 + (c == 0 ? 128 : 0) + 8 * hi;
#pragma unroll
            for (int ks = 0; ks < 8; ++ks) qf[ks] = *(const bf16x8_t*)(qn + 16 * ks);
        }
        u32 k[64];
#pragma unroll
        for (int kb = 0; kb < 4; ++kb)
#pragma unroll
            for (int r = 0; r < 16; ++r) k[kb * 16 + r] = (f2ord(sc[kb][r]) & ~127u) | (u32)(127 - (32 * kb + crow(r, hi)));
#ifdef PROBE_TOPK_CHECK
        u32 k2[64];
#pragma unroll
        for (int i = 0; i < 64; ++i) k2[i] = k[i];
        u32 told[16];
#pragma unroll
        for (int rd = 0; rd < 16; ++rd) {
            u32 b = umax3(k2[0], k2[1], k2[2]);
#pragma unroll
            for (int i = 3; i + 1 < 64; i += 2) b = umax3(b, k2[i], k2[i + 1]);
            b = max(b, k2[63]);
            const u32 g = max(b, (u32)__shfl_xor((int)b, 32));
            told[rd] = g;
#pragma unroll
            for (int i = 0; i < 64; ++i) k2[i] = (k2[i] == g) ? 0u : k2[i];
        }
#endif
        TOPK_NET();
        TOPK_XMERGE(top[c]);
#ifdef PROBE_TOPK_CHECK
#pragma unroll
        for (int rd = 0; rd < 16; ++rd) bad |= (told[rd] != top[c][rd]);
#endif
    }
    float va[16], vb[16];
#pragma unroll
    for (int i = 0; i < 16; ++i) { va[i] = ord2f(top[0][i] & ~127u); vb[i] = ord2f(top[1][i] & ~127u); }
    LAS u32* tlr = (LAS u32*)(tl + ql * 144);
    {
        u32 w_[16];
#pragma unroll
        for (int i = 0; i < 16; ++i) w_[i] = hi ? top[1][i] : top[0][i];
#pragma unroll
        for (int q = 0; q < 4; ++q) { u32x4_t t4; t4.x = w_[4 * q]; t4.y = w_[4 * q + 1]; t4.z = w_[4 * q + 2]; t4.w = w_[4 * q + 3]; *(LAS u32x4_t*)(tlr + 16 * hi + 4 * q) = t4; }
    }
    float sv[16]; u32 oe[8];
    {
        u32 k[64];
#pragma unroll
        for (int t = 0; t < 25; ++t) {
            constexpr int CI[50] = {0, 0, 0, 0, 0, 0, 0, 0, 0, 0, 0, 0, 0, 0, 0, 0, 1, 1, 1, 1, 1, 1, 1, 1, 2, 2, 2, 2, 2, 3, 3, 3, 3, 4, 4, 4, 5, 5, 6, 6, 7, 7, 8, 9, 10, 11, 12, 13, 14, 15};
            constexpr int CJ[50] = {0, 1, 2, 3, 4, 5, 6, 7, 8, 9, 10, 11, 12, 13, 14, 15, 0, 1, 2, 3, 4, 5, 6, 7, 0, 1, 2, 3, 4, 0, 1, 2, 3, 0, 1, 2, 0, 1, 0, 1, 0, 1, 0, 0, 0, 0, 0, 0, 0, 0};
            const int i0 = CI[2 * t], j0 = CJ[2 * t], i1 = CI[2 * t + 1], j1 = CJ[2 * t + 1];
            const u32 key0 = (f2ord(va[i0] + vb[j0]) & ~255u) | (u32)(255 - (i0 * 16 + j0)), key1 = (f2ord(va[i1] + vb[j1]) & ~255u) | (u32)(255 - (i1 * 16 + j1));
            k[t] = hi ? key1 : key0;
        }
#pragma unroll
        for (int t = 25; t < 64; ++t) k[t] = 0u;
        TOPK_NET();
        u32 g[16];
        TOPK_XMERGE(g);
#pragma unroll
        for (int rd = 0; rd < 16; ++rd) sv[rd] = ord2f(g[rd] & ~255u);
#pragma unroll
        for (int q = 0; q < 8; ++q) {
            const u32 key = hi ? g[8 + q] : g[q], ci = 255u - (key & 255u);
            const u32 e1 = 127u - (tlr[ci >> 4] & 127u), e2 = 127u - (tlr[16 + (ci & 15u)] & 127u);
            oe[q] = e1 * 128u + e2;
        }
    }
    const float mx = sv[0]; float sum = 0.f;
#pragma unroll
    for (int rd = 0; rd < 16; ++rd) { sv[rd] = __expf(sv[rd] - mx); sum += sv[rd]; }
    const float inv = 1.0f / sum;
    float og[8];
#pragma unroll
    for (int q = 0; q < 8; ++q) og[q] = (hi ? sv[8 + q] : sv[q]) * inv;
    const size_t o = (size_t)(tok0 + ql) * 128 + head * 16 + 8 * hi;
    *(uint4*)(IDX + o) = make_uint4(oe[0], oe[1], oe[2], oe[3]); *(uint4*)(IDX + o + 4) = make_uint4(oe[4], oe[5], oe[6], oe[7]);
#ifdef PROBE_TOPK_CHECK
    if (bad) { og[0] = __builtin_nanf(""); }
#endif
    *(float4*)(GATE + o) = make_float4(og[0], og[1], og[2], og[3]); *(float4*)(GATE + o + 4) = make_float4(og[4], og[5], og[6], og[7]);
}

#define MFMA16(a, b, c) __builtin_amdgcn_mfma_f32_16x16x32_bf16((a), (b), (c), 0, 0, 0)
__device__ __forceinline__ void peer_token(int lane, int tok, const bf16_t* __restrict__ U, const bf16_t* __restrict__ Vt, const int* __restrict__ IDX, const float* __restrict__ GATE,
                                           float* __restrict__ H, bf16_t* __restrict__ HB, const float* __restrict__ rss1, float* __restrict__ rss2, const bool wr = true) {
    const int r = lane & 15, kq = lane >> 4;
    int ev[8];
#pragma unroll
    for (int g = 0; g < 8; ++g) ev[g] = IDX[(size_t)tok * 128 + 16 * g + r];
    const float r1 = rsqrtf(rss1[tok] * (1.f / DM) + 1e-6f);
    const bf16_t* hrow = HB + (size_t)tok * DM + 8 * kq;
    f32x4_t acc[8];
#pragma unroll
    for (int g = 0; g < 8; ++g) acc[g] = (f32x4_t){0.f, 0.f, 0.f, 0.f};
    const char* ub = (const char*)U + 16 * kq;
#pragma unroll 4
    for (int ks = 0; ks < 32; ++ks) {
        const bf16x8_t bfr = *(const bf16x8_t*)(hrow + 32 * ks);
#pragma unroll
        for (int g = 0; g < 8; ++g) { const bf16x8_t a = *(const bf16x8_t*)(ub + (size_t)(unsigned)ev[g] * 2048u + 64 * ks); acc[g] = MFMA16(a, bfr, acc[g]); }
    }
#pragma unroll
    for (int g = 0; g < 8; ++g) {
        const float4 gt = *(const float4*)(GATE + (size_t)tok * 128 + 16 * g + 4 * kq);
        const float gg[4] = {gt.x, gt.y, gt.z, gt.w};
#pragma unroll
        for (int i = 0; i < 4; ++i) { const float z = acc[g][i] * r1; acc[g][i] = 0.5f * z * (1.f + erff(z * 0.70710678118654752f)) * gg[i]; }
    }
    float o[16];
#pragma unroll
    for (int j = 0; j < 16; ++j) o[j] = 0.f;
    const char* vb = (const char*)Vt + 16 * lane;
#pragma unroll
    for (int g = 0; g < 8; ++g) {
#pragma unroll
        for (int rr = 0; rr < 16; rr += 4) {
            u32x4_t w0[4], w1[4]; float ae[4];
#pragma unroll
            for (int q = 0; q < 4; ++q) {
                const int e = __builtin_amdgcn_readlane(ev[g], rr + q);
                ae[q] = __int_as_float(__builtin_amdgcn_readlane(__float_as_int(acc[g][(rr + q) & 3]), 16 * ((rr + q) >> 2)));
                const char* vp = vb + (size_t)(unsigned)e * 2048u;
                w0[q] = *(const u32x4_t*)vp; w1[q] = *(const u32x4_t*)(vp + 1024);
            }
#pragma unroll
            for (int q = 0; q < 4; ++q) {
                const float a = ae[q];
                const u32 ww[8] = {w0[q].x, w0[q].y, w0[q].z, w0[q].w, w1[q].x, w1[q].y, w1[q].z, w1[q].w};
#pragma unroll
                for (int j = 0; j < 8; ++j) { o[2 * j] = fmaf(a, __uint_as_float(ww[j] << 16), o[2 * j]); o[2 * j + 1] = fmaf(a, __uint_as_float(ww[j] & 0xffff0000u), o[2 * j + 1]); }
            }
        }
    }
    float* hp = H + (size_t)tok * DM + 8 * lane;
    float4 h0 = *(float4*)hp, h1 = *(float4*)(hp + 4), h2 = *(float4*)(hp + 512), h3 = *(float4*)(hp + 516);
    h0.x += o[0]; h0.y += o[1]; h0.z += o[2]; h0.w += o[3]; h1.x += o[4]; h1.y += o[5]; h1.z += o[6]; h1.w += o[7];
    h2.x += o[8]; h2.y += o[9]; h2.z += o[10]; h2.w += o[11]; h3.x += o[12]; h3.y += o[13]; h3.z += o[14]; h3.w += o[15];
    if (wr) { *(float4*)hp = h0; *(float4*)(hp + 4) = h1; *(float4*)(hp + 512) = h2; *(float4*)(hp + 516) = h3; }
    const float wa[8] = {h0.x, h0.y, h0.z, h0.w, h1.x, h1.y, h1.z, h1.w}, wb[8] = {h2.x, h2.y, h2.z, h2.w, h3.x, h3.y, h3.z, h3.w};
    bf16_t* hb = HB + (size_t)tok * DM + 8 * lane;
    float s = 0.f;
#pragma unroll
    for (int j = 0; j < 8; ++j) s += wa[j] * wa[j] + wb[j] * wb[j];
    s = wave_sum(s);
    if (wr) { *(uint4*)hb = pack8(wa); *(uint4*)(hb + 512) = pack8(wb); }
    if (lane == 0) { if (wr) rss2[tok] = s; else if (s == 123.456f) rss2[tok] = s; }
}
__device__ __forceinline__ void b_rowquant(int row, int lane, const float* __restrict__ src, const float* __restrict__ gain, unsigned char* __restrict__ dst8, float* __restrict__ scale) {
    const float4* sp = (const float4*)(src + (size_t)row * DM + 16 * lane);
    float v[16];
#pragma unroll
    for (int j = 0; j < 4; ++j) { const float4 t = sp[j]; v[4 * j] = t.x; v[4 * j + 1] = t.y; v[4 * j + 2] = t.z; v[4 * j + 3] = t.w; }
    if (gain) {
#pragma unroll
        for (int j = 0; j < 16; ++j) v[j] *= gain[16 * lane + j];
    }
    float am = 0.f;
#pragma unroll
    for (int j = 0; j < 16; ++j) am = fmaxf(am, fabsf(v[j]));
    am = wave_max(am);
    const float sc = am > 0.f ? am * (1.0f / 440.0f) : 1.0f, inv = 1.0f / sc;
    int w[4];
#pragma unroll
    for (int j = 0; j < 4; ++j) { int t = 0; t = __builtin_amdgcn_cvt_pk_fp8_f32(v[4 * j] * inv, v[4 * j + 1] * inv, t, false); t = __builtin_amdgcn_cvt_pk_fp8_f32(v[4 * j + 2] * inv, v[4 * j + 3] * inv, t, true); w[j] = t; }
    *(uint4*)(dst8 + ((size_t)(lane >> 3) * NEXP + row) * 128 + 16 * (lane & 7)) = make_uint4((u32)w[0], (u32)w[1], (u32)w[2], (u32)w[3]);
    if (lane == 0) scale[row] = sc;
}
__device__ __forceinline__ float gelu_as(float v) {
    const float av = fabsf(v), t = __builtin_amdgcn_rcpf(av * 0.2316418882f + 1.0f);
    float q = t * 0.5307027145f + (-0.7265760135f); q = q * t + 0.7107068705f; q = q * t + (-0.142248368f); q = q * t + 0.127414796f; q = q * t;
    const float e = __builtin_amdgcn_exp2f((v * v) * (-0.72134752044f));
    const float m = v * (q * e);
    return v < 0.f ? m : v - m;
}
typedef float f32x2_t __attribute__((ext_vector_type(2)));
#define MFMA8(a, b, c) __builtin_amdgcn_mfma_f32_16x16x32_fp8_fp8((a), (b), (c), 0, 0, 0)
__device__ __forceinline__ void peer_token8(int lane, int tok, LAS unsigned char* wb, const unsigned char* __restrict__ U8, const unsigned char* __restrict__ V8, const float* __restrict__ SU, const float* __restrict__ SV,
                                            const int* __restrict__ IDX, const float* __restrict__ GATE, float* __restrict__ H, bf16_t* __restrict__ HB, const float* __restrict__ rss1, float* __restrict__ rss2) {
    const int r = lane & 15, kq = lane >> 4;
    int ev[8];
#pragma unroll
    for (int g = 0; g < 8; ++g) ev[g] = IDX[(size_t)tok * 128 + 16 * g + r];
    const float r1 = rsqrtf(rss1[tok] * (1.f / DM) + 1e-6f);
    float sh;
    {
        const uint4 a0 = *(const uint4*)(HB + (size_t)tok * DM + 16 * lane), a1 = *(const uint4*)(HB + (size_t)tok * DM + 16 * lane + 8);
        const u32 ww[8] = {a0.x, a0.y, a0.z, a0.w, a1.x, a1.y, a1.z, a1.w};
        float v[16]; float am = 0.f;
#pragma unroll
        for (int j = 0; j < 8; ++j) { v[2 * j] = __uint_as_float(ww[j] << 16); v[2 * j + 1] = __uint_as_float(ww[j] & 0xffff0000u); am = fmaxf(am, fmaxf(fabsf(v[2 * j]), fabsf(v[2 * j + 1]))); }
        am = wave_max(am);
        sh = am > 0.f ? am * (1.0f / 440.0f) : 1.0f;
        const float inv = 1.0f / sh;
        u32x4_t w;
        { int t = 0; t = __builtin_amdgcn_cvt_pk_fp8_f32(v[0] * inv, v[1] * inv, t, false); t = __builtin_amdgcn_cvt_pk_fp8_f32(v[2] * inv, v[3] * inv, t, true); w.x = (u32)t; }
        { int t = 0; t = __builtin_amdgcn_cvt_pk_fp8_f32(v[4] * inv, v[5] * inv, t, false); t = __builtin_amdgcn_cvt_pk_fp8_f32(v[6] * inv, v[7] * inv, t, true); w.y = (u32)t; }
        { int t = 0; t = __builtin_amdgcn_cvt_pk_fp8_f32(v[8] * inv, v[9] * inv, t, false); t = __builtin_amdgcn_cvt_pk_fp8_f32(v[10] * inv, v[11] * inv, t, true); w.z = (u32)t; }
        { int t = 0; t = __builtin_amdgcn_cvt_pk_fp8_f32(v[12] * inv, v[13] * inv, t, false); t = __builtin_amdgcn_cvt_pk_fp8_f32(v[14] * inv, v[15] * inv, t, true); w.w = (u32)t; }
        *(LAS u32x4_t*)(wb + 16 * lane) = w;
    }
    f32x4_t acc[8];
#pragma unroll
    for (int g = 0; g < 8; ++g) acc[g] = (f32x4_t){0.f, 0.f, 0.f, 0.f};
    const unsigned char* ub = U8 + 16 * kq;
#pragma unroll 2
    for (int c = 0; c < 16; ++c) {
        const u32x4_t bq = *(const LAS u32x4_t*)(wb + 64 * c + 16 * kq);
        const long b0 = (long)(((unsigned long long)bq.y << 32) | bq.x), b1 = (long)(((unsigned long long)bq.w << 32) | bq.z);
#pragma unroll
        for (int g = 0; g < 8; ++g) {
            const u32x4_t a = *(const u32x4_t*)(ub + (size_t)(unsigned)ev[g] * 1024u + 64 * c);
            const long a0 = (long)(((unsigned long long)a.y << 32) | a.x), a1 = (long)(((unsigned long long)a.w << 32) | a.z);
            acc[g] = MFMA8(a0, b0, acc[g]); acc[g] = MFMA8(a1, b1, acc[g]);
        }
    }
    const float zs = sh * r1;
#pragma unroll
    for (int g = 0; g < 8; ++g) {
        const float4 gt = *(const float4*)(GATE + (size_t)tok * 128 + 16 * g + 4 * kq);
        const int4 ei = *(const int4*)(IDX + (size_t)tok * 128 + 16 * g + 4 * kq);
        const float gg[4] = {gt.x, gt.y, gt.z, gt.w}; const int ee[4] = {ei.x, ei.y, ei.z, ei.w};
#pragma unroll
        for (int i = 0; i < 4; ++i) { const float z = acc[g][i] * zs * SU[ee[i]]; acc[g][i] = gelu_as(z) * gg[i] * SV[ee[i]]; }
    }
    float o[16];
#pragma unroll
    for (int j = 0; j < 16; ++j) o[j] = 0.f;
    const unsigned char* vb = V8 + 16 * lane;
#pragma unroll
    for (int g = 0; g < 8; ++g) {
#pragma unroll
        for (int rr = 0; rr < 16; rr += 4) {
            u32x4_t w[4]; float ae[4];
#pragma unroll
            for (int q = 0; q < 4; ++q) {
                const int e = __builtin_amdgcn_readlane(ev[g], rr + q);
                ae[q] = __int_as_float(__builtin_amdgcn_readlane(__float_as_int(acc[g][(rr + q) & 3]), 16 * ((rr + q) >> 2)));
                w[q] = *(const u32x4_t*)(vb + (size_t)(unsigned)e * 1024u);
            }
#pragma unroll
            for (int q = 0; q < 4; ++q) {
                const float a = ae[q];
                const u32 ww[4] = {w[q].x, w[q].y, w[q].z, w[q].w};
#pragma unroll
                for (int j = 0; j < 4; ++j) {
                    const f32x2_t lo = __builtin_amdgcn_cvt_pk_f32_fp8((int)ww[j], false), hi2 = __builtin_amdgcn_cvt_pk_f32_fp8((int)ww[j], true);
                    o[4 * j] = fmaf(a, lo[0], o[4 * j]); o[4 * j + 1] = fmaf(a, lo[1], o[4 * j + 1]); o[4 * j + 2] = fmaf(a, hi2[0], o[4 * j + 2]); o[4 * j + 3] = fmaf(a, hi2[1], o[4 * j + 3]);
                }
            }
        }
    }
    float* hp = H + (size_t)tok * DM + 16 * lane;
    float hv[16]; float s = 0.f;
#pragma unroll
    for (int j = 0; j < 4; ++j) { const float4 t = *(const float4*)(hp + 4 * j); hv[4 * j] = t.x + o[4 * j]; hv[4 * j + 1] = t.y + o[4 * j + 1]; hv[4 * j + 2] = t.z + o[4 * j + 2]; hv[4 * j + 3] = t.w + o[4 * j + 3]; }
#pragma unroll
    for (int j = 0; j < 4; ++j) *(float4*)(hp + 4 * j) = make_float4(hv[4 * j], hv[4 * j + 1], hv[4 * j + 2], hv[4 * j + 3]);
#pragma unroll
    for (int j = 0; j < 16; ++j) s += hv[j] * hv[j];
    s = wave_sum(s);
    bf16_t* hb = HB + (size_t)tok * DM + 16 * lane;
    *(uint4*)hb = pack8(hv); *(uint4*)(hb + 8) = pack8(hv + 8);
    if (lane == 0) rss2[tok] = s;
}
constexpr int PL_ZP = 0;
constexpr int PL_EI = 65536;
constexpr int PL_SS = 131072;
__device__ __forceinline__ void b_tokquant(int tok, int lane, const bf16_t* __restrict__ HB, unsigned char* __restrict__ HB8, float* __restrict__ SH) {
    const uint4 a0 = *(const uint4*)(HB + (size_t)tok * DM + 16 * lane), a1 = *(const uint4*)(HB + (size_t)tok * DM + 16 * lane + 8);
    const u32 ww[8] = {a0.x, a0.y, a0.z, a0.w, a1.x, a1.y, a1.z, a1.w};
    float v[16]; float am = 0.f;
#pragma unroll
    for (int j = 0; j < 8; ++j) { v[2 * j] = __uint_as_float(ww[j] << 16); v[2 * j + 1] = __uint_as_float(ww[j] & 0xffff0000u); am = fmaxf(am, fmaxf(fabsf(v[2 * j]), fabsf(v[2 * j + 1]))); }
    am = wave_max(am);
    const float sh = am > 0.f ? am * (1.0f / 440.0f) : 1.0f, inv = 1.0f / sh;
    int w[4];
#pragma unroll
    for (int j = 0; j < 4; ++j) { int t = 0; t = __builtin_amdgcn_cvt_pk_fp8_f32(v[4 * j] * inv, v[4 * j + 1] * inv, t, false); t = __builtin_amdgcn_cvt_pk_fp8_f32(v[4 * j + 2] * inv, v[4 * j + 3] * inv, t, true); w[j] = t; }
    *(uint4*)(HB8 + (size_t)tok * DM + 16 * lane) = make_uint4((u32)w[0], (u32)w[1], (u32)w[2], (u32)w[3]);
    if (lane == 0) SH[tok] = sh;
}
__device__ __forceinline__ void peer_sliced(LAS unsigned char* lds, int lane, int wave, int tok0, const unsigned char* __restrict__ U8, const unsigned char* __restrict__ V8, const float* __restrict__ SU, const float* __restrict__ SV,
                                            const unsigned char* __restrict__ HB8, const float* __restrict__ SH, const int* __restrict__ IDX, const float* __restrict__ GATE,
                                            float* __restrict__ H, bf16_t* __restrict__ HB, const float* __restrict__ rss1, float* __restrict__ rss2) {
    LAS float* zp = (LAS float*)(lds + PL_ZP) + wave * (16 * 128);
    LAS int* ei = (LAS int*)(lds + PL_EI) + wave * (16 * 128);
    LAS float* ssl = (LAS float*)(lds + PL_SS) + wave * 16;
    const int tw = tok0 + 16 * wave;
#pragma unroll
    for (int i = 0; i < 8; ++i) { const int o = i * 256 + 4 * lane; *(LAS u32x4_t*)(ei + o) = *(const u32x4_t*)(IDX + (size_t)tw * 128 + o); }
    if (lane < 16) ssl[lane] = 0.f;
    const int r = lane & 15, kq = lane >> 4;
    {
        int lane_u = lane;
#define UV_LOAD(W_, TG_, EB_) do { \
        _Pragma("unroll") for (int q = 0; q < 2; ++q) { const u32x4_t ev_ = *(const LAS u32x4_t*)(ei + (8 * (TG_) + ju) * 128 + 8 * (EB_) + 4 * q); \
            W_[4 * q] = *(const u32x4_t*)(ub_ + (ev_.x * 128u + (unsigned)(16 * du))); W_[4 * q + 1] = *(const u32x4_t*)(ub_ + (ev_.y * 128u + (unsigned)(16 * du))); \
            W_[4 * q + 2] = *(const u32x4_t*)(ub_ + (ev_.z * 128u + (unsigned)(16 * du))); W_[4 * q + 3] = *(const u32x4_t*)(ub_ + (ev_.w * 128u + (unsigned)(16 * du))); } } while (0)
#define UV_DOT(W_, TG_, EB_) do { float v_[8]; \
        _Pragma("unroll") for (int k = 0; k < 8; ++k) { const u32 ww_[4] = {W_[k].x, W_[k].y, W_[k].z, W_[k].w}; float d0_ = 0.f, d1_ = 0.f; \
            _Pragma("unroll") for (int q = 0; q < 4; ++q) { \
                const f32x2_t lo_ = __builtin_amdgcn_cvt_pk_f32_fp8((int)ww_[q], false), hi_ = __builtin_amdgcn_cvt_pk_f32_fp8((int)ww_[q], true); \
                d0_ = fmaf(lo_[0], hv[4 * q], d0_); d1_ = fmaf(lo_[1], hv[4 * q + 1], d1_); d0_ = fmaf(hi_[0], hv[4 * q + 2], d0_); d1_ = fmaf(hi_[1], hv[4 * q + 3], d1_); } \
            v_[k] = d0_ + d1_; } \
        _Pragma("unroll") for (int k = 0; k < 4; ++k) { const float snd_ = (du & 4) ? v_[k] : v_[k + 4], kp_ = (du & 4) ? v_[k + 4] : v_[k]; v_[k] = kp_ + __shfl_xor(snd_, 4); } \
        _Pragma("unroll") for (int k = 0; k < 2; ++k) { const float snd_ = (du & 2) ? v_[k] : v_[k + 2], kp_ = (du & 2) ? v_[k + 2] : v_[k]; v_[k] = kp_ + __shfl_xor(snd_, 2); } \
        { const float snd_ = (du & 1) ? v_[0] : v_[1], kp_ = (du & 1) ? v_[1] : v_[0]; v_[0] = kp_ + __shfl_xor(snd_, 1); } \
        { LAS float* zq_ = zp + (8 * (TG_) + ju) * 128 + 8 * (EB_) + du; if (s_ == 0) *zq_ = v_[0]; else *zq_ += v_[0]; } \
        asm volatile("" ::: "memory"); } while (0)
#define UV_TG(TG_) do { float hv[16]; \
            { const bf16_t* hp_ = HB + (size_t)(tw + 8 * (TG_) + ju) * DM + 128 * s_ + 16 * du;        \
              const u32x4_t hq0 = *(const u32x4_t*)hp_, hq1 = *(const u32x4_t*)(hp_ + 8); \
              const u32 hw[8] = {hq0.x, hq0.y, hq0.z, hq0.w, hq1.x, hq1.y, hq1.z, hq1.w}; \
              _Pragma("unroll") for (int q = 0; q < 8; ++q) { hv[2 * q] = __uint_as_float(hw[q] << 16); hv[2 * q + 1] = __uint_as_float(hw[q] & 0xffff0000u); } } \
            u32x4_t wA[8], wB[8]; \
            UV_LOAD(wA, TG_, 0); \
            UV_LOAD(wB, TG_, 1);  UV_DOT(wA, TG_, 0);  UV_LOAD(wA, TG_, 2);  UV_DOT(wB, TG_, 1); \
            UV_LOAD(wB, TG_, 3);  UV_DOT(wA, TG_, 2);  UV_LOAD(wA, TG_, 4);  UV_DOT(wB, TG_, 3); \
            UV_LOAD(wB, TG_, 5);  UV_DOT(wA, TG_, 4);  UV_LOAD(wA, TG_, 6);  UV_DOT(wB, TG_, 5); \
            UV_LOAD(wB, TG_, 7);  UV_DOT(wA, TG_, 6);  UV_LOAD(wA, TG_, 8);  UV_DOT(wB, TG_, 7); \
            UV_LOAD(wB, TG_, 9);  UV_DOT(wA, TG_, 8);  UV_LOAD(wA, TG_, 10); UV_DOT(wB, TG_, 9); \
            UV_LOAD(wB, TG_, 11); UV_DOT(wA, TG_, 10); UV_LOAD(wA, TG_, 12); UV_DOT(wB, TG_, 11); \
            UV_LOAD(wB, TG_, 13); UV_DOT(wA, TG_, 12); UV_LOAD(wA, TG_, 14); UV_DOT(wB, TG_, 13); \
            UV_LOAD(wB, TG_, 15); UV_DOT(wA, TG_, 14); UV_DOT(wB, TG_, 15); } while (0)
#pragma unroll 1
        for (int s_ = 0; s_ < 8; ++s_) {
            asm volatile("" : "+v"(lane_u));
            const int ju = lane_u >> 3, du = lane_u & 7;
            const unsigned char* ub_ = U8 + (size_t)s_ * NEXP * 128;
            UV_TG(0);
            UV_TG(1);
        }
#undef UV_TG
#undef UV_LOAD
#undef UV_DOT
    }
#pragma unroll 1
    for (int i0 = 0; i0 < 16; i0 += 4) {
        float su_[8], sv_[8], gt_[8], zs_[4];
#pragma unroll
        for (int q = 0; q < 8; ++q) { const int i = i0 + (q >> 1), k = lane + 64 * (q & 1), e = ei[i * 128 + k]; su_[q] = SU[e]; sv_[q] = SV[e]; gt_[q] = GATE[(size_t)(tw + i) * 128 + k]; }
#pragma unroll
        for (int q = 0; q < 4; ++q) zs_[q] = rsqrtf(rss1[tw + i0 + q] * (1.f / DM) + 1e-6f);
#pragma unroll
        for (int q = 0; q < 8; ++q) { const int i = i0 + (q >> 1), k = lane + 64 * (q & 1);
            const float z = zp[i * 128 + k] * zs_[q >> 1] * su_[q];
            zp[i * 128 + k] = gelu_as(z) * gt_[q] * sv_[q]; }
    }
    const int j = lane >> 3, d = lane & 7;
#define V_LOAD(W_, st_) do { const int eb_ = (st_) & 15, tg_ = ((st_) >> 4) & 1, s_ = (st_) >> 5; const unsigned char* vb_ = V8 + (size_t)s_ * NEXP * 128; \
        _Pragma("unroll") for (int q = 0; q < 2; ++q) { const u32x4_t ev_ = *(const LAS u32x4_t*)(ei + (8 * tg_ + j) * 128 + 8 * eb_ + 4 * q); \
            W_[4 * q] = *(const u32x4_t*)(vb_ + (ev_.x * 128u + (unsigned)(16 * d))); W_[4 * q + 1] = *(const u32x4_t*)(vb_ + (ev_.y * 128u + (unsigned)(16 * d))); \
            W_[4 * q + 2] = *(const u32x4_t*)(vb_ + (ev_.z * 128u + (unsigned)(16 * d))); W_[4 * q + 3] = *(const u32x4_t*)(vb_ + (ev_.w * 128u + (unsigned)(16 * d))); } } while (0)
#define V_FMA(W_, st_) do { const int eb_ = (st_) & 15, tg_ = ((st_) >> 4) & 1; \
        float a_[8]; \
        _Pragma("unroll") for (int q = 0; q < 2; ++q) { const f32x4_t av_ = *(const LAS f32x4_t*)(zp + (8 * tg_ + j) * 128 + 8 * eb_ + 4 * q); a_[4 * q] = av_[0]; a_[4 * q + 1] = av_[1]; a_[4 * q + 2] = av_[2]; a_[4 * q + 3] = av_[3]; } \
        _Pragma("unroll") for (int k = 0; k < 8; ++k) { const u32 ww_[4] = {W_[k].x, W_[k].y, W_[k].z, W_[k].w}; \
            _Pragma("unroll") for (int q = 0; q < 4; ++q) { \
                const f32x2_t lo_ = __builtin_amdgcn_cvt_pk_f32_fp8((int)ww_[q], false), hi_ = __builtin_amdgcn_cvt_pk_f32_fp8((int)ww_[q], true); \
                o_[4 * q] = fmaf(a_[k], lo_[0], o_[4 * q]); o_[4 * q + 1] = fmaf(a_[k], lo_[1], o_[4 * q + 1]); o_[4 * q + 2] = fmaf(a_[k], hi_[0], o_[4 * q + 2]); o_[4 * q + 3] = fmaf(a_[k], hi_[1], o_[4 * q + 3]); } } } while (0)
#define V_HBLD(sg_) do { const int tg_ = (sg_) & 1, s_ = (sg_) >> 1; const bf16_t* hb_ = HB + (size_t)(tw + 8 * tg_ + j) * DM + 128 * s_ + 16 * d; \
        hbA_ = *(const u32x4_t*)hb_; hbB_ = *(const u32x4_t*)(hb_ + 8); } while (0)
#define V_FIN(sg_) do { const int tg_ = (sg_) & 1, s_ = (sg_) >> 1, i_ = 8 * tg_ + j, t_ = tw + i_; \
        bf16_t* hb_ = HB + (size_t)t_ * DM + 128 * s_ + 16 * d; \
        { \
            const u32 gw_[8] = {hbA_.x, hbA_.y, hbA_.z, hbA_.w, hbB_.x, hbB_.y, hbB_.z, hbB_.w};        \
            float hv_[16]; \
            _Pragma("unroll") for (int q = 0; q < 8; ++q) { hv_[2 * q] = __uint_as_float(gw_[q] << 16) + o_[2 * q]; hv_[2 * q + 1] = __uint_as_float(gw_[q] & 0xffff0000u) + o_[2 * q + 1]; } \
            *(uint4*)hb_ = pack8(hv_); *(uint4*)(hb_ + 8) = pack8(hv_ + 8); \
            float ss_ = 0.f; \
            _Pragma("unroll") for (int q = 0; q < 16; ++q) ss_ += hv_[q] * hv_[q]; \
            ss_ += __shfl_xor(ss_, 1); ss_ += __shfl_xor(ss_, 2); ss_ += __shfl_xor(ss_, 4); \
            if (d == 0) ssl[i_] += ss_; } \
        _Pragma("unroll") for (int q = 0; q < 16; ++q) o_[q] = 0.f; } while (0)
    {
        u32x4_t wA[8], wB[8], hbA_, hbB_; float o_[16];
#pragma unroll
        for (int q = 0; q < 16; ++q) o_[q] = 0.f;
        V_LOAD(wA, 0);
#pragma unroll 1
        for (int sg = 0; sg < 16; ++sg) {
            V_HBLD(sg);
#pragma unroll 1
            for (int eb = 0; eb < 16; eb += 2) {
                const int st = sg * 16 + eb;
                V_LOAD(wB, st + 1);
                V_FMA(wA, st);
                V_LOAD(wA, (st + 2 < 256 ? st + 2 : 255));
                V_FMA(wB, st + 1);
            }
            V_FIN(sg);
        }
    }
#undef V_LOAD
#undef V_FMA
#undef V_FIN
#undef V_HBLD
    if (lane < 16) rss2[tw + lane] = ssl[lane];
}
#define XB_TMO      128
#define XB_XCNT(j)  (256  + 64 * (j))
#define XB_XSUB(j)  (1280 + 64 * (j))
#define XB_XGEN(j)  (2304 + 64 * (j))
#define XB_TOP      3328
#define XB_TOPGEN   3392
#define XCD_BAR_WORDS 3456
#define XB_SPIN_CAP (1u << 28)
__device__ __forceinline__ unsigned xb_ld(unsigned* p)              { return __hip_atomic_load(p, __ATOMIC_RELAXED, __HIP_MEMORY_SCOPE_AGENT); }
__device__ __forceinline__ unsigned xb_add(unsigned* p, unsigned v) { return __hip_atomic_fetch_add(p, v, __ATOMIC_RELAXED, __HIP_MEMORY_SCOPE_AGENT); }
__device__ __forceinline__ unsigned xb_xcc_id() { return (unsigned)__builtin_amdgcn_s_getreg((3 << 11) | 20) & 0xFu; }
#define XB_SPIN(cond, bar) do { unsigned _sp = 0; while (cond) { __builtin_amdgcn_s_sleep(1); \
    if ((++_sp & 255u) == 0u) { if (xb_ld(&(bar)[XB_TMO])) break; if (_sp > XB_SPIN_CAP) { atomicAdd(&(bar)[XB_TMO], 1u); break; } } } } while (0)
struct XcdBarrier { unsigned* bar; unsigned x; volatile LAS unsigned* st; };
__device__ __forceinline__ XcdBarrier xcd_barrier_post(unsigned* bar, volatile LAS unsigned* st) {
    XcdBarrier b; b.bar = bar; b.x = xb_xcc_id(); b.st = st;
    if (threadIdx.x == 0) (void)xb_add(&bar[XB_XCNT(b.x)], 1u);
    return b;
}
__device__ __forceinline__ void xcd_barrier_complete(unsigned* bar, unsigned x, unsigned& nloc, unsigned& nx) {
    const unsigned G = gridDim.x * gridDim.y * gridDim.z;
    unsigned sum, cnt, mine, sp = 0u;
    for (;;) {
        sum = 0u; cnt = 0u; mine = 0u;
#pragma unroll
        for (unsigned j = 0; j < 16; ++j) { const unsigned c = xb_ld(&bar[XB_XCNT(j)]); sum += c; cnt += (c > 0u) ? 1u : 0u; mine = (j == x) ? c : mine; }
        if (sum == G) break;
        __builtin_amdgcn_s_sleep(1);
        if ((++sp & 255u) == 0u) { if (xb_ld(&bar[XB_TMO])) break; if (sp > XB_SPIN_CAP) { atomicAdd(&bar[XB_TMO], 1u); break; } }
    }
    nloc = mine > 0u ? mine : 1u; nx = cnt > 0u ? cnt : 1u;
}
__device__ __forceinline__ void xcd_barrier(const XcdBarrier& b) {
    asm volatile("s_waitcnt vmcnt(0)" ::: "memory");
    __syncthreads();
    if (threadIdx.x == 0) {
        unsigned* bar = b.bar;
        __builtin_amdgcn_s_waitcnt(0);
        unsigned nloc = b.st[0], nx = b.st[1];
        if (nloc == 0u) { xcd_barrier_complete(bar, b.x, nloc, nx); b.st[0] = nloc; b.st[1] = nx; }
        const unsigned old = xb_add(&bar[XB_XSUB(b.x)], 1u);
        const unsigned gen = old / nloc;
        if (old + 1u == (gen + 1u) * nloc) {
            __builtin_amdgcn_fence(__ATOMIC_RELEASE, "agent");
            asm volatile("s_waitcnt vmcnt(0)" ::: "memory");
            const unsigned og = xb_add(&bar[XB_TOP], 1u);
            const unsigned tg = og / nx;
            if (og + 1u == (tg + 1u) * nx) xb_add(&bar[XB_TOPGEN], 1u);
            else XB_SPIN(xb_ld(&bar[XB_TOPGEN]) == tg, bar);
            __builtin_amdgcn_fence(__ATOMIC_ACQUIRE, "agent");
            xb_add(&bar[XB_XGEN(b.x)], 1u);
            asm volatile("s_waitcnt vmcnt(0)" ::: "memory");
        } else {
            XB_SPIN(xb_ld(&bar[XB_XGEN(b.x)]) == gen, bar);
            __builtin_amdgcn_fence(__ATOMIC_ACQUIRE, "agent");
            asm volatile("s_waitcnt vmcnt(0)" ::: "memory");
        }
    }
    __syncthreads();
}

constexpr int NTHR = 512;
constexpr int LDS_BYTES = 147456;
constexpr int LDS_MISC = 147456 - 256;
constexpr size_t CTL_BAR_OFF = 65536;
struct Args { const float* in[21]; float* out; unsigned char* ws; };

__global__ void __launch_bounds__(NTHR, 2) mega_fwd(Args a) {
    extern __shared__ __attribute__((aligned(16))) unsigned char lds[];
    const float* x = a.in[0]; const float* p = a.in[1]; const float* attn_norm = a.in[2]; const float* w_in = a.in[3];
    const float* lq1 = a.in[4]; const float* lk1 = a.in[5]; const float* lq2 = a.in[6]; const float* lk2 = a.in[7];
    const float* subln = a.in[8]; const float* w_out = a.in[9]; const float* rel_bias = a.in[10]; const float* ffn_norm = a.in[11];
    const float* peer_query = a.in[12]; const float* peer_subkeys = a.in[13]; const float* peer_u = a.in[14]; const float* peer_v = a.in[15];
    const float* ple_norm = a.in[16]; const float* ple_gate_w = a.in[17]; const float* ple_gate_b = a.in[18]; const float* ple_proj = a.in[19];
    const float* final_norm = a.in[20];
    unsigned char* ws = a.ws;
    float* H = a.out;
    float* ctl = (float*)(ws + WS_CTL); float* rss = (float*)(ws + WS_RSS); float* cs = (float*)(ws + WS_CS);
    float* rss1 = rss, *rss2 = rss + 32768, *rss3 = rss + 65536;
    bf16_t* WIN = (bf16_t*)(ws + WS_WIN); bf16_t* WOUT = (bf16_t*)(ws + WS_WOUT); bf16_t* WQ = (bf16_t*)(ws + WS_WQ); bf16_t* WG = (bf16_t*)(ws + WS_WG); bf16_t* WP = (bf16_t*)(ws + WS_WP);
    bf16_t* SUBK = (bf16_t*)(ws + WS_SUBK); bf16_t* U = (bf16_t*)(ws + WS_U); bf16_t* Vt = (bf16_t*)(ws + WS_V);
    bf16_t* XN = (bf16_t*)(ws + WS_XN); bf16_t* HB = XN; bf16_t* PB = (bf16_t*)(ws + WS_PB);
    bf16_t* Q = (bf16_t*)(ws + WS_Q); bf16_t* Kb = (bf16_t*)(ws + WS_K); bf16_t* VV = (bf16_t*)(ws + WS_VV);
    bf16_t* RQ = (bf16_t*)(ws + WS_RQ); bf16_t* RK = (bf16_t*)(ws + WS_RK); bf16_t* RV = (bf16_t*)(ws + WS_RV); bf16_t* RG = (bf16_t*)(ws + WS_RG);
    bf16_t* QRY = (bf16_t*)(ws + WS_QRY); int* IDX = (int*)(ws + WS_IDX); float* GATE = (float*)(ws + WS_GATE);
    bf16_t* MIX = (bf16_t*)(ws + WS_MIX); bf16_t* PP = MIX;
    float* RAWROT = (float*)(ws + WS_MIX);

    const int G = gridDim.x, bx = blockIdx.x, wave_s = __builtin_amdgcn_readfirstlane(threadIdx.x >> 6), gn = G * NTHR;
#define TIDS() const int lane = lane_id(), wave = wave_s, t512 = wave_s * 64 + lane, half = wave_s >> 2, tid = t512 & 255, gtid = bx * NTHR + t512; (void)gtid; (void)tid; (void)wave; (void)half
#define sm ((char*)lds + half * 65536)
    volatile LAS unsigned* misc = (volatile LAS unsigned*)((LAS unsigned char*)lds + LDS_MISC);
    if (threadIdx.x < 64) misc[threadIdx.x] = 0u;
    __syncthreads();
    XcdBarrier bar = xcd_barrier_post((unsigned*)(ws + WS_CTL + CTL_BAR_OFF), misc + 8);
#define VLOOP(NBLK) for (int base_ = 2 * bx, bid = base_ + half; base_ < (NBLK); base_ += 2 * G, bid = base_ + half)
#define GRID_BAR() xcd_barrier(bar)

#define GEMM_PHASE(EPI, A_, B_, N_, K_, ...) do { int k_ = K_; asm volatile("" : "+s"(k_)); pg8::Gemm g_{A_, B_, M, N_, k_}; pg8::StaticOrder S_; S_.init(M, N_, G, bx); EpiRow8<EPI> E_{EPI{__VA_ARGS__}}; \
        pg8::gemm_phase<EpiRow8<EPI>, pg8::StaticOrder, true, true>((PG8_LAS unsigned char*)lds, g_, S_, E_, wave_s * 64 + lane_id()); } while (0)
    {   TIDS();
    for (int g = gtid; g < 4096 * 32; g += gn) b_tables(g, lq1, lk1, lq2, lk2, rel_bias, ctl, cs);
    {
        LAS float* scr = (LAS float*)((LAS unsigned char*)lds + wave * 16384);
        const int gw = bx * 8 + wave, ngw = G * 8;
        constexpr int I1 = (DM / 64) * (INW / 32), I2 = (DM / 64) * (DM / 32), I3 = (DM / 64) * (2048 / 32), I4 = I2, I5 = (256 / 64) * (DM / 32);
        for (int it = gw; it < I1 + I2 + I3 + I4 + I5; it += ngw) {
            int q = it;
            if (q < I1) { wave_transpose_item<true>(w_in, DM, INW, WIN, nullptr, scr, q, lane); continue; } q -= I1;
            if (q < I2) { wave_transpose_item<false>(w_out, DM, DM, WOUT, nullptr, scr, q, lane); continue; } q -= I2;
            if (q < I3) { wave_transpose_item<false>(peer_query, DM, 2048, WQ, ffn_norm, scr, q, lane); continue; } q -= I3;
            if (q < I4) { wave_transpose_item<false>(ple_gate_w, DM, DM, WG, ple_norm, scr, q, lane); continue; } q -= I4;
            wave_transpose_item<false>(ple_proj, 256, DM, WP, nullptr, scr, q, lane);
        }
    }
    b_convert(gtid, gn, peer_subkeys, SUBK, (size_t)16 * 128 * 128 / 4, nullptr, 1024);
    for (int row = bx * 8 + wave; row < NEXP; row += G * 8) { b_rowquant(row, lane, peer_u, ffn_norm, (unsigned char*)U, (float*)(ws + WS_SU)); b_rowquant(row, lane, peer_v, nullptr, (unsigned char*)Vt, (float*)(ws + WS_SV)); }
    b_convert(gtid, gn, p, PB, (size_t)M * 256 / 4, nullptr, 256);
    for (int row = bx * 8 + wave; row < M; row += G * 8) b_rmsnorm_bf16(row, lane, x, attn_norm, XN, 1e-6f);
    }
    GRID_BAR();
    { int k_ = DM; asm volatile("" : "+s"(k_)); pg8::Gemm g_{XN, WIN, M, INW, k_}; pg8::StaticOrder S_; S_.init(M, INW, G, bx); EpiInProjT E_{ws, cs};
      pg8::gemm_phase<EpiInProjT, pg8::StaticOrder, true, true>((PG8_LAS unsigned char*)lds, g_, S_, E_, wave_s * 64 + lane_id()); }
    GRID_BAR();
    {
        const int vcu = (G & 7) ? bx : (bx & 7) * (G >> 3) + (bx >> 3);
        bf16_t* RKT = (bf16_t*)(ws + WS_RKT); float* KVT = (float*)(ws + WS_KVT); bf16_t* ST = (bf16_t*)(ws + WS_ST);
        { TIDS(); for (int u = vcu; u < BATCH * 4 * 32; u += G) ret_kv_unit(t512, u >> 5, u & 31, RV, RKT, KVT); }
        GRID_BAR();
        { TIDS(); for (int e = gtid; e < BATCH * 4 * 8192; e += gn) ret_scan(e, KVT, ST);
        for (int v = vcu; v < 256; v += G) {
            const int xg = v >> 5, w = v & 31, s16 = w & 15;
#pragma unroll 1
            for (int i = 0; i < 4; ++i) {
                const int bh = 4 * xg + 2 * (i >> 1) + (w >> 4), qb = (i & 1) ? s16 : 31 - s16;
                attn_unit<0>((LAS unsigned char*)lds, t512, bh >> 2, bh & 3, qb, Q, Kb, VV, ctl, subln, MIX);
            }
        }
#ifdef ATT_PROBE
        for (int v = vcu; v < 256; v += G) {
            const int bh = v >> 3, sidx = v & 7;
#pragma unroll 1
            for (int i = 0; i < 4; ++i) {
                const int qb = (i == 0) ? 31 - sidx : (i == 1) ? 16 + sidx : (i == 2) ? 15 - sidx : sidx;
                attn_unit<ATT_PROBE>((LAS unsigned char*)lds, t512, bh >> 2, bh & 3, qb, Q, Kb, VV, ctl, subln, MIX);
            }
        }
#endif
        }
        GRID_BAR();
        { TIDS(); ret_out_units((LAS unsigned char*)lds, t512, vcu, G, BATCH * 4 * 32, RQ, RK, RV, ST, RG, MIX); __syncthreads(); }
    }
    GRID_BAR();
    GEMM_PHASE(EpiOutProj, MIX, WOUT, DM, DM, x, H, HB, rss1);
    GRID_BAR();
    GEMM_PHASE(EpiQry, HB, WQ, 2048, DM, QRY, rss1);
    GRID_BAR();
    {   TIDS();
        const int head = bx & 7, nw = G >> 3, wq = bx >> 3;
        __syncthreads();
        for (int c16 = t512; c16 < 2 * 128 * 16; c16 += NTHR) { const int row = c16 >> 4, ch = c16 & 15;
            *(LAS u32x4_t*)((LAS unsigned char*)lds + row * SKROW + 16 * ch) = *(const u32x4_t*)(SUBK + ((size_t)head * 256 + row) * 128 + 8 * ch); }
        __syncthreads();
        {   bf16x8_t qf[8]; int tb = wq + nw * wave;
            { const bf16_t* q0 = QRY + (size_t)((tb < M / 32 ? tb : 0) * 32 + (lane & 31)) * 2048 + head * 256 + 8 * (lane >> 5);
#pragma unroll
              for (int ks = 0; ks < 8; ++ks) qf[ks] = *(const bf16x8_t*)(q0 + 16 * ks); }
#pragma unroll 1
            for (; tb < M / 32; tb += nw * 8) { const int tn = tb + nw * 8 < M / 32 ? tb + nw * 8 : tb;
                peer_topk_unit(lane, tb * 32, tn * 32, head, QRY, qf, (const LAS unsigned char*)lds, (LAS unsigned char*)lds + 2 * 128 * SKROW + wave * (32 * 144), IDX, GATE); } }
        __syncthreads();
    }
    GRID_BAR();
    {   TIDS(); __syncthreads(); for (int tb = bx; tb < M / 128; tb += G) peer_sliced((LAS unsigned char*)lds, lane, wave, tb * 128, (const unsigned char*)U, (const unsigned char*)Vt, (const float*)(ws + WS_SU), (const float*)(ws + WS_SV), (const unsigned char*)(ws + WS_HB8), (const float*)(ws + WS_SH), IDX, GATE, H, HB, rss1, rss2); __syncthreads(); }
    GRID_BAR();
    GEMM_PHASE(EpiPP, PB, WP, DM, 256, PP);
    GRID_BAR();
    GEMM_PHASE(EpiGate, HB, WG, DM, DM, HB, PP, ple_gate_b, rss2, rss3, QRY);
    GRID_BAR();
    {   TIDS(); for (size_t g = gtid; g < (size_t)M * DM / 8; g += gn) b_final(g, QRY, H, rss3, final_norm); }
}

extern "C" void kernel_launch(void* const* d_in, const int* in_sizes, int n_in, void* d_out, int out_size, void* d_ws, size_t ws_size, hipStream_t stream) {
    static int grid = 0;
    if (grid == 0) {
        int dev = 0, cus = 0;
        if (n_in != 21 || out_size != M * DM || ws_size < WS_END) { fprintf(stderr, "kernel_launch: unexpected problem shape (n_in %d out %d ws %zu)\n", n_in, out_size, ws_size); grid = -1; return; }
        if (hipGetDevice(&dev) != hipSuccess || hipDeviceGetAttribute(&cus, hipDeviceAttributeMultiprocessorCount, dev) != hipSuccess) { grid = -1; return; }
        if (hipFuncSetAttribute((const void*)mega_fwd, hipFuncAttributeMaxDynamicSharedMemorySize, LDS_BYTES) != hipSuccess) { fprintf(stderr, "kernel_launch: hipFuncSetAttribute failed\n"); grid = -1; return; }
        int per_cu = 0;
        if (hipOccupancyMaxActiveBlocksPerMultiprocessor(&per_cu, (const void*)mega_fwd, NTHR, LDS_BYTES) != hipSuccess || per_cu < 1) { fprintf(stderr, "kernel_launch: occupancy query says %d\n", per_cu); }
        (void)hipGetLastError();
        grid = cus;
    }
    if (grid < 0) return;
    if (hipMemsetAsync((char*)d_ws, 0, WS_RSS + 3 * 32768 * 4, stream) != hipSuccess) return;
    Args a{};
    for (int i = 0; i < 21; ++i) a.in[i] = (const float*)d_in[i];
    a.out = (float*)d_out; a.ws = (unsigned char*)d_ws;
    hipLaunchKernelGGL(mega_fwd, dim3(grid), dim3(NTHR), LDS_BYTES, stream, a);
}
```

```cpp
#include <hip/hip_runtime.h>
#include <cstdint>
#include <cstdio>

typedef unsigned short bf16_t;
typedef unsigned int u32;
#define LAS __attribute__((address_space(3)))

constexpr int BATCH = 8, SEQ = 4096, DM = 1024, M = BATCH * SEQ;
constexpr int INW = 3072;
constexpr int NEXP = 16384;
constexpr float LOG2E = 1.4426950408889634f;
constexpr float QSCALE = 0.125f * LOG2E;

constexpr size_t MiB = 1u << 20;
constexpr size_t WS_CTL = 0;
constexpr size_t WS_RSS = 1 * MiB;
constexpr size_t WS_CS = 2 * MiB;
constexpr size_t WS_WIN = 4 * MiB;
constexpr size_t WS_WOUT = 10 * MiB;
constexpr size_t WS_WQ = 12 * MiB;
constexpr size_t WS_WG = 16 * MiB;
constexpr size_t WS_WP = 18 * MiB;
constexpr size_t WS_SUBK = 18 * MiB + 512 * 1024;
constexpr size_t WS_U = 20 * MiB;
constexpr size_t WS_V = 52 * MiB;
constexpr size_t WS_XN = 84 * MiB;
constexpr size_t WS_PB = 148 * MiB;
constexpr size_t WS_BIG = 164 * MiB;
constexpr size_t WS_Q = WS_BIG, WS_K = WS_BIG + 32 * MiB, WS_VV = WS_BIG + 64 * MiB;
constexpr size_t WS_RQ = WS_BIG + 96 * MiB, WS_RK = WS_BIG + 112 * MiB, WS_RV = WS_BIG + 128 * MiB, WS_RG = WS_BIG + 160 * MiB;
constexpr size_t WS_QRY = WS_BIG;
constexpr size_t WS_IDX = WS_BIG + 128 * MiB;
constexpr size_t WS_GATE = WS_BIG + 144 * MiB;
constexpr size_t WS_MIX = 356 * MiB;
constexpr size_t WS_RKT = 420 * MiB;
constexpr size_t WS_KVT = 436 * MiB;
constexpr size_t WS_ST = 468 * MiB;
constexpr size_t WS_END = 484 * MiB;
constexpr size_t WS_HB8 = WS_MIX, WS_SH = WS_MIX + 32 * MiB;
constexpr size_t WS_SU = WS_U + 16 * MiB, WS_SV = WS_U + 16 * MiB + 65536;

__device__ __forceinline__ float bf2f(bf16_t v) { return __uint_as_float(((u32)v) << 16); }
__device__ __forceinline__ bf16_t f2bf(float f) { u32 u = __float_as_uint(f); return (bf16_t)((u + 0x7fffu + ((u >> 16) & 1u)) >> 16); }

__device__ __forceinline__ int lane_id() { int l; asm volatile("v_mbcnt_lo_u32_b32 %0, -1, 0\n\tv_mbcnt_hi_u32_b32 %0, -1, %0" : "=v"(l)); return l; }
__device__ __forceinline__ float wave_sum(float v) {
#pragma unroll
    for (int o = 1; o < 64; o <<= 1) v += __shfl_xor(v, o);
    return v;
}
__device__ __forceinline__ float wave_max(float v) {
#pragma unroll
    for (int o = 1; o < 64; o <<= 1) v = fmaxf(v, __shfl_xor(v, o));
    return v;
}

__host__ __device__ __forceinline__ int rot_dst_row(int n);
template <bool ROT> __device__ __forceinline__ void b_transpose_wt(int bid, int tid, char* sm, const float* __restrict__ W, int K, int N, bf16_t* __restrict__ WT, const float* __restrict__ gain) {
    float (*t)[33] = (float (*)[33])sm;
    const int nbx = N / 32; const int k0 = (bid / nbx) * 32, n0 = (bid % nbx) * 32, tx = tid & 31, ty = tid >> 5;
    __syncthreads();
    for (int i = ty; i < 32; i += 8) { float g = gain ? gain[k0 + i] : 1.f; t[i][tx] = W[(size_t)(k0 + i) * N + n0 + tx] * g; }
    __syncthreads();
    for (int i = ty; i < 32; i += 8) WT[(size_t)(ROT ? rot_dst_row(n0 + i) : (n0 + i)) * K + k0 + tx] = f2bf(t[tx][i]);
}
__device__ __forceinline__ void b_transpose_w(int bid, int tid, char* sm, const float* __restrict__ W, int K, int N, bf16_t* __restrict__ WT, const float* __restrict__ gain) {
    float (*t)[33] = (float (*)[33])sm;
    const int nbx = N / 32; const int k0 = (bid / nbx) * 32, n0 = (bid % nbx) * 32, tx = tid & 31, ty = tid >> 5;
    __syncthreads();
    for (int i = ty; i < 32; i += 8) { float g = gain ? gain[k0 + i] : 1.f; t[i][tx] = W[(size_t)(k0 + i) * N + n0 + tx] * g; }
    __syncthreads();
    for (int i = ty; i < 32; i += 8) WT[(size_t)(n0 + i) * K + k0 + tx] = f2bf(t[tx][i]);
}
__device__ __forceinline__ void b_convert(int gtid, int gn, const float* __restrict__ in, bf16_t* __restrict__ out, size_t n4, const float* __restrict__ gain, int period) {
    for (size_t i = (size_t)gtid; i < n4; i += (size_t)gn) {
        float4 v = ((const float4*)in)[i];
        if (gain) { const int c = (int)((i * 4) % period); v.x *= gain[c]; v.y *= gain[c + 1]; v.z *= gain[c + 2]; v.w *= gain[c + 3]; }
        ushort4 o; o.x = f2bf(v.x); o.y = f2bf(v.y); o.z = f2bf(v.z); o.w = f2bf(v.w);
        ((ushort4*)out)[i] = o;
    }
}
__device__ __forceinline__ void b_rmsnorm_bf16(int row, int lane, const float* __restrict__ x, const float* __restrict__ gain, bf16_t* __restrict__ out, float eps) {
    const float4* xr = (const float4*)(x + (size_t)row * DM);
    float4 v[4]; float s = 0.f;
#pragma unroll
    for (int j = 0; j < 4; ++j) { v[j] = xr[lane + 64 * j]; s += v[j].x * v[j].x + v[j].y * v[j].y + v[j].z * v[j].z + v[j].w * v[j].w; }
    s = wave_sum(s);
    const float r = rsqrtf(s * (1.f / DM) + eps);
#pragma unroll
    for (int j = 0; j < 4; ++j) {
        const float4 g = ((const float4*)gain)[lane + 64 * j];
        ushort4 o; o.x = f2bf(v[j].x * r * g.x); o.y = f2bf(v[j].y * r * g.y); o.z = f2bf(v[j].z * r * g.z); o.w = f2bf(v[j].w * r * g.w);
        ((ushort4*)(out + (size_t)row * DM))[lane + 64 * j] = o;
    }
}
__device__ __forceinline__ void sincos_acc(float ang, float& s, float& c) {
    const double x = (double)ang;
    const double k = rint(x * 0.63661977236758134308);
    double r = fma(-k, 1.57079632679489655800, x); r = fma(-k, 6.12323399573676603587e-17, r);
    const double r2 = r * r;
    double sp = r * (1.0 + r2 * (-1.0 / 6 + r2 * (1.0 / 120 + r2 * (-1.0 / 5040 + r2 * (1.0 / 362880 + r2 * (-1.0 / 39916800 + r2 * (1.0 / 6227020800.0)))))));
    double cp = 1.0 + r2 * (-0.5 + r2 * (1.0 / 24 + r2 * (-1.0 / 720 + r2 * (1.0 / 40320 + r2 * (-1.0 / 3628800 + r2 * (1.0 / 479001600.0 + r2 * (-1.0 / 87178291200.0)))))));
    const int q = ((int)(long long)k) & 3;
    double ss, cc;
    if (q == 0) { ss = sp; cc = cp; } else if (q == 1) { ss = cp; cc = -sp; } else if (q == 2) { ss = -sp; cc = -cp; } else { ss = -cp; cc = sp; }
    s = (float)ss; c = (float)cc;
}
__device__ __forceinline__ void b_tables(int gid, const float* lq1, const float* lk1, const float* lq2, const float* lk2, const float* __restrict__ rel_bias,
                                                float* __restrict__ ctl, float* __restrict__ cs) {
    if (gid == 0) {
        float a = 0.f, b = 0.f;
        for (int i = 0; i < 64; ++i) { a += lq1[i] * lk1[i]; b += lq2[i] * lk2[i]; }
        ctl[0] = expf(a) - expf(b) + 0.2f;
    }
    if (gid < 512) {
        const int h = gid >> 7, n = gid & 127;
        int bucket;
        if (n < 16) bucket = n;
        else { const float nf = (float)n; int lg = 16 + (int)(logf(nf / 16.0f) / 2.0794415416798357f * 16.0f); bucket = lg < 31 ? lg : 31; }
        ctl[64 + h * 128 + n] = rel_bias[bucket * 4 + h] * LOG2E;
    }
    if (gid < 4096 * 32) {
        const int pos = gid >> 5, i = gid & 31;
        const float freq = 1.0f / powf(10000.0f, (float)i / 32.0f);
        const float ang = (float)pos * freq;
        float s, c; sincos_acc(ang, s, c);
        cs[gid] = c; cs[4096 * 32 + gid] = s;
    }
}

namespace pg8 {
#define PG8_LAS __attribute__((address_space(3)))
typedef unsigned short bf16_t;
typedef short bf16x8 __attribute__((ext_vector_type(8)));
typedef float f32x4 __attribute__((ext_vector_type(4)));
typedef unsigned u32x4 __attribute__((ext_vector_type(4)));
constexpr int BM = 256, BK = 64, HALF = 128, HTB = HALF * BK * 2  , STAGE_BYTES = 8 * HTB, NXCD = 8, WGM = 8;

__host__ __device__ __forceinline__ int lds_byte(int r, int c) { const int st = (r >> 4) * 2 + (c >> 5), rr = r & 15, cc = c & 31, ob = rr * 64 + cc * 2; return st * 1024 + (ob ^ (((ob >> 9) & 1) << 5)); }
__host__ __device__ __forceinline__ void stage_rc(int b, int& R, int& C) { const int st = b / 1024, sb = b % 1024, swz = sb ^ (((sb >> 9) & 1) << 5); R = (st >> 1) * 16 + swz / 64; C = (st & 1) * 32 + (swz % 64) / 2; }
__host__ __device__ __forceinline__ int perm32(int rho) { const int n = rho >> 4, i = rho & 15; return 8 * (i >> 2) + 4 * n + (i & 3); }

struct Unit { int pm, pn; };
struct Gemm { const bf16_t* A; const bf16_t* Bt; int M, N, K; };

struct StaticOrder {
    int nM, nN, nwg, G, c;
    __host__ __device__ void init(int M, int N, int G_, int c_) { nM = M / BM; nN = N / BM; nwg = nM * nN; G = G_; c = c_; }
    __host__ __device__ bool next(int i, Unit& u) const {
        const long L = (long)i * G + c; if (L >= nwg) return false;
        int wgid = (int)L; { const int q = nwg / NXCD, r = nwg % NXCD, xcd = wgid % NXCD, off = wgid / NXCD; wgid = (xcd < r ? xcd * (q + 1) : r * (q + 1) + (xcd - r) * q) + off; }
        const int nig = WGM * nN, gid = wgid / nig, fm = gid * WGM, gsz = (nM - fm) < WGM ? (nM - fm) : WGM;
        u.pm = fm + ((wgid % nig) % gsz); u.pn = (wgid % nig) / gsz; return true;
    }
    __device__ __forceinline__ void a_ready(const Unit&) const {}
    __device__ __forceinline__ void done(const Unit&) const {}
};

__device__ __forceinline__ unsigned cvt_pk_bf16(float lo, float hi) { unsigned r; asm volatile("v_cvt_pk_bf16_f32 %0, %1, %2" : "=v"(r) : "v"(lo), "v"(hi)); return r; }
typedef float f32x2 __attribute__((ext_vector_type(2)));
template <class Epi, class Sched, bool ALIGN_EPI = false, bool SP2 = false>
__device__ __forceinline__ void gemm_phase(PG8_LAS unsigned char* lds, const Gemm g, const Sched& S, const Epi& E, const int tid) {
    const int wid = __builtin_amdgcn_readfirstlane(tid >> 6), lane = tid & 63, wr = wid >> 2, wc = wid & 3, fr = lane & 15, fq = lane >> 4;
    const int K = g.K, nt = K / BK;
    unsigned voffA[2], voffB[2];
#pragma unroll
    for (int i = 0; i < 2; ++i) { int R, C; stage_rc(tid * 16 + i * 8192, R, C); const int Rb = Epi::PERM ? ((R & ~31) + perm32(R & 31)) : R;
        voffA[i] = (unsigned)(R * K + C) * 2u; voffB[i] = (unsigned)(Rb * K + C) * 2u; }
    const size_t kstep = (size_t)(BK * 2);
    const size_t hstep = (size_t)HALF * K * 2;
    const size_t tstep = 2 * hstep;
    const unsigned ldsw = (unsigned)wid * 1024u;
    const int aoff = lds_byte(wr * 64 + fr, fq * 8), boff = lds_byte(wc * 32 + fr, fq * 8);
#define PG8_SA(b, h) (((b) * 2 + (h)) * HTB)
#define PG8_SB(b, h) ((4 + (b) * 2 + (h)) * HTB)
#define PG8_STAGE(bufoff, gbase, voff) do { _Pragma("unroll") for (int _i = 0; _i < 2; ++_i) \
        __builtin_amdgcn_global_load_lds((const unsigned*)((const char*)(gbase) + (voff)[_i]), (PG8_LAS unsigned*)(lds + (bufoff) + ldsw + _i * 8192), 16, 0, 0); } while (0)
#define PG8_LDA(dst, b, h) do { _Pragma("unroll") for (int m = 0; m < 4; ++m) _Pragma("unroll") for (int k = 0; k < 2; ++k) dst[m][k] = *(const PG8_LAS bf16x8*)(lds + PG8_SA(b, h) + aoff + m * 2048 + k * 1024); } while (0)
#define PG8_LDB(dst, b, h) do { _Pragma("unroll") for (int n = 0; n < 2; ++n) _Pragma("unroll") for (int k = 0; k < 2; ++k) dst[n][k] = *(const PG8_LAS bf16x8*)(lds + PG8_SB(b, h) + boff + n * 2048 + k * 1024); } while (0)
#define PG8_MMA(ai, bj, At, Bt) do { __builtin_amdgcn_s_setprio(1); _Pragma("unroll") for (int m = 0; m < 4; ++m) _Pragma("unroll") for (int n = 0; n < 2; ++n) _Pragma("unroll") for (int k = 0; k < 2; ++k) \
        acc[ai][bj][m][n] = __builtin_amdgcn_mfma_f32_16x16x32_bf16(Bt[n][k], At[m][k], acc[ai][bj][m][n], 0, 0, 0); __builtin_amdgcn_s_setprio(0); } while (0)
#define PG8_WAIT_V(n) asm volatile("s_waitcnt vmcnt(" #n ")" ::: "memory")
#define PG8_WAIT_L(n) asm volatile("s_waitcnt lgkmcnt(" #n ")" ::: "memory")
#define PG8_BAR __builtin_amdgcn_s_barrier()
#define PG8_SCHED __builtin_amdgcn_sched_barrier(0)
    Unit cur, nxt; int ui = 0;
    if (!S.next(0, cur)) return;
    f32x4 acc[2][2][4][2];
#pragma unroll
    for (int a = 0; a < 2; ++a)
#pragma unroll
        for (int b = 0; b < 2; ++b)
#pragma unroll
            for (int m = 0; m < 4; ++m)
#pragma unroll
                for (int n = 0; n < 2; ++n) acc[a][b][m][n] = (f32x4){0.f, 0.f, 0.f, 0.f};
    bf16x8 At[4][2], B0[2][2], B1[2][2];
    const char* cA = (const char*)g.A + (size_t)cur.pm * tstep; const char* cB = (const char*)g.Bt + (size_t)cur.pn * tstep;
    S.a_ready(cur);
    if constexpr (SP2) {
        PG8_STAGE(PG8_SB(0, 0), cB, voffB); PG8_STAGE(PG8_SB(0, 1), cB + hstep, voffB); PG8_STAGE(PG8_SA(0, 0), cA, voffA); PG8_STAGE(PG8_SA(0, 1), cA + hstep, voffA);
        if (wr == 1) PG8_BAR;
        PG8_WAIT_V(2); PG8_BAR;
        PG8_STAGE(PG8_SB(1, 0), cB + kstep, voffB); PG8_STAGE(PG8_SA(1, 0), cA + kstep, voffA); PG8_STAGE(PG8_SB(1, 1), cB + hstep + kstep, voffB);
        PG8_WAIT_V(6); PG8_BAR;
    } else {
        PG8_STAGE(PG8_SB(0, 0), cB, voffB); PG8_STAGE(PG8_SA(0, 0), cA, voffA); PG8_STAGE(PG8_SB(0, 1), cB + hstep, voffB); PG8_STAGE(PG8_SA(0, 1), cA + hstep, voffA);
        if (wr == 1) PG8_BAR;
        PG8_WAIT_V(4); PG8_BAR;
        PG8_STAGE(PG8_SB(1, 0), cB + kstep, voffB); PG8_STAGE(PG8_SA(1, 0), cA + kstep, voffA); PG8_STAGE(PG8_SB(1, 1), cB + hstep + kstep, voffB);
        PG8_WAIT_V(6); PG8_BAR;
    }
    for (;;) {
        const bool has_next = S.next(ui + 1, nxt);
        const char* nA = has_next ? (const char*)g.A + (size_t)nxt.pm * tstep : cA; const char* nB = has_next ? (const char*)g.Bt + (size_t)nxt.pn * tstep : cB;
        for (int t = 0; t < nt; t += 2) {
            const bool last = (t == nt - 2);
            const char* a1 = cA + (size_t)(t + 1) * kstep;
            const char* a2 = last ? nA : cA + (size_t)(t + 2) * kstep; const char* b2 = last ? nB : cB + (size_t)(t + 2) * kstep;
            const char* a3 = a2 + kstep; const char* b3 = b2 + kstep;
            if (last && has_next) S.a_ready(nxt);
            if constexpr (SP2) {
            PG8_LDB(B0, 0, 0); PG8_LDB(B1, 0, 1); PG8_SCHED; PG8_LDA(At, 0, 0); PG8_STAGE(PG8_SA(1, 1), a1 + hstep, voffA);
            PG8_WAIT_V(8); PG8_WAIT_L(0); PG8_BAR; PG8_MMA(0, 0, At, B0); PG8_MMA(0, 1, At, B1); PG8_BAR; PG8_SCHED;
            PG8_LDA(At, 0, 1); PG8_STAGE(PG8_SB(0, 0), b2, voffB); PG8_STAGE(PG8_SB(0, 1), b2 + hstep, voffB); PG8_STAGE(PG8_SA(0, 0), a2, voffA);
            PG8_WAIT_V(8); PG8_WAIT_L(0); PG8_BAR; PG8_MMA(1, 0, At, B0); PG8_MMA(1, 1, At, B1); PG8_BAR; PG8_SCHED;
            PG8_LDB(B0, 1, 0); PG8_LDB(B1, 1, 1); PG8_SCHED; PG8_LDA(At, 1, 0); PG8_STAGE(PG8_SA(0, 1), a2 + hstep, voffA);
            PG8_WAIT_V(8); PG8_WAIT_L(0); PG8_BAR; PG8_MMA(0, 0, At, B0); PG8_MMA(0, 1, At, B1); PG8_BAR; PG8_SCHED;
            PG8_LDA(At, 1, 1); PG8_STAGE(PG8_SB(1, 0), b3, voffB); PG8_STAGE(PG8_SB(1, 1), b3 + hstep, voffB); PG8_STAGE(PG8_SA(1, 0), a3, voffA);
            PG8_WAIT_V(8); PG8_WAIT_L(0); PG8_BAR; PG8_MMA(1, 0, At, B0); PG8_MMA(1, 1, At, B1); PG8_BAR; PG8_SCHED;
            } else {
            PG8_LDB(B0, 0, 0); PG8_SCHED; PG8_LDA(At, 0, 0); PG8_STAGE(PG8_SA(1, 1), a1 + hstep, voffA);
            PG8_WAIT_L(8); PG8_BAR; PG8_WAIT_L(0); PG8_MMA(0, 0, At, B0); PG8_BAR; PG8_SCHED;
            PG8_LDB(B1, 0, 1); PG8_STAGE(PG8_SB(0, 0), b2, voffB);
            PG8_BAR; PG8_WAIT_L(0); PG8_MMA(0, 1, At, B1); PG8_BAR;
            PG8_LDA(At, 0, 1); PG8_STAGE(PG8_SA(0, 0), a2, voffA);
            PG8_BAR; PG8_WAIT_L(0); PG8_MMA(1, 0, At, B0); PG8_BAR; PG8_SCHED;
            PG8_STAGE(PG8_SB(0, 1), b2 + hstep, voffB);
            PG8_WAIT_V(6); PG8_BAR; PG8_MMA(1, 1, At, B1); PG8_BAR;
            PG8_LDB(B0, 1, 0); PG8_SCHED; PG8_LDA(At, 1, 0); PG8_STAGE(PG8_SA(0, 1), a2 + hstep, voffA);
            PG8_WAIT_L(8); PG8_BAR; PG8_WAIT_L(0); PG8_MMA(0, 0, At, B0); PG8_BAR; PG8_SCHED;
            PG8_LDB(B1, 1, 1); PG8_STAGE(PG8_SB(1, 0), b3, voffB);
            PG8_BAR; PG8_WAIT_L(0); PG8_MMA(0, 1, At, B1); PG8_BAR;
            PG8_LDA(At, 1, 1); PG8_STAGE(PG8_SA(1, 0), a3, voffA);
            PG8_BAR; PG8_WAIT_L(0); PG8_MMA(1, 0, At, B0); PG8_BAR; PG8_SCHED;
            PG8_STAGE(PG8_SB(1, 1), b3 + hstep, voffB);
            PG8_WAIT_V(6); PG8_BAR; PG8_MMA(1, 1, At, B1); PG8_BAR;
            }
        }
        if constexpr (ALIGN_EPI) { if (wr == 0) PG8_BAR; }
        if constexpr (!Epi::AFTER_DRAIN) { E(acc, cur, wr, wc, fr, fq); S.done(cur); }
        if (!has_next) break;
#pragma unroll
        for (int a = 0; a < 2; ++a)
#pragma unroll
            for (int b = 0; b < 2; ++b)
#pragma unroll
                for (int m = 0; m < 4; ++m)
#pragma unroll
                    for (int n = 0; n < 2; ++n) acc[a][b][m][n] = (f32x4){0.f, 0.f, 0.f, 0.f};
        cur = nxt; cA = nA; cB = nB; ++ui;
        if constexpr (ALIGN_EPI) { if (wr == 1) PG8_BAR; }
    }
    PG8_WAIT_V(0);
    if constexpr (!ALIGN_EPI) { if (wr == 0) PG8_BAR; }
    PG8_BAR;
    if constexpr (Epi::AFTER_DRAIN) { E.fused(acc, cur, wr, wc, fr, fq, lds, wid, lane); S.done(cur); }
#undef PG8_SA
#undef PG8_SB
#undef PG8_STAGE
#undef PG8_LDA
#undef PG8_LDB
#undef PG8_MMA
#undef PG8_WAIT_V
#undef PG8_WAIT_L
#undef PG8_BAR
#undef PG8_SCHED
}
}

template <class E> struct EpiRow8 {
    static constexpr bool PERM = true, AFTER_DRAIN = false;
    E e;
    __device__ __forceinline__ void operator()(const pg8::f32x4 (&acc)[2][2][4][2], const pg8::Unit& u, int wr, int wc, int fr, int fq) const {
        const int row0 = u.pm * 256 + wr * 64 + fr, col0 = u.pn * 256 + wc * 32 + 8 * fq;
#pragma unroll
        for (int ai = 0; ai < 2; ++ai)
#pragma unroll
            for (int m = 0; m < 4; ++m) {
                const int row = row0 + ai * 128 + m * 16; float s = 0.f;
#pragma unroll
                for (int bj = 0; bj < 2; ++bj) {
                    const float v[8] = {acc[ai][bj][m][0][0], acc[ai][bj][m][0][1], acc[ai][bj][m][0][2], acc[ai][bj][m][0][3], acc[ai][bj][m][1][0], acc[ai][bj][m][1][1], acc[ai][bj][m][1][2], acc[ai][bj][m][1][3]};
                    s += e.row8(row, col0 + bj * 128, v);
                }
                if (E::ROWSUM) { s += __shfl_xor(s, 16); s += __shfl_xor(s, 32); if (fq == 0) e.rowsum(row, s); }
            }
    }
};
__device__ __forceinline__ uint4 pack8_asm(const float* w) { uint4 o; o.x = pg8::cvt_pk_bf16(w[0], w[1]); o.y = pg8::cvt_pk_bf16(w[2], w[3]); o.z = pg8::cvt_pk_bf16(w[4], w[5]); o.w = pg8::cvt_pk_bf16(w[6], w[7]); return o; }

template <class Epi>
__device__ __forceinline__ void b_gemm(int bid, int tid, char* sm, int nbx, const bf16_t* __restrict__ A, const bf16_t* __restrict__ Bt, int K, const Epi& epi) {
    float (*As)[132] = (float (*)[132])sm;
    float (*Bs)[132] = (float (*)[132])(sm + 16 * 132 * 4);
    const int tx = tid & 15, ty = tid >> 4;
    const int row0 = (bid / nbx) * 128, col0 = (bid % nbx) * 128;
    const int lr = tid >> 1, lk = (tid & 1) * 8;
    const bf16_t* ap = A + (size_t)(row0 + lr) * K + lk;
    const bf16_t* bp = Bt + (size_t)(col0 + lr) * K + lk;
    float acc[8][8];
#pragma unroll
    for (int i = 0; i < 8; ++i)
#pragma unroll
        for (int j = 0; j < 8; ++j) acc[i][j] = 0.f;
    for (int k0 = 0; k0 < K; k0 += 16) {
        const uint4 av = *(const uint4*)(ap + k0), bv = *(const uint4*)(bp + k0);
        __syncthreads();
        const u32 aw[4] = {av.x, av.y, av.z, av.w}, bw[4] = {bv.x, bv.y, bv.z, bv.w};
#pragma unroll
        for (int j = 0; j < 4; ++j) {
            As[lk + 2 * j][lr] = __uint_as_float(aw[j] << 16); As[lk + 2 * j + 1][lr] = __uint_as_float(aw[j] & 0xffff0000u);
            Bs[lk + 2 * j][lr] = __uint_as_float(bw[j] << 16); Bs[lk + 2 * j + 1][lr] = __uint_as_float(bw[j] & 0xffff0000u);
        }
        __syncthreads();
#pragma unroll 2
        for (int k = 0; k < 16; ++k) {
            float a[8], b[8];
            const float4 a0 = *(const float4*)&As[k][ty * 8], a1 = *(const float4*)&As[k][ty * 8 + 4];
            const float4 b0 = *(const float4*)&Bs[k][tx * 8], b1 = *(const float4*)&Bs[k][tx * 8 + 4];
            a[0] = a0.x; a[1] = a0.y; a[2] = a0.z; a[3] = a0.w; a[4] = a1.x; a[5] = a1.y; a[6] = a1.z; a[7] = a1.w;
            b[0] = b0.x; b[1] = b0.y; b[2] = b0.z; b[3] = b0.w; b[4] = b1.x; b[5] = b1.y; b[6] = b1.z; b[7] = b1.w;
#pragma unroll
            for (int i = 0; i < 8; ++i)
#pragma unroll
                for (int j = 0; j < 8; ++j) acc[i][j] = fmaf(a[i], b[j], acc[i][j]);
        }
    }
#pragma unroll
    for (int i = 0; i < 8; ++i) { const float s_ = epi.row8(row0 + ty * 8 + i, col0 + tx * 8, acc[i]); if (Epi::ROWSUM) epi.rowsum(row0 + ty * 8 + i, s_); }
}

struct EpiInProj {
    static constexpr bool ROWSUM = false;
    __device__ __forceinline__ void rowsum(int, float) const {}
    bf16_t *Q, *Kb, *V, *RQ, *RK, *RV, *RG; const float* cs;
    __device__ __forceinline__ float row8(int row, int col, const float* v) const {
        bf16_t* dst; float sc = 1.f; int c = col; bool silu = false;
        if (col < 512) { dst = Q + (size_t)row * 512; sc = QSCALE; }
        else if (col < 1024) { dst = Kb + (size_t)row * 512; c = col - 512; }
        else if (col < 1536) { dst = V + (size_t)row * 512; c = col - 1024; }
        else if (col < 1792) { dst = RQ + (size_t)row * 256; c = col - 1536; }
        else if (col < 2048) { dst = RK + (size_t)row * 256; c = col - 1792; }
        else if (col < 2560) { dst = RV + (size_t)row * 512; c = col - 2048; }
        else { dst = RG + (size_t)row * 512; c = col - 2560; silu = true; }
        const bool rot = (col >= 1536 && col < 2048);
        if (rot) {
            float* raw = rawrot + (size_t)row * 512 + (col - 1536);
#pragma unroll
            for (int j = 0; j < 8; ++j) raw[j] = v[j];
            return 0.f;
        }
        ushort4 o0, o1; float w[8];
#pragma unroll
        for (int j = 0; j < 8; ++j) { float x = v[j] * sc; if (silu) x = x / (1.f + __expf(-x)); w[j] = x; }
        o0.x = f2bf(w[0]); o0.y = f2bf(w[1]); o0.z = f2bf(w[2]); o0.w = f2bf(w[3]); o1.x = f2bf(w[4]); o1.y = f2bf(w[5]); o1.z = f2bf(w[6]); o1.w = f2bf(w[7]);
        *(ushort4*)(dst + c) = o0; *(ushort4*)(dst + c + 4) = o1;
        return 0.f;
    }
    float* rawrot;
};
__device__ __forceinline__ void b_rotary(size_t gid, const float* __restrict__ raw, const float* __restrict__ cs, bf16_t* __restrict__ RQ, bf16_t* __restrict__ RK) {
    const int row = (int)(gid >> 9), c = (int)(gid & 511);
    const int which = c >> 8, cc = c & 255, d = cc & 63, i = d & 31, pos = row & (SEQ - 1);
    const float co = cs[pos * 32 + i], si = cs[4096 * 32 + pos * 32 + i];
    const float* r = raw + (size_t)row * 512 + which * 256 + (cc & ~63);
    const float x1 = r[i], x2 = r[i + 32];
    float o = (d < 32) ? (x1 * co - x2 * si) : (x1 * si + x2 * co);
    if (which) { o *= 0.125f; RK[(size_t)row * 256 + cc] = f2bf(o); } else RQ[(size_t)row * 256 + cc] = f2bf(o);
}

__device__ __forceinline__ void b_mix_naive(int bid, int tid, char* sm, const bf16_t* __restrict__ Q, const bf16_t* __restrict__ Kb, const bf16_t* __restrict__ V,
                                                   const bf16_t* __restrict__ RQ, const bf16_t* __restrict__ RK, const bf16_t* __restrict__ RV, const bf16_t* __restrict__ RG,
                                                   const float* __restrict__ ctl, const float* __restrict__ subln, bf16_t* __restrict__ MIX, int mode) {
    float* q1 = (float*)sm; float* q2 = q1 + 64; float* w = q2 + 64; float* w2 = w + SEQ; float* red = w2 + SEQ; float* part = red + 8;
    const int lane = tid & 63, wid = (tid >> 6) & 3;
    __syncthreads();
    const int h = bid & 3, row = bid >> 2, t = row & (SEQ - 1), rb = row - t;
    if (mode == 0) { if (tid < 64) { q1[tid] = bf2f(Q[(size_t)row * 512 + h * 64 + tid]); q2[tid] = bf2f(Q[(size_t)row * 512 + 256 + h * 64 + tid]); } }
    else { if (tid < 64) q1[tid] = bf2f(RQ[(size_t)row * 256 + h * 64 + tid]); }
    __syncthreads();
    float m1 = -INFINITY, m2 = -INFINITY;
    const float lg = (mode == 1) ? log2f(1.0f - exp2f(-5.0f - (float)h)) : 0.f;
    for (int j = tid; j <= t; j += 256) {
        if (mode == 0) {
            const bf16_t* k1 = Kb + (size_t)(rb + j) * 512 + h * 64; const bf16_t* k2 = k1 + 256;
            float s1 = 0.f, s2 = 0.f;
            for (int d = 0; d < 64; d += 8) {
                const uint4 a = *(const uint4*)(k1 + d), b2 = *(const uint4*)(k2 + d);
                const u32 aw[4] = {a.x, a.y, a.z, a.w}, bw[4] = {b2.x, b2.y, b2.z, b2.w};
#pragma unroll
                for (int e = 0; e < 4; ++e) {
                    s1 += q1[d + 2 * e] * __uint_as_float(aw[e] << 16) + q1[d + 2 * e + 1] * __uint_as_float(aw[e] & 0xffff0000u);
                    s2 += q2[d + 2 * e] * __uint_as_float(bw[e] << 16) + q2[d + 2 * e + 1] * __uint_as_float(bw[e] & 0xffff0000u);
                }
            }
            int dist = t - j; if (dist > 127) dist = 127;
            const float b = ctl[64 + h * 128 + dist];
            s1 += b; s2 += b; w[j] = s1; w2[j] = s2; m1 = fmaxf(m1, s1); m2 = fmaxf(m2, s2);
        } else {
            const bf16_t* k1 = RK + (size_t)(rb + j) * 256 + h * 64;
            float s1 = 0.f;
            for (int d = 0; d < 64; d += 8) {
                const uint4 a = *(const uint4*)(k1 + d);
                const u32 aw[4] = {a.x, a.y, a.z, a.w};
#pragma unroll
                for (int e = 0; e < 4; ++e) s1 += q1[d + 2 * e] * __uint_as_float(aw[e] << 16) + q1[d + 2 * e + 1] * __uint_as_float(aw[e] & 0xffff0000u);
            }
            w[j] = s1 * exp2f((float)(t - j) * lg);
        }
    }
    if (mode == 0) {
        m1 = wave_max(m1); m2 = wave_max(m2);
        if (lane == 0) { red[wid] = m1; red[4 + wid] = m2; }
        __syncthreads();
        m1 = fmaxf(fmaxf(red[0], red[1]), fmaxf(red[2], red[3])); m2 = fmaxf(fmaxf(red[4], red[5]), fmaxf(red[6], red[7]));
        __syncthreads();
        float l1 = 0.f, l2 = 0.f;
        for (int j = tid; j <= t; j += 256) { const float e1 = exp2f(w[j] - m1), e2 = exp2f(w2[j] - m2); w[j] = e1; w2[j] = e2; l1 += e1; l2 += e2; }
        l1 = wave_sum(l1); l2 = wave_sum(l2);
        if (lane == 0) { red[wid] = l1; red[4 + wid] = l2; }
        __syncthreads();
        l1 = red[0] + red[1] + red[2] + red[3]; l2 = red[4] + red[5] + red[6] + red[7];
        const float lam = ctl[0];
        const float i1 = 1.f / l1, i2 = lam / l2;
        for (int j = tid; j <= t; j += 256) w[j] = w[j] * i1 - w2[j] * i2;
    }
    __syncthreads();
    const bf16_t* vs = (mode == 0 ? V : RV) + (size_t)rb * 512 + h * 128 + (tid & 127);
    float acc = 0.f;
    for (int j = (tid >> 7); j <= t; j += 2) acc += w[j] * bf2f(vs[(size_t)j * 512]);
    if (tid >= 128) part[tid - 128] = acc;
    __syncthreads();
    float o = 0.f, ss = 0.f;
    if (tid < 128) { o = acc + part[tid]; ss = o * o; }
    ss = wave_sum(ss);
    if (lane == 0) red[wid] = ss;
    __syncthreads();
    if (tid < 128) {
        const float tot = red[0] + red[1];
        float r;
        if (mode == 0) { r = o * rsqrtf(tot * (1.f / 128) + 1e-5f) * subln[tid] * 0.8f; MIX[(size_t)row * DM + h * 128 + tid] = f2bf(r); }
        else { r = o * rsqrtf(tot * (1.f / 128) + 1e-6f) * bf2f(RG[(size_t)row * 512 + h * 128 + tid]); MIX[(size_t)row * DM + 512 + h * 128 + tid] = f2bf(r); }
    }
}

typedef float f32x2c_t __attribute__((ext_vector_type(2)));
typedef __bf16 bf16x2c_t __attribute__((ext_vector_type(2)));
__device__ __forceinline__ u32 pk2f(float lo, float hi) { const f32x2c_t v = {lo, hi}; return __builtin_bit_cast(u32, __builtin_convertvector(v, bf16x2c_t)); }
__device__ __forceinline__ uint4 pack8(const float* w) { uint4 o; o.x = pk2f(w[0], w[1]); o.y = pk2f(w[2], w[3]); o.z = pk2f(w[4], w[5]); o.w = pk2f(w[6], w[7]); return o; }
template <bool ROT> __device__ __forceinline__ void wave_transpose_item(const float* __restrict__ W, int K, int N, bf16_t* __restrict__ WT, const float* __restrict__ gain, LAS float* scr, int item, int lane) {
    const int nblk = N / 32, kb = item / nblk, nb = item % nblk, k0 = 64 * kb, n0 = 32 * nb;
#pragma unroll 8
    for (int i = 0; i < 32; ++i) { const int kk = 2 * i + (lane >> 5); const float g = gain ? gain[k0 + kk] : 1.f; scr[kk * 33 + (lane & 31)] = W[(size_t)(k0 + kk) * N + n0 + (lane & 31)] * g; }
    asm volatile("s_waitcnt lgkmcnt(0)" ::: "memory");
    const int c = lane & 7;
#pragma unroll
    for (int j = 0; j < 4; ++j) { const int n = (lane >> 3) + 8 * j; const LAS float* sp = scr + (8 * c) * 33 + n;
        uint4 o; o.x = pk2f(sp[0 * 33], sp[1 * 33]); o.y = pk2f(sp[2 * 33], sp[3 * 33]); o.z = pk2f(sp[4 * 33], sp[5 * 33]); o.w = pk2f(sp[6 * 33], sp[7 * 33]);
        *(uint4*)(WT + (size_t)(ROT ? rot_dst_row(n0 + n) : (n0 + n)) * K + k0 + 8 * c) = o; }
    asm volatile("s_waitcnt lgkmcnt(0)" ::: "memory");
}
typedef short bf16x8_t __attribute__((ext_vector_type(8)));
typedef float f32x16_t __attribute__((ext_vector_type(16)));
typedef unsigned u32x4_t __attribute__((ext_vector_type(4)));
typedef unsigned u32x2_t __attribute__((ext_vector_type(2)));
typedef float f32x4_t __attribute__((ext_vector_type(4)));
#define MFMA32(a, b, c) __builtin_amdgcn_mfma_f32_32x32x16_bf16((a), (b), (c), 0, 0, 0)
__device__ __forceinline__ int crow(int r, int hi) { return (r & 3) + 8 * (r >> 2) + 4 * hi; }
__device__ __forceinline__ bf16x8_t pack_p(const f32x16_t& p, int s) {
    u32x4_t w; w.x = pk2f(p[8 * s + 0], p[8 * s + 1]); w.y = pk2f(p[8 * s + 2], p[8 * s + 3]); w.z = pk2f(p[8 * s + 4], p[8 * s + 5]); w.w = pk2f(p[8 * s + 6], p[8 * s + 7]);
    return __builtin_bit_cast(bf16x8_t, w);
}
constexpr int KROW = 144;
constexpr int VROW = 144;
constexpr int AL_K = 0;
constexpr int AL_V = AL_K + 2 * 2 * 64 * KROW;
constexpr int AL_X = 0;
constexpr int AL_ALS = AL_V + 2 * 128 * VROW;
constexpr int AL_TAB = AL_ALS + 8 * 32 * 4;
constexpr int AL_Q = AL_TAB + 1536;
constexpr int AL_END = AL_Q + 8 * 32 * KROW;
static_assert(AL_ALS >= 65536 && AL_END <= 131072, "attention LDS map");

template <int MODE>
__device__ __forceinline__ void attn_unit(LAS unsigned char* lds, int tid, int b, int h, int qb, const bf16_t* __restrict__ Q, const bf16_t* __restrict__ Kb, const bf16_t* __restrict__ VT,
                                          const float* __restrict__ ctl, const float* __restrict__ subln, bf16_t* __restrict__ MIX) {
    asm volatile("" : "+v"(tid));
    const int lane = tid & 63, wave = __builtin_amdgcn_readfirstlane(tid >> 6), map = wave >> 2, qs = wave & 3, ql = lane & 31, hi = lane >> 5;
    const int q0 = qb * 128, q0w = q0 + 32 * qs, nt = 2 * (qb + 1);
    const size_t rowbase = (size_t)b * SEQ;
    LAS float* als = (LAS float*)(lds + AL_ALS) + wave * 32;
    LAS float* tab = (LAS float*)(lds + AL_TAB);
    if (tid < 384) { const int d_ = tid - 128; tab[tid] = d_ < 0 ? 0.f : ctl[64 + h * 128 + (d_ > 127 ? 127 : d_)] - ctl[64 + h * 128 + 127]; }
    LAS unsigned char* qlds = lds + AL_Q + wave * (32 * KROW) + ql * KROW + 16 * hi;
    {
        const bf16_t* qp = Q + (rowbase + q0w + ql) * 512 + map * 256 + h * 64 + 8 * hi;
        bf16x8_t qtmp[4];
#pragma unroll
        for (int ks = 0; ks < 4; ++ks) qtmp[ks] = *(const bf16x8_t*)(qp + 16 * ks);
#pragma unroll
        for (int ks = 0; ks < 4; ++ks) *(LAS bf16x8_t*)(qlds + 32 * ks) = qtmp[ks];
    }
    const int kkey = (tid >> 3) & 63, kc = tid & 7;
    const bf16_t* kg = Kb + (rowbase + kkey) * 512 + h * 64 + 8 * kc;
    const bf16_t* vg = VT + ((size_t)(b * 4 + h) * 128 + (tid >> 3)) * SEQ + 8 * kc;
    const int klds = AL_K + kkey * KROW + 16 * kc, vlds = AL_V + (tid >> 3) * VROW + 16 * kc;
    u32x4_t sk0, sk1, sv0, sv1;
#define ATT_LOADK(t) do { sk0 = *(const u32x4_t*)(kg + (size_t)(t) * 64 * 512); sk1 = *(const u32x4_t*)(kg + (size_t)(t) * 64 * 512 + 256); } while (0)
#define ATT_LOADV(t) do { sv0 = *(const u32x4_t*)(vg + (t) * 64); sv1 = *(const u32x4_t*)(vg + (size_t)64 * SEQ + (t) * 64); } while (0)
#define ATT_STOREK(buf) do { *(LAS u32x4_t*)(lds + klds + (buf) * (2 * 64 * KROW)) = sk0; *(LAS u32x4_t*)(lds + klds + (buf) * (2 * 64 * KROW) + 64 * KROW) = sk1; } while (0)
#define ATT_STOREV(buf) do { *(LAS u32x4_t*)(lds + vlds + (buf) * (128 * VROW)) = sv0; *(LAS u32x4_t*)(lds + vlds + (buf) * (128 * VROW) + 64 * VROW) = sv1; } while (0)
#define ATT_QK(P_, KB_, C0_) do { const LAS unsigned char* kb_ = lds + AL_K + (KB_) * (2 * 64 * KROW) + map * (64 * KROW) + ql * KROW + 16 * hi; \
        _Pragma("unroll") for (int blk = 0; blk < 2; ++blk) { \
            _Pragma("unroll") for (int ks = 0; ks < 4; ++ks) { const bf16x8_t a_ = *(const LAS bf16x8_t*)(kb_ + blk * 32 * KROW + 32 * ks); const bf16x8_t q_ = *(const LAS bf16x8_t*)(qlds + 32 * ks); \
                if (ks == 0) P_[blk] = MFMA32(a_, q_, C0_); else P_[blk] = MFMA32(a_, q_, P_[blk]); } } } while (0)
#define ATT_VLD(W_, VB_, G_) do { const LAS unsigned char* vq_ = lds + AL_V + (VB_) * (128 * VROW) + ql * VROW + 16 * hi + 32 * (G_); \
        _Pragma("unroll") for (int cb = 0; cb < 4; ++cb) W_[cb] = *(const LAS u32x4_t*)(vq_ + cb * 32 * VROW); } while (0)
#define ATT_EXPC(P_, G_, C_, W_) do { const float x0_ = P_[(G_) >> 1][8 * ((G_) & 1) + 2 * (C_)], x1_ = P_[(G_) >> 1][8 * ((G_) & 1) + 2 * (C_) + 1]; \
        const float a_ = (MODE & 4) ? x0_ : __builtin_amdgcn_exp2f(x0_), b_ = (MODE & 4) ? x1_ : __builtin_amdgcn_exp2f(x1_); \
        W_[C_] = pk2f(a_, b_); ls0_ += a_; ls1_ += b_; } while (0)
#define ATT_SLOT(P_, G_, CB_, WC_, VC_, WN_) do { \
        if (!(MODE & 16)) o[CB_] = MFMA32(__builtin_bit_cast(bf16x8_t, WC_), __builtin_bit_cast(bf16x8_t, VC_[CB_]), o[CB_]); \
        if ((G_) < 3) { ATT_EXPC(P_, ((G_) + 1) & 3, CB_, WN_); asm volatile("" : "+v"(ls0_), "+v"(ls1_)); }        \
        __builtin_amdgcn_sched_barrier(0); } while (0)
#define ATT_SMPV(P_, PN_, KT_, VB_) do { \
        u32x4_t vA_[4], vB_[4]; \
        ATT_VLD(vA_, VB_, 0); \
        if ((KT_) + 4 >= nt) { const int db_ = q0w + ql - 64 * (KT_) - 4 * hi;        \
            const LAS float* tp_ = tab + (128 - 59) + db_; \
            _Pragma("unroll") for (int blk = 0; blk < 2; ++blk) { float bs_[16]; \
                _Pragma("unroll") for (int r = 0; r < 16; ++r) bs_[r] = tp_[59 - (32 * blk + (r & 3) + 8 * (r >> 2))]; \
                _Pragma("unroll") for (int r = 0; r < 16; ++r) asm volatile("" : "+v"(bs_[r])); \
                _Pragma("unroll") for (int r = 0; r < 16; ++r) P_[blk][r] = db_ < (32 * blk + (r & 3) + 8 * (r >> 2)) ? -INFINITY : P_[blk][r] + bs_[r]; } } \
        float rm_ = P_[0][0]; \
        _Pragma("unroll") for (int r = 1; r < 16; ++r) rm_ = fmaxf(rm_, P_[0][r]); \
        _Pragma("unroll") for (int r = 0; r < 16; ++r) rm_ = fmaxf(rm_, P_[1][r]); \
        rm_ = fmaxf(rm_, __shfl_xor(rm_, 32)); \
          \
          \
        if (__any(rm_ > 8.0f || ((KT_) == 0 && rm_ < -8.0f))) { \
            const float dl_ = (KT_) == 0 ? rm_ : fmaxf(rm_, 0.f); \
            const float alpha_ = __builtin_amdgcn_exp2f(-dl_); \
            l *= alpha_; \
            if (hi == 0) als[ql] = alpha_; \
            asm volatile("s_waitcnt lgkmcnt(0)" ::: "memory"); \
            float al_[16]; \
            _Pragma("unroll") for (int r = 0; r < 16; ++r) al_[r] = als[crow(r, hi)]; \
            _Pragma("unroll") for (int cb = 0; cb < 4; ++cb) _Pragma("unroll") for (int r = 0; r < 16; ++r) o[cb][r] *= al_[r]; \
            _Pragma("unroll") for (int blk = 0; blk < 2; ++blk) _Pragma("unroll") for (int r = 0; r < 16; ++r) { P_[blk][r] -= dl_; PN_[blk][r] -= dl_; } \
            _Pragma("unroll") for (int r = 0; r < 16; ++r) negm[r] -= dl_; } \
        float ls0_ = 0.f, ls1_ = 0.f; \
        u32x4_t wE_, wO_;        \
        ATT_EXPC(P_, 0, 0, wE_); ATT_EXPC(P_, 0, 1, wE_); ATT_EXPC(P_, 0, 2, wE_); ATT_EXPC(P_, 0, 3, wE_); ATT_VLD(vB_, VB_, 1); \
        __builtin_amdgcn_sched_barrier(0); \
        ATT_SLOT(P_, 0, 0, wE_, vA_, wO_); ATT_SLOT(P_, 0, 1, wE_, vA_, wO_); ATT_SLOT(P_, 0, 2, wE_, vA_, wO_); ATT_SLOT(P_, 0, 3, wE_, vA_, wO_); \
        ATT_VLD(vA_, VB_, 2); \
        ATT_SLOT(P_, 1, 0, wO_, vB_, wE_); ATT_SLOT(P_, 1, 1, wO_, vB_, wE_); ATT_SLOT(P_, 1, 2, wO_, vB_, wE_); ATT_SLOT(P_, 1, 3, wO_, vB_, wE_); \
        ATT_VLD(vB_, VB_, 3); \
        ATT_SLOT(P_, 2, 0, wE_, vA_, wO_); ATT_SLOT(P_, 2, 1, wE_, vA_, wO_); ATT_SLOT(P_, 2, 2, wE_, vA_, wO_); ATT_SLOT(P_, 2, 3, wE_, vA_, wO_); \
        ATT_SLOT(P_, 3, 0, wO_, vB_, wE_); ATT_SLOT(P_, 3, 1, wO_, vB_, wE_); ATT_SLOT(P_, 3, 2, wO_, vB_, wE_); ATT_SLOT(P_, 3, 3, wO_, vB_, wE_); \
        l += ls0_ + ls1_; } while (0)
#define ATT_ITER(PC_, PN_, KT_) do { \
        { const int tk_ = (KT_) + 2 < nt ? (KT_) + 2 : nt - 1, tv_ = (KT_) + 1 < nt ? (KT_) + 1 : nt - 1;     \
          if (!(MODE & 8)) { ATT_LOADK(tk_); ATT_LOADV(tv_); } }                                                                  \
        if (!(MODE & 32)) ATT_QK(PN_, ((KT_) + 1) & 1, negm); \
        __builtin_amdgcn_sched_barrier(0); \
        ATT_SMPV(PC_, PN_, (KT_), (KT_) & 1); \
        if (!(MODE & 8)) { ATT_STOREK((KT_) & 1); ATT_STOREV(((KT_) + 1) & 1); } \
        if (!(MODE & 2)) __syncthreads(); } while (0)
    ATT_LOADK(0); ATT_LOADV(0);
    __syncthreads();
    ATT_STOREK(0); ATT_STOREV(0);
    ATT_LOADK(1);
    ATT_STOREK(1);
    __syncthreads();
    f32x16_t o[4];
#pragma unroll
    for (int cb = 0; cb < 4; ++cb) o[cb] = (f32x16_t){0.f, 0.f, 0.f, 0.f, 0.f, 0.f, 0.f, 0.f, 0.f, 0.f, 0.f, 0.f, 0.f, 0.f, 0.f, 0.f};
    float l = 0.f;
    f32x16_t pA[2], pB[2];
    f32x16_t negm;
    {
        const f32x16_t zero16 = (f32x16_t){0.f, 0.f, 0.f, 0.f, 0.f, 0.f, 0.f, 0.f, 0.f, 0.f, 0.f, 0.f, 0.f, 0.f, 0.f, 0.f};
        ATT_QK(pA, 0, zero16);
        float m0 = pA[0][0];
#pragma unroll
        for (int r = 1; r < 16; ++r) m0 = fmaxf(m0, pA[0][r]);
#pragma unroll
        for (int r = 0; r < 16; ++r) m0 = fmaxf(m0, pA[1][r]);
        m0 = fmaxf(m0, __shfl_xor(m0, 32));
#pragma unroll
        for (int r = 0; r < 16; ++r) { pA[0][r] -= m0; pA[1][r] -= m0; negm[r] = -m0; }
    }
#pragma unroll 1
    for (int kt = 0; kt < nt; kt += 2) {
        ATT_ITER(pA, pB, kt);
        ATT_ITER(pB, pA, kt + 1);
    }
#undef ATT_LOADK
#undef ATT_LOADV
#undef ATT_STOREK
#undef ATT_STOREV
#undef ATT_QK
#undef ATT_SMPV
#undef ATT_VLD
#undef ATT_EXPC
#undef ATT_SLOT
#undef ATT_ITER
    l += __shfl_xor(l, 32);
    if (hi == 0) als[ql] = 1.0f / l;
    asm volatile("s_waitcnt lgkmcnt(0)" ::: "memory");
    float il[16];
#pragma unroll
    for (int r = 0; r < 16; ++r) il[r] = als[crow(r, hi)];
    LAS float* xo = (LAS float*)(lds + AL_X) + qs * (32 * 128);
    if (map == 1) {
#pragma unroll
        for (int cb = 0; cb < 4; ++cb)
#pragma unroll
            for (int r = 0; r < 16; ++r) xo[crow(r, hi) * 128 + 32 * cb + ql] = o[cb][r] * il[r];
    }
    __syncthreads();
    if (map == 0) {
        const float lam = ctl[0];
        float ss[16];
#pragma unroll
        for (int r = 0; r < 16; ++r) ss[r] = 0.f;
#pragma unroll
        for (int cb = 0; cb < 4; ++cb)
#pragma unroll
            for (int r = 0; r < 16; ++r) { const float d = o[cb][r] * il[r] - lam * xo[crow(r, hi) * 128 + 32 * cb + ql]; o[cb][r] = d; ss[r] += d * d; }
#pragma unroll
        for (int r = 0; r < 16; ++r) {
            float s = ss[r];
            s += __shfl_xor(s, 1); s += __shfl_xor(s, 2); s += __shfl_xor(s, 4); s += __shfl_xor(s, 8); s += __shfl_xor(s, 16);
            ss[r] = rsqrtf(s * (1.f / 128) + 1e-5f) * 0.8f;
        }
#pragma unroll
        for (int cb = 0; cb < 4; ++cb) {
            const float g = subln[32 * cb + ql];
#pragma unroll
            for (int r = 0; r < 16; ++r) if (!(MODE & 1)) MIX[(rowbase + q0w + crow(r, hi)) * DM + h * 128 + 32 * cb + ql] = f2bf(o[cb][r] * ss[r] * g);
        }
    }
    __syncthreads();
}

__device__ __forceinline__ void ret_kv_unit(int tid, int bh, int n, const bf16_t* __restrict__ RVT, const bf16_t* __restrict__ RKT, float* __restrict__ KVT) {
    const int lane = tid & 63, wave = tid >> 6, rb = wave & 3, cbk = wave >> 2, ql = lane & 31, hi = lane >> 5, h = bh & 3;
    const float lg = log2f(1.0f - exp2f(-5.0f - (float)h));
    const bf16_t* ap = RVT + ((size_t)bh * 128 + 32 * rb + ql) * SEQ + 128 * n + 8 * hi;
    const bf16_t* bp = RKT + ((size_t)bh * 64 + 32 * cbk + ql) * SEQ + 128 * n + 8 * hi;
    f32x16_t acc = (f32x16_t){0.f, 0.f, 0.f, 0.f, 0.f, 0.f, 0.f, 0.f, 0.f, 0.f, 0.f, 0.f, 0.f, 0.f, 0.f, 0.f};
#pragma unroll
    for (int s = 0; s < 8; ++s) {
        const bf16x8_t a = *(const bf16x8_t*)(ap + 16 * s);
        const uint4 kw = *(const uint4*)(bp + 16 * s);
        const u32 kk[4] = {kw.x, kw.y, kw.z, kw.w};
        u32x4_t w;
        u32 ww[4];
#pragma unroll
        for (int e = 0; e < 4; ++e) {
            const int key = 16 * s + 8 * hi + 2 * e;
            const float z0 = exp2f((float)(127 - key) * lg), z1 = exp2f((float)(126 - key) * lg);
            ww[e] = pk2f(__uint_as_float(kk[e] << 16) * z0, __uint_as_float(kk[e] & 0xffff0000u) * z1);
        }
        w.x = ww[0]; w.y = ww[1]; w.z = ww[2]; w.w = ww[3];
        acc = MFMA32(a, __builtin_bit_cast(bf16x8_t, w), acc);
    }
    float* out = KVT + ((size_t)(bh * 32 + n) * 128 + 32 * rb) * 64 + 32 * cbk + ql;
#pragma unroll
    for (int r = 0; r < 16; ++r) out[crow(r, hi) * 64] = acc[r];
}
__device__ __forceinline__ void ret_scan(int e, const float* __restrict__ KVT, bf16_t* __restrict__ ST) {
    const int bh = e >> 13, idx = e & 8191, h = bh & 3;
    const float cd = exp2f(128.0f * log2f(1.0f - exp2f(-5.0f - (float)h)));
    float s = 0.f;
    for (int n = 0; n < 32; ++n) {
        ST[((size_t)(bh * 32 + n) << 13) + idx] = f2bf(s);
        s = s * cd + KVT[((size_t)(bh * 32 + n) << 13) + idx];
    }
}
constexpr int RVROW = 272;
constexpr int RL_K = 0;
constexpr int RL_V = RL_K + 128 * KROW;
constexpr int RL_S = RL_V + 128 * RVROW;
constexpr int RL_DT = RL_S + 128 * KROW;
constexpr int RL_BUF = RL_DT + 512;
constexpr int RL_SS = 2 * RL_BUF;
constexpr int RL_END = RL_SS + 4 * 2 * 32 * 4;
static_assert(RL_END <= 147456 - 256, "retention LDS map");
__device__ __forceinline__ void ret_out_units(LAS unsigned char* lds0, int tid, int u0, int ustep, int nunits, const bf16_t* __restrict__ RQ, const bf16_t* __restrict__ RK, const bf16_t* __restrict__ RVT,
                                              const bf16_t* __restrict__ ST, const bf16_t* __restrict__ RG, bf16_t* __restrict__ MIX) {
    asm volatile("" : "+v"(tid));
    const int lane = tid & 63, wave = __builtin_amdgcn_readfirstlane(tid >> 6), qs = wave & 3, dvh = wave >> 2, ql = lane & 31, hi = lane >> 5;
    u32x4_t rk[2], rv[4], rs[2];
#define RL_LOAD(U_) do { const int bh_ = (U_) >> 5, n_ = (U_) & 31; const size_t r0_ = (size_t)(bh_ >> 2) * SEQ + 128 * n_; \
        _Pragma("unroll") for (int q = 0; q < 2; ++q) { const int i_ = tid + 512 * q, key = i_ >> 3, c = i_ & 7; rk[q] = *(const u32x4_t*)(RK + (r0_ + key) * 256 + (bh_ & 3) * 64 + 8 * c); } \
        _Pragma("unroll") for (int q = 0; q < 4; ++q) { const int i_ = tid + 512 * q, dv = i_ >> 4, c = i_ & 15; rv[q] = *(const u32x4_t*)(RVT + ((size_t)bh_ * 128 + dv) * SEQ + 128 * n_ + 8 * c); } \
        _Pragma("unroll") for (int q = 0; q < 2; ++q) { const int i_ = tid + 512 * q, dv = i_ >> 3, c = i_ & 7; rs[q] = *(const u32x4_t*)(ST + ((size_t)(U_) << 13) + dv * 64 + 8 * c); } } while (0)
#define RL_STORE(L_) do { \
        _Pragma("unroll") for (int q = 0; q < 2; ++q) { const int i_ = tid + 512 * q, key = i_ >> 3, c = i_ & 7; *(LAS u32x4_t*)((L_) + RL_K + key * KROW + 16 * c) = rk[q]; } \
        _Pragma("unroll") for (int q = 0; q < 4; ++q) { const int i_ = tid + 512 * q, dv = i_ >> 4, c = i_ & 15; *(LAS u32x4_t*)((L_) + RL_V + dv * RVROW + 16 * c) = rv[q]; } \
        _Pragma("unroll") for (int q = 0; q < 2; ++q) { const int i_ = tid + 512 * q, dv = i_ >> 3, c = i_ & 7; *(LAS u32x4_t*)((L_) + RL_S + dv * KROW + 16 * c) = rs[q]; } } while (0)
    RL_LOAD(u0 < nunits ? u0 : 0);
    int it = 0;
#pragma unroll 1
  for (int u = u0; u < nunits; u += ustep, ++it) {
    LAS unsigned char* lds = lds0 + (it & 1) * RL_BUF;
    const int bh = u >> 5, n = u & 31, b = bh >> 2, h = bh & 3;
    const size_t row0 = (size_t)b * SEQ + 128 * n;
    const float lg = log2f(1.0f - exp2f(-5.0f - (float)h));
    __syncthreads();
    RL_STORE(lds);
    if (tid < 128) ((LAS float*)(lds + RL_DT))[tid] = exp2f((float)tid * lg);
    bf16x8_t qf[4];
    {
        const bf16_t* qp = RQ + (row0 + 32 * qs + ql) * 256 + h * 64 + 8 * hi;
#pragma unroll
        for (int ks = 0; ks < 4; ++ks) qf[ks] = *(const bf16x8_t*)(qp + 16 * ks);
    }
    __syncthreads();
    { const int un_ = u + ustep < nunits ? u + ustep : u; RL_LOAD(un_); }
    const LAS float* dt = (const LAS float*)(lds + RL_DT);
    f32x16_t o[2];
    o[0] = (f32x16_t){0.f, 0.f, 0.f, 0.f, 0.f, 0.f, 0.f, 0.f, 0.f, 0.f, 0.f, 0.f, 0.f, 0.f, 0.f, 0.f}; o[1] = o[0];
    const int qloc = 32 * qs + ql;
    for (int kb = 0; kb <= qs; ++kb) {
        f32x16_t p = (f32x16_t){0.f, 0.f, 0.f, 0.f, 0.f, 0.f, 0.f, 0.f, 0.f, 0.f, 0.f, 0.f, 0.f, 0.f, 0.f, 0.f};
        const LAS unsigned char* kp = lds + RL_K + (32 * kb + ql) * KROW + 16 * hi;
#pragma unroll
        for (int ks = 0; ks < 4; ++ks) { const bf16x8_t a = *(const LAS bf16x8_t*)(kp + 32 * ks); p = MFMA32(a, qf[ks], p); }
#pragma unroll
        for (int r = 0; r < 16; ++r) { const int dist = qloc - (32 * kb + crow(r, hi)); p[r] = dist < 0 ? 0.f : p[r] * dt[dist < 0 ? 0 : dist]; }
#pragma unroll
        for (int s = 0; s < 2; ++s) {
            const bf16x8_t pa = pack_p(p, s);
#pragma unroll
            for (int cbl = 0; cbl < 2; ++cbl) {
                const LAS unsigned char* vp = lds + RL_V + (64 * dvh + 32 * cbl + ql) * RVROW + (32 * kb + 16 * s) * 2 + 8 * hi;
                const u32x2_t lo = *(const LAS u32x2_t*)vp, hi2 = *(const LAS u32x2_t*)(vp + 16);
                u32x4_t w; w.x = lo.x; w.y = lo.y; w.z = hi2.x; w.w = hi2.y;
                o[cbl] = MFMA32(pa, __builtin_bit_cast(bf16x8_t, w), o[cbl]);
            }
        }
    }
    if (n > 0) {
        const float xi = exp2f((float)(qloc + 1) * lg);
#pragma unroll
        for (int ks = 0; ks < 4; ++ks) {
            u32x4_t qw = __builtin_bit_cast(u32x4_t, qf[ks]);
            u32 qq[4] = {qw.x, qw.y, qw.z, qw.w};
#pragma unroll
            for (int e = 0; e < 4; ++e) qq[e] = pk2f(__uint_as_float(qq[e] << 16) * xi, __uint_as_float(qq[e] & 0xffff0000u) * xi);
            qw.x = qq[0]; qw.y = qq[1]; qw.z = qq[2]; qw.w = qq[3];
            const bf16x8_t qx = __builtin_bit_cast(bf16x8_t, qw);
#pragma unroll
            for (int cbl = 0; cbl < 2; ++cbl) {
                const bf16x8_t bs = *(const LAS bf16x8_t*)(lds + RL_S + (64 * dvh + 32 * cbl + ql) * KROW + 32 * ks + 16 * hi);
                o[cbl] = MFMA32(qx, bs, o[cbl]);
            }
        }
    }
    float ss[16];
#pragma unroll
    for (int r = 0; r < 16; ++r) {
        float s = o[0][r] * o[0][r] + o[1][r] * o[1][r];
        s += __shfl_xor(s, 1); s += __shfl_xor(s, 2); s += __shfl_xor(s, 4); s += __shfl_xor(s, 8); s += __shfl_xor(s, 16);
        ss[r] = s;
    }
    LAS float* sx = (LAS float*)(lds0 + RL_SS);
    if (ql == 0) {
#pragma unroll
        for (int r = 0; r < 16; ++r) sx[(qs * 2 + dvh) * 32 + crow(r, hi)] = ss[r];
    }
    __syncthreads();
#pragma unroll
    for (int r = 0; r < 16; ++r) ss[r] = rsqrtf((sx[(qs * 2) * 32 + crow(r, hi)] + sx[(qs * 2 + 1) * 32 + crow(r, hi)]) * (1.f / 128) + 1e-6f);
    {
        LAS float* wt = (LAS float*)(lds + wave * 8704);
#pragma unroll
        for (int cbl = 0; cbl < 2; ++cbl)
#pragma unroll
            for (int r = 0; r < 16; ++r) wt[crow(r, hi) * 68 + 32 * cbl + ql] = o[cbl][r] * ss[r];
#pragma unroll
        for (int ps = 0; ps < 4; ++ps) {
            const int rr = 8 * ps + (lane >> 3), c8 = 8 * (lane & 7);
            const f32x4_t a0 = *(const LAS f32x4_t*)(wt + rr * 68 + c8), a1 = *(const LAS f32x4_t*)(wt + rr * 68 + c8 + 4);
            const size_t row = row0 + 32 * qs + rr; const int col = h * 128 + 64 * dvh + c8;
            const uint4 gw = *(const uint4*)(RG + row * 512 + col);
            const float w8[8] = {a0[0] * __uint_as_float(gw.x << 16), a0[1] * __uint_as_float(gw.x & 0xffff0000u), a0[2] * __uint_as_float(gw.y << 16), a0[3] * __uint_as_float(gw.y & 0xffff0000u),
                                 a1[0] * __uint_as_float(gw.z << 16), a1[1] * __uint_as_float(gw.z & 0xffff0000u), a1[2] * __uint_as_float(gw.w << 16), a1[3] * __uint_as_float(gw.w & 0xffff0000u)};
            *(uint4*)(MIX + row * DM + 512 + col) = pack8(w8);
        }
    }
  }
#undef RL_LOAD
#undef RL_STORE
}
__host__ __device__ __forceinline__ int rot_dst_row(int n) {
    if (n < 1536 || n >= 2048) return n;
    const int o = (n - 1536) & 255, base = n - o, head = o >> 6, d = o & 63, half = d >> 5, p = d & 31;
    return base + 8 * (head * 8 + (p >> 2)) + (p & 3) + 4 * half;
}
struct EpiInProjT {
    static constexpr bool PERM = true, AFTER_DRAIN = false;
    unsigned char* ws; const float* cs;
#define EPI_FOREACH(...) _Pragma("unroll") for (int ai = 0; ai < 2; ++ai) _Pragma("unroll") for (int m = 0; m < 4; ++m) { const int row = row0 + ai * 128 + m * 16; \
        _Pragma("unroll") for (int bj = 0; bj < 2; ++bj) { const int lc = lc0 + bj * 128; \
            const float v[8] = {acc[ai][bj][m][0][0], acc[ai][bj][m][0][1], acc[ai][bj][m][0][2], acc[ai][bj][m][0][3], acc[ai][bj][m][1][0], acc[ai][bj][m][1][1], acc[ai][bj][m][1][2], acc[ai][bj][m][1][3]}; __VA_ARGS__ } \
        asm volatile("" ::: "memory"); }
    __device__ __forceinline__ void operator()(const pg8::f32x4 (&acc)[2][2][4][2], const pg8::Unit& u, int wr, int wc, int fr, int fq) const {
        const int pn = __builtin_amdgcn_readfirstlane(u.pn);
        const int row0 = u.pm * 256 + wr * 64 + fr, lc0 = wc * 32 + 8 * fq;
        if (pn < 4) {
            const float sc = pn < 2 ? QSCALE : 1.f;
            bf16_t* base = (bf16_t*)(ws + (pn < 2 ? WS_Q : WS_K)) + (pn & 1) * 256;
            EPI_FOREACH({ const float w[8] = {v[0] * sc, v[1] * sc, v[2] * sc, v[3] * sc, v[4] * sc, v[5] * sc, v[6] * sc, v[7] * sc}; *(uint4*)(base + (size_t)row * 512 + lc) = pack8(w); })
        } else if (pn == 6 || pn == 7) {
            const bool isk = pn == 7; const float sc = isk ? 0.125f : 1.f;
            bf16_t* base = (bf16_t*)(ws + (isk ? WS_RK : WS_RQ));
            EPI_FOREACH({ const int j = lc >> 3, head = j >> 3, p = 4 * (j & 7), pos = row & (SEQ - 1);
                const float4 co = *(const float4*)(cs + pos * 32 + p), si = *(const float4*)(cs + 4096 * 32 + pos * 32 + p);
                uint2 a, b;
                a.x = pk2f((v[0] * co.x - v[4] * si.x) * sc, (v[1] * co.y - v[5] * si.y) * sc); a.y = pk2f((v[2] * co.z - v[6] * si.z) * sc, (v[3] * co.w - v[7] * si.w) * sc);
                b.x = pk2f((v[0] * si.x + v[4] * co.x) * sc, (v[1] * si.y + v[5] * co.y) * sc); b.y = pk2f((v[2] * si.z + v[6] * co.z) * sc, (v[3] * si.w + v[7] * co.w) * sc);
                bf16_t* dst = base + (size_t)row * 256 + head * 64 + p;
                *(uint2*)dst = a; *(uint2*)(dst + 32) = b;
                if (isk) {
                    bf16_t* kt = (bf16_t*)(ws + WS_RKT) + ((size_t)((row >> 12) * 4 + head) * 64 + p) * SEQ + pos;
                    const u32 wv[4] = {a.x, a.y, b.x, b.y};
                    _Pragma("unroll") for (int q = 0; q < 4; ++q) { *kt = (bf16_t)wv[q]; kt += SEQ; asm volatile("" : "+v"(kt)); *kt = (bf16_t)(wv[q] >> 16); kt += (q == 1 ? (size_t)29 * SEQ : (size_t)SEQ); asm volatile("" : "+v"(kt)); }
                } })
        } else if (pn >= 10) {
            bf16_t* base = (bf16_t*)(ws + WS_RG) + (pn - 10) * 256;
            EPI_FOREACH({ float w[8]; _Pragma("unroll") for (int q = 0; q < 8; ++q) w[q] = v[q] / (1.f + __expf(-v[q])); *(uint4*)(base + (size_t)row * 512 + lc) = pack8(w); })
        } else {
            bf16_t* base = (bf16_t*)(ws + (pn >= 8 ? WS_RV : WS_VV));
            const int cb = (pn & 1) * 256;
            EPI_FOREACH({ const int c = cb + lc, tp = row & (SEQ - 1), tq = pn >= 8 ? tp : ((tp & ~12) | ((tp & 4) << 1) | ((tp & 8) >> 1));
                bf16_t* vt = base + ((size_t)((row >> 12) * 4 + (c >> 7)) * 128 + (c & 127)) * SEQ + tq;
                _Pragma("unroll") for (int q = 0; q < 8; q += 2) { const u32 w = pk2f(v[q], v[q + 1]); *vt = (bf16_t)w; vt += SEQ; asm volatile("" : "+v"(vt)); *vt = (bf16_t)(w >> 16); vt += SEQ; asm volatile("" : "+v"(vt)); } })
        }
    }
#undef EPI_FOREACH
};

struct EpiOutProj {
    static constexpr bool ROWSUM = true;
    const float* x; float* H; bf16_t* HB; float* rss;
    __device__ __forceinline__ void rowsum(int row, float s) const { atomicAdd(rss + row, s); }
    __device__ __forceinline__ float row8(int row, int col, const float* v) const {
        const float4 x0 = *(const float4*)(x + (size_t)row * DM + col), x1 = *(const float4*)(x + (size_t)row * DM + col + 4);
        const float hh[8] = {x0.x + v[0], x0.y + v[1], x0.z + v[2], x0.w + v[3], x1.x + v[4], x1.y + v[5], x1.z + v[6], x1.w + v[7]};
        *(uint4*)(HB + (size_t)row * DM + col) = pack8(hh);
        float s = 0.f;
#pragma unroll
        for (int j = 0; j < 8; ++j) s += hh[j] * hh[j];
        return s;
    }
};
struct EpiQry {
    static constexpr bool ROWSUM = false;
    bf16_t* QRY; const float* rss;
    __device__ __forceinline__ void rowsum(int, float) const {}
    __device__ __forceinline__ float row8(int row, int col, const float* v) const {
        const float r = rsqrtf(rss[row] * (1.f / DM) + 1e-6f);
        const float w[8] = {v[0] * r, v[1] * r, v[2] * r, v[3] * r, v[4] * r, v[5] * r, v[6] * r, v[7] * r};
        *(uint4*)(QRY + (size_t)row * 2048 + col) = pack8(w);
        return 0.f;
    }
};
struct EpiPP {
    static constexpr bool ROWSUM = false;
    bf16_t* PP;
    __device__ __forceinline__ void rowsum(int, float) const {}
    __device__ __forceinline__ float row8(int row, int col, const float* v) const { *(uint4*)(PP + (size_t)row * DM + col) = pack8(v); return 0.f; }
};
struct EpiGate {
    static constexpr bool ROWSUM = true;
    const bf16_t* HBr; const bf16_t* PP; const float* bg; const float* rss2; float* rss3; bf16_t* H3B;
    __device__ __forceinline__ void rowsum(int row, float s) const { atomicAdd(rss3 + row, s); }
    __device__ __forceinline__ float row8(int row, int col, const float* v) const {
        const float r = rsqrtf(rss2[row] * (1.f / DM) + 1e-6f);
        const uint4 pw = *(const uint4*)(PP + (size_t)row * DM + col), hw = *(const uint4*)(HBr + (size_t)row * DM + col);
        const float4 b0 = *(const float4*)(bg + col), b1 = *(const float4*)(bg + col + 4);
        const float hv[8] = {__uint_as_float(hw.x << 16), __uint_as_float(hw.x & 0xffff0000u), __uint_as_float(hw.y << 16), __uint_as_float(hw.y & 0xffff0000u),
                             __uint_as_float(hw.z << 16), __uint_as_float(hw.z & 0xffff0000u), __uint_as_float(hw.w << 16), __uint_as_float(hw.w & 0xffff0000u)};
        const float bb[8] = {b0.x, b0.y, b0.z, b0.w, b1.x, b1.y, b1.z, b1.w};
        const float pp[8] = {__uint_as_float(pw.x << 16), __uint_as_float(pw.x & 0xffff0000u), __uint_as_float(pw.y << 16), __uint_as_float(pw.y & 0xffff0000u),
                             __uint_as_float(pw.z << 16), __uint_as_float(pw.z & 0xffff0000u), __uint_as_float(pw.w << 16), __uint_as_float(pw.w & 0xffff0000u)};
        float o[8], s = 0.f;
#pragma unroll
        for (int j = 0; j < 8; ++j) { const float g = 1.f / (1.f + __expf(-(v[j] * r + bb[j]))); o[j] = hv[j] + g * pp[j]; s += o[j] * o[j]; }
        *(uint4*)(H3B + (size_t)row * DM + col) = pack8(o);
        return s;
    }
};

__device__ __forceinline__ void b_peer_topk(int tok, int tid, char* sm, const bf16_t* __restrict__ QRY, const bf16_t* __restrict__ SUBK, int* __restrict__ IDX, float* __restrict__ GATE) {
    float* q = (float*)sm; float* sc = q + 2048; float (*tv)[16] = (float (*)[16])(sc + 2048); int (*ti)[16] = (int (*)[16])(sc + 2048 + 256);
    __syncthreads();
    for (int i = tid; i < 2048; i += 256) q[i] = bf2f(QRY[(size_t)tok * 2048 + i]);
    __syncthreads();
    for (int s = tid; s < 2048; s += 256) {
        const int hc = s >> 7;
        const bf16_t* kr = SUBK + (size_t)s * 128; const float* qq = q + hc * 128;
        float a = 0.f;
        for (int d = 0; d < 128; ++d) a += qq[d] * bf2f(kr[d]);
        sc[s] = a;
    }
    __syncthreads();
    if (tid < 16) {
        float* s = sc + tid * 128;
        for (int r = 0; r < 16; ++r) {
            float best = -INFINITY; int bi = 0;
            for (int k = 0; k < 128; ++k) { const float x = s[k]; if (x > best) { best = x; bi = k; } }
            tv[tid][r] = best; ti[tid][r] = bi; s[bi] = -INFINITY;
        }
    }
    __syncthreads();
    if (tid < 8) {
        const int h = tid;
        unsigned used[8] = {0, 0, 0, 0, 0, 0, 0, 0};
        float ts[16]; int te[16];
        for (int r = 0; r < 16; ++r) {
            float best = -INFINITY; int bc = 0;
            for (int c = 0; c < 256; ++c) {
                if (used[c >> 5] & (1u << (c & 31))) continue;
                const float x = tv[2 * h][c >> 4] + tv[2 * h + 1][c & 15];
                if (x > best) { best = x; bc = c; }
            }
            used[bc >> 5] |= 1u << (bc & 31);
            ts[r] = best; te[r] = ti[2 * h][bc >> 4] * 128 + ti[2 * h + 1][bc & 15];
        }
        float mx = ts[0], sum = 0.f;
        for (int r = 0; r < 16; ++r) { ts[r] = __expf(ts[r] - mx); sum += ts[r]; }
        for (int r = 0; r < 16; ++r) { IDX[(size_t)tok * 128 + h * 16 + r] = te[r]; GATE[(size_t)tok * 128 + h * 16 + r] = ts[r] / sum; }
    }
}
__device__ __forceinline__ void b_peer_gather(int tok, int tid, char* sm, const bf16_t* __restrict__ U, const bf16_t* __restrict__ Vt, const int* __restrict__ IDX, const float* __restrict__ GATE,
                                                     float* __restrict__ H, bf16_t* __restrict__ HB, const float* __restrict__ rss1, float* __restrict__ rss2) {
    float* hrow = (float*)sm; float* a = hrow + 1024; int* ex = (int*)(a + 128); float* red = (float*)(ex + 128);
    const int lane = tid & 63, wid = (tid >> 6) & 3;
    __syncthreads();
    for (int i = tid; i < 1024; i += 256) hrow[i] = bf2f(HB[(size_t)tok * DM + i]);
    if (tid < 128) ex[tid] = IDX[(size_t)tok * 128 + tid];
    __syncthreads();
    const float r1 = rsqrtf(rss1[tok] * (1.f / DM) + 1e-6f);
    for (int e = wid * 32; e < wid * 32 + 32; ++e) {
        const bf16_t* ur = U + (size_t)ex[e] * DM + lane * 16;
        float d = 0.f;
#pragma unroll
        for (int j = 0; j < 16; ++j) d += bf2f(ur[j]) * hrow[lane * 16 + j];
        d = wave_sum(d);
        if (lane == 0) { const float z = d * r1; a[e] = 0.5f * z * (1.f + erff(z * 0.70710678118654752f)) * GATE[(size_t)tok * 128 + e]; }
    }
    __syncthreads();
    float acc[4] = {0.f, 0.f, 0.f, 0.f};
    for (int e = 0; e < 128; ++e) {
        const ushort4 v = *(const ushort4*)(Vt + (size_t)ex[e] * DM + tid * 4);
        const float ae = a[e];
        acc[0] += ae * bf2f(v.x); acc[1] += ae * bf2f(v.y); acc[2] += ae * bf2f(v.z); acc[3] += ae * bf2f(v.w);
    }
    float4 hv = *(float4*)(H + (size_t)tok * DM + tid * 4);
    hv.x += acc[0]; hv.y += acc[1]; hv.z += acc[2]; hv.w += acc[3];
    *(float4*)(H + (size_t)tok * DM + tid * 4) = hv;
    ushort4 o; o.x = f2bf(hv.x); o.y = f2bf(hv.y); o.z = f2bf(hv.z); o.w = f2bf(hv.w);
    __syncthreads();
    *(ushort4*)(HB + (size_t)tok * DM + tid * 4) = o;
    float s = hv.x * hv.x + hv.y * hv.y + hv.z * hv.z + hv.w * hv.w;
    s = wave_sum(s);
    if (lane == 0) red[wid] = s;
    __syncthreads();
    if (tid == 0) rss2[tok] = red[0] + red[1] + red[2] + red[3];
}
__device__ __forceinline__ void b_final(size_t i, const bf16_t* __restrict__ H3B, float* __restrict__ OUT, const float* __restrict__ rss3, const float* __restrict__ gain) {
    const int row = (int)(i >> 7), c = (int)(i & 127) * 8;
    const float r = rsqrtf(rss3[row] * (1.f / DM) + 1e-6f);
    const uint4 w = ((const uint4*)H3B)[i]; const float4 g0 = *(const float4*)(gain + c), g1 = *(const float4*)(gain + c + 4);
    float4 a, b2;
    a.x = __uint_as_float(w.x << 16) * r * g0.x; a.y = __uint_as_float(w.x & 0xffff0000u) * r * g0.y; a.z = __uint_as_float(w.y << 16) * r * g0.z; a.w = __uint_as_float(w.y & 0xffff0000u) * r * g0.w;
    b2.x = __uint_as_float(w.z << 16) * r * g1.x; b2.y = __uint_as_float(w.z & 0xffff0000u) * r * g1.y; b2.z = __uint_as_float(w.w << 16) * r * g1.z; b2.w = __uint_as_float(w.w & 0xffff0000u) * r * g1.w;
    ((float4*)OUT)[2 * i] = a; ((float4*)OUT)[2 * i + 1] = b2;
}

__device__ __forceinline__ u32 f2ord(float x) { const u32 u = __float_as_uint(x); return (u & 0x80000000u) ? ~u : (u | 0x80000000u); }
__device__ __forceinline__ float ord2f(u32 o) { const u32 u = (o & 0x80000000u) ? (o & 0x7fffffffu) : ~o; return __uint_as_float(u); }
__device__ __forceinline__ u32 umax3(u32 a, u32 b, u32 c) { return max(max(a, b), c); }
#define CE_(a_, b_) do { const u32 hi_ = max(a_, b_), lo_ = min(a_, b_); a_ = hi_; b_ = lo_; } while (0)
#define TOPK_NET() do { CE_(k[0], k[13]); CE_(k[1], k[12]); CE_(k[2], k[15]); CE_(k[3], k[14]); CE_(k[4], k[8]); CE_(k[5], k[6]); CE_(k[7], k[11]); CE_(k[9], k[10]); CE_(k[16], k[29]); CE_(k[17], k[28]); CE_(k[18], k[31]); CE_(k[19], k[30]); CE_(k[20], k[24]); CE_(k[21], k[22]); CE_(k[23], k[27]); CE_(k[25], k[26]); CE_(k[32], k[45]); CE_(k[33], k[44]); CE_(k[34], k[47]); CE_(k[35], k[46]); CE_(k[36], k[40]); CE_(k[37], k[38]); CE_(k[39], k[43]); CE_(k[41], k[42]); CE_(k[48], k[61]); CE_(k[49], k[60]); CE_(k[50], k[63]); CE_(k[51], k[62]); CE_(k[52], k[56]); CE_(k[53], k[54]); CE_(k[55], k[59]); CE_(k[57], k[58]); CE_(k[0], k[5]); CE_(k[1], k[7]); CE_(k[2], k[9]); CE_(k[3], k[4]); CE_(k[6], k[13]); CE_(k[8], k[14]); CE_(k[10], k[15]); CE_(k[11], k[12]); CE_(k[16], k[21]); CE_(k[17], k[23]); CE_(k[18], k[25]); CE_(k[19], k[20]); CE_(k[22], k[29]); CE_(k[24], k[30]); CE_(k[26], k[31]); CE_(k[27], k[28]); CE_(k[32], k[37]); CE_(k[33], k[39]); CE_(k[34], k[41]); CE_(k[35], k[36]); CE_(k[38], k[45]); CE_(k[40], k[46]); CE_(k[42], k[47]); CE_(k[43], k[44]); CE_(k[48], k[53]); CE_(k[49], k[55]); CE_(k[50], k[57]); CE_(k[51], k[52]); CE_(k[54], k[61]); CE_(k[56], k[62]); CE_(k[58], k[63]); CE_(k[59], k[60]); CE_(k[0], k[1]); CE_(k[2], k[3]); CE_(k[4], k[5]); CE_(k[6], k[8]); CE_(k[7], k[9]); CE_(k[10], k[11]); CE_(k[12], k[13]); CE_(k[14], k[15]); CE_(k[16], k[17]); CE_(k[18], k[19]); CE_(k[20], k[21]); CE_(k[22], k[24]); CE_(k[23], k[25]); CE_(k[26], k[27]); CE_(k[28], k[29]); CE_(k[30], k[31]); CE_(k[32], k[33]); CE_(k[34], k[35]); CE_(k[36], k[37]); CE_(k[38], k[40]); CE_(k[39], k[41]); CE_(k[42], k[43]); CE_(k[44], k[45]); CE_(k[46], k[47]); CE_(k[48], k[49]); CE_(k[50], k[51]); CE_(k[52], k[53]); CE_(k[54], k[56]); CE_(k[55], k[57]); CE_(k[58], k[59]); CE_(k[60], k[61]); CE_(k[62], k[63]); CE_(k[0], k[2]); CE_(k[1], k[3]); CE_(k[4], k[10]); CE_(k[5], k[11]); CE_(k[6], k[7]); CE_(k[8], k[9]); CE_(k[12], k[14]); CE_(k[13], k[15]); CE_(k[16], k[18]); CE_(k[17], k[19]); CE_(k[20], k[26]); CE_(k[21], k[27]); CE_(k[22], k[23]); CE_(k[24], k[25]); CE_(k[28], k[30]); CE_(k[29], k[31]); CE_(k[32], k[34]); CE_(k[33], k[35]); CE_(k[36], k[42]); CE_(k[37], k[43]); CE_(k[38], k[39]); CE_(k[40], k[41]); CE_(k[44], k[46]); CE_(k[45], k[47]); CE_(k[48], k[50]); CE_(k[49], k[51]); CE_(k[52], k[58]); CE_(k[53], k[59]); CE_(k[54], k[55]); CE_(k[56], k[57]); CE_(k[60], k[62]); CE_(k[61], k[63]); CE_(k[1], k[2]); CE_(k[3], k[12]); CE_(k[4], k[6]); CE_(k[5], k[7]); CE_(k[8], k[10]); CE_(k[9], k[11]); CE_(k[13], k[14]); CE_(k[17], k[18]); CE_(k[19], k[28]); CE_(k[20], k[22]); CE_(k[21], k[23]); CE_(k[24], k[26]); CE_(k[25], k[27]); CE_(k[29], k[30]); CE_(k[33], k[34]); CE_(k[35], k[44]); CE_(k[36], k[38]); CE_(k[37], k[39]); CE_(k[40], k[42]); CE_(k[41], k[43]); CE_(k[45], k[46]); CE_(k[49], k[50]); CE_(k[51], k[60]); CE_(k[52], k[54]); CE_(k[53], k[55]); CE_(k[56], k[58]); CE_(k[57], k[59]); CE_(k[61], k[62]); CE_(k[1], k[4]); CE_(k[2], k[6]); CE_(k[5], k[8]); CE_(k[7], k[10]); CE_(k[9], k[13]); CE_(k[11], k[14]); CE_(k[17], k[20]); CE_(k[18], k[22]); CE_(k[21], k[24]); CE_(k[23], k[26]); CE_(k[25], k[29]); CE_(k[27], k[30]); CE_(k[33], k[36]); CE_(k[34], k[38]); CE_(k[37], k[40]); CE_(k[39], k[42]); CE_(k[41], k[45]); CE_(k[43], k[46]); CE_(k[49], k[52]); CE_(k[50], k[54]); CE_(k[53], k[56]); CE_(k[55], k[58]); CE_(k[57], k[61]); CE_(k[59], k[62]); CE_(k[2], k[4]); CE_(k[3], k[6]); CE_(k[9], k[12]); CE_(k[11], k[13]); CE_(k[18], k[20]); CE_(k[19], k[22]); CE_(k[25], k[28]); CE_(k[27], k[29]); CE_(k[34], k[36]); CE_(k[35], k[38]); CE_(k[41], k[44]); CE_(k[43], k[45]); CE_(k[50], k[52]); CE_(k[51], k[54]); CE_(k[57], k[60]); CE_(k[59], k[61]); CE_(k[3], k[5]); CE_(k[6], k[8]); CE_(k[7], k[9]); CE_(k[10], k[12]); CE_(k[19], k[21]); CE_(k[22], k[24]); CE_(k[23], k[25]); CE_(k[26], k[28]); CE_(k[35], k[37]); CE_(k[38], k[40]); CE_(k[39], k[41]); CE_(k[42], k[44]); CE_(k[51], k[53]); CE_(k[54], k[56]); CE_(k[55], k[57]); CE_(k[58], k[60]); CE_(k[3], k[4]); CE_(k[5], k[6]); CE_(k[7], k[8]); CE_(k[9], k[10]); CE_(k[11], k[12]); CE_(k[19], k[20]); CE_(k[21], k[22]); CE_(k[23], k[24]); CE_(k[25], k[26]); CE_(k[27], k[28]); CE_(k[35], k[36]); CE_(k[37], k[38]); CE_(k[39], k[40]); CE_(k[41], k[42]); CE_(k[43], k[44]); CE_(k[51], k[52]); CE_(k[53], k[54]); CE_(k[55], k[56]); CE_(k[57], k[58]); CE_(k[59], k[60]); CE_(k[6], k[7]); CE_(k[8], k[9]); CE_(k[22], k[23]); CE_(k[24], k[25]); CE_(k[38], k[39]); CE_(k[40], k[41]); CE_(k[54], k[55]); CE_(k[56], k[57]); k[0] = max(k[0], k[31]); k[1] = max(k[1], k[30]); k[2] = max(k[2], k[29]); k[3] = max(k[3], k[28]); k[4] = max(k[4], k[27]); k[5] = max(k[5], k[26]); k[6] = max(k[6], k[25]); k[7] = max(k[7], k[24]); k[8] = max(k[8], k[23]); k[9] = max(k[9], k[22]); k[10] = max(k[10], k[21]); k[11] = max(k[11], k[20]); k[12] = max(k[12], k[19]); k[13] = max(k[13], k[18]); k[14] = max(k[14], k[17]); k[15] = max(k[15], k[16]); CE_(k[0], k[8]); CE_(k[1], k[9]); CE_(k[2], k[10]); CE_(k[3], k[11]); CE_(k[4], k[12]); CE_(k[5], k[13]); CE_(k[6], k[14]); CE_(k[7], k[15]); CE_(k[0], k[4]); CE_(k[1], k[5]); CE_(k[2], k[6]); CE_(k[3], k[7]); CE_(k[8], k[12]); CE_(k[9], k[13]); CE_(k[10], k[14]); CE_(k[11], k[15]); CE_(k[0], k[2]); CE_(k[1], k[3]); CE_(k[4], k[6]); CE_(k[5], k[7]); CE_(k[8], k[10]); CE_(k[9], k[11]); CE_(k[12], k[14]); CE_(k[13], k[15]); CE_(k[0], k[1]); CE_(k[2], k[3]); CE_(k[4], k[5]); CE_(k[6], k[7]); CE_(k[8], k[9]); CE_(k[10], k[11]); CE_(k[12], k[13]); CE_(k[14], k[15]); k[32] = max(k[32], k[63]); k[33] = max(k[33], k[62]); k[34] = max(k[34], k[61]); k[35] = max(k[35], k[60]); k[36] = max(k[36], k[59]); k[37] = max(k[37], k[58]); k[38] = max(k[38], k[57]); k[39] = max(k[39], k[56]); k[40] = max(k[40], k[55]); k[41] = max(k[41], k[54]); k[42] = max(k[42], k[53]); k[43] = max(k[43], k[52]); k[44] = max(k[44], k[51]); k[45] = max(k[45], k[50]); k[46] = max(k[46], k[49]); k[47] = max(k[47], k[48]); CE_(k[32], k[40]); CE_(k[33], k[41]); CE_(k[34], k[42]); CE_(k[35], k[43]); CE_(k[36], k[44]); CE_(k[37], k[45]); CE_(k[38], k[46]); CE_(k[39], k[47]); CE_(k[32], k[36]); CE_(k[33], k[37]); CE_(k[34], k[38]); CE_(k[35], k[39]); CE_(k[40], k[44]); CE_(k[41], k[45]); CE_(k[42], k[46]); CE_(k[43], k[47]); CE_(k[32], k[34]); CE_(k[33], k[35]); CE_(k[36], k[38]); CE_(k[37], k[39]); CE_(k[40], k[42]); CE_(k[41], k[43]); CE_(k[44], k[46]); CE_(k[45], k[47]); CE_(k[32], k[33]); CE_(k[34], k[35]); CE_(k[36], k[37]); CE_(k[38], k[39]); CE_(k[40], k[41]); CE_(k[42], k[43]); CE_(k[44], k[45]); CE_(k[46], k[47]); k[0] = max(k[0], k[47]); k[1] = max(k[1], k[46]); k[2] = max(k[2], k[45]); k[3] = max(k[3], k[44]); k[4] = max(k[4], k[43]); k[5] = max(k[5], k[42]); k[6] = max(k[6], k[41]); k[7] = max(k[7], k[40]); k[8] = max(k[8], k[39]); k[9] = max(k[9], k[38]); k[10] = max(k[10], k[37]); k[11] = max(k[11], k[36]); k[12] = max(k[12], k[35]); k[13] = max(k[13], k[34]); k[14] = max(k[14], k[33]); k[15] = max(k[15], k[32]); CE_(k[0], k[8]); CE_(k[1], k[9]); CE_(k[2], k[10]); CE_(k[3], k[11]); CE_(k[4], k[12]); CE_(k[5], k[13]); CE_(k[6], k[14]); CE_(k[7], k[15]); CE_(k[0], k[4]); CE_(k[1], k[5]); CE_(k[2], k[6]); CE_(k[3], k[7]); CE_(k[8], k[12]); CE_(k[9], k[13]); CE_(k[10], k[14]); CE_(k[11], k[15]); CE_(k[0], k[2]); CE_(k[1], k[3]); CE_(k[4], k[6]); CE_(k[5], k[7]); CE_(k[8], k[10]); CE_(k[9], k[11]); CE_(k[12], k[14]); CE_(k[13], k[15]); CE_(k[0], k[1]); CE_(k[2], k[3]); CE_(k[4], k[5]); CE_(k[6], k[7]); CE_(k[8], k[9]); CE_(k[10], k[11]); CE_(k[12], k[13]); CE_(k[14], k[15]); } while (0)
#define TOPK_XMERGE(T_) do { u32 pp_[16]; _Pragma("unroll") for (int i_ = 0; i_ < 16; ++i_) pp_[i_] = (u32)__shfl_xor((int)k[i_], 32); T_[0] = max(k[0], pp_[15]); T_[1] = max(k[1], pp_[14]); T_[2] = max(k[2], pp_[13]); T_[3] = max(k[3], pp_[12]); T_[4] = max(k[4], pp_[11]); T_[5] = max(k[5], pp_[10]); T_[6] = max(k[6], pp_[9]); T_[7] = max(k[7], pp_[8]); T_[8] = max(k[8], pp_[7]); T_[9] = max(k[9], pp_[6]); T_[10] = max(k[10], pp_[5]); T_[11] = max(k[11], pp_[4]); T_[12] = max(k[12], pp_[3]); T_[13] = max(k[13], pp_[2]); T_[14] = max(k[14], pp_[1]); T_[15] = max(k[15], pp_[0]); CE_(T_[0], T_[8]); CE_(T_[1], T_[9]); CE_(T_[2], T_[10]); CE_(T_[3], T_[11]); CE_(T_[4], T_[12]); CE_(T_[5], T_[13]); CE_(T_[6], T_[14]); CE_(T_[7], T_[15]); CE_(T_[0], T_[4]); CE_(T_[1], T_[5]); CE_(T_[2], T_[6]); CE_(T_[3], T_[7]); CE_(T_[8], T_[12]); CE_(T_[9], T_[13]); CE_(T_[10], T_[14]); CE_(T_[11], T_[15]); CE_(T_[0], T_[2]); CE_(T_[1], T_[3]); CE_(T_[4], T_[6]); CE_(T_[5], T_[7]); CE_(T_[8], T_[10]); CE_(T_[9], T_[11]); CE_(T_[12], T_[14]); CE_(T_[13], T_[15]); CE_(T_[0], T_[1]); CE_(T_[2], T_[3]); CE_(T_[4], T_[5]); CE_(T_[6], T_[7]); CE_(T_[8], T_[9]); CE_(T_[10], T_[11]); CE_(T_[12], T_[13]); CE_(T_[14], T_[15]); } while (0)
constexpr int SKROW = 272;
__device__ __forceinline__ void peer_topk_unit(int lane, int tok0, int tokn, int head, const bf16_t* __restrict__ QRY, bf16x8_t (&qf)[8], const LAS unsigned char* sk, LAS unsigned char* tl, int* __restrict__ IDX, float* __restrict__ GATE) {
    const int ql = lane & 31, hi = lane >> 5;
    bool bad = false; (void)bad;
    u32 top[2][16];
#pragma unroll
    for (int c = 0; c < 2; ++c) {
        const LAS unsigned char* kp = sk + (c * 128 + ql) * SKROW + 16 * hi;
        f32x16_t sc[4];
#pragma unroll
        for (int kb = 0; kb < 4; ++kb) sc[kb] = (f32x16_t){0.f, 0.f, 0.f, 0.f, 0.f, 0.f, 0.f, 0.f, 0.f, 0.f, 0.f, 0.f, 0.f, 0.f, 0.f, 0.f};
#pragma unroll
        for (int ks = 0; ks < 8; ++ks) {
#pragma unroll
            for (int kb = 0; kb < 4; ++kb) { const bf16x8_t a = *(const LAS bf16x8_t*)(kp + kb * 32 * SKROW + 32 * ks); sc[kb] = MFMA32(a, qf[ks], sc[kb]); }
        }
        {
            const bf16_t* qn = QRY + (size_t)((c == 0 ? tok0 : tokn) + ql) * 2048 + head * 256 + (c == 0 ? 128 : 0) + 8 * hi;
#pragma unroll
            for (int ks = 0; ks < 8; ++ks) qf[ks] = *(const bf16x8_t*)(qn + 16 * ks);
        }
        u32 k[64];
#pragma unroll
        for (int kb = 0; kb < 4; ++kb)
#pragma unroll
            for (int r = 0; r < 16; ++r) k[kb * 16 + r] = (f2ord(sc[kb][r]) & ~127u) | (u32)(127 - (32 * kb + crow(r, hi)));
#ifdef PROBE_TOPK_CHECK
        u32 k2[64];
#pragma unroll
        for (int i = 0; i < 64; ++i) k2[i] = k[i];
        u32 told[16];
#pragma unroll
        for (int rd = 0; rd < 16; ++rd) {
            u32 b = umax3(k2[0], k2[1], k2[2]);
#pragma unroll
            for (int i = 3; i + 1 < 64; i += 2) b = umax3(b, k2[i], k2[i + 1]);
            b = max(b, k2[63]);
            const u32 g = max(b, (u32)__shfl_xor((int)b, 32));
            told[rd] = g;
#pragma unroll
            for (int i = 0; i < 64; ++i) k2[i] = (k2[i] == g) ? 0u : k2[i];
        }
#endif
        TOPK_NET();
        TOPK_XMERGE(top[c]);
#ifdef PROBE_TOPK_CHECK
#pragma unroll
        for (int rd = 0; rd < 16; ++rd) bad |= (told[rd] != top[c][rd]);
#endif
    }
    float va[16], vb[16];
#pragma unroll
    for (int i = 0; i < 16; ++i) { va[i] = ord2f(top[0][i] & ~127u); vb[i] = ord2f(top[1][i] & ~127u); }
    LAS u32* tlr = (LAS u32*)(tl + ql * 144);
    {
        u32 w_[16];
#pragma unroll
        for (int i = 0; i < 16; ++i) w_[i] = hi ? top[1][i] : top[0][i];
#pragma unroll
        for (int q = 0; q < 4; ++q) { u32x4_t t4; t4.x = w_[4 * q]; t4.y = w_[4 * q + 1]; t4.z = w_[4 * q + 2]; t4.w = w_[4 * q + 3]; *(LAS u32x4_t*)(tlr + 16 * hi + 4 * q) = t4; }
    }
    float sv[16]; u32 oe[8];
    {
        u32 k[64];
#pragma unroll
        for (int t = 0; t < 25; ++t) {
            constexpr int CI[50] = {0, 0, 0, 0, 0, 0, 0, 0, 0, 0, 0, 0, 0, 0, 0, 0, 1, 1, 1, 1, 1, 1, 1, 1, 2, 2, 2, 2, 2, 3, 3, 3, 3, 4, 4, 4, 5, 5, 6, 6, 7, 7, 8, 9, 10, 11, 12, 13, 14, 15};
            constexpr int CJ[50] = {0, 1, 2, 3, 4, 5, 6, 7, 8, 9, 10, 11, 12, 13, 14, 15, 0, 1, 2, 3, 4, 5, 6, 7, 0, 1, 2, 3, 4, 0, 1, 2, 3, 0, 1, 2, 0, 1, 0, 1, 0, 1, 0, 0, 0, 0, 0, 0, 0, 0};
            const int i0 = CI[2 * t], j0 = CJ[2 * t], i1 = CI[2 * t + 1], j1 = CJ[2 * t + 1];
            const u32 key0 = (f2ord(va[i0] + vb[j0]) & ~255u) | (u32)(255 - (i0 * 16 + j0)), key1 = (f2ord(va[i1] + vb[j1]) & ~255u) | (u32)(255 - (i1 * 16 + j1));
            k[t] = hi ? key1 : key0;
        }
#pragma unroll
        for (int t = 25; t < 64; ++t) k[t] = 0u;
        TOPK_NET();
        u32 g[16];
        TOPK_XMERGE(g);
#pragma unroll
        for (int rd = 0; rd < 16; ++rd) sv[rd] = ord2f(g[rd] & ~255u);
#pragma unroll
        for (int q = 0; q < 8; ++q) {
            const u32 key = hi ? g[8 + q] : g[q], ci = 255u - (key & 255u);
            const u32 e1 = 127u - (tlr[ci >> 4] & 127u), e2 = 127u - (tlr[16 + (ci & 15u)] & 127u);
            oe[q] = e1 * 128u + e2;
        }
    }
    const float mx = sv[0]; float sum = 0.f;
#pragma unroll
    for (int rd = 0; rd < 16; ++rd) { sv[rd] = __expf(sv[rd] - mx); sum += sv[rd]; }
    const float inv = 1.0f / sum;
    float og[8];
#pragma unroll
    for (int q = 0; q < 8; ++q) og[q] = (hi ? sv[8 + q] : sv[q]) * inv;
    const size_t o = (size_t)(tok0 + ql) * 128 + head * 16 + 8 * hi;
    *(uint4*)(IDX + o) = make_uint4(oe[0], oe[1], oe[2], oe[3]); *(uint4*)(IDX + o + 4) = make_uint4(oe[4], oe[5], oe[6], oe[7]);
#ifdef PROBE_TOPK_CHECK
    if (bad) { og[0] = __builtin_nanf(""); }
#endif
    *(float4*)(GATE + o) = make_float4(og[0], og[1], og[2], og[3]); *(float4*)(GATE + o + 4) = make_float4(og[4], og[5], og[6], og[7]);
}

#define MFMA16(a, b, c) __builtin_amdgcn_mfma_f32_16x16x32_bf16((a), (b), (c), 0, 0, 0)
__device__ __forceinline__ void peer_token(int lane, int tok, const bf16_t* __restrict__ U, const bf16_t* __restrict__ Vt, const int* __restrict__ IDX, const float* __restrict__ GATE,
                                           float* __restrict__ H, bf16_t* __restrict__ HB, const float* __restrict__ rss1, float* __restrict__ rss2, const bool wr = true) {
    const int r = lane & 15, kq = lane >> 4;
    int ev[8];
#pragma unroll
    for (int g = 0; g < 8; ++g) ev[g] = IDX[(size_t)tok * 128 + 16 * g + r];
    const float r1 = rsqrtf(rss1[tok] * (1.f / DM) + 1e-6f);
    const bf16_t* hrow = HB + (size_t)tok * DM + 8 * kq;
    f32x4_t acc[8];
#pragma unroll
    for (int g = 0; g < 8; ++g) acc[g] = (f32x4_t){0.f, 0.f, 0.f, 0.f};
    const char* ub = (const char*)U + 16 * kq;
#pragma unroll 4
    for (int ks = 0; ks < 32; ++ks) {
        const bf16x8_t bfr = *(const bf16x8_t*)(hrow + 32 * ks);
#pragma unroll
        for (int g = 0; g < 8; ++g) { const bf16x8_t a = *(const bf16x8_t*)(ub + (size_t)(unsigned)ev[g] * 2048u + 64 * ks); acc[g] = MFMA16(a, bfr, acc[g]); }
    }
#pragma unroll
    for (int g = 0; g < 8; ++g) {
        const float4 gt = *(const float4*)(GATE + (size_t)tok * 128 + 16 * g + 4 * kq);
        const float gg[4] = {gt.x, gt.y, gt.z, gt.w};
#pragma unroll
        for (int i = 0; i < 4; ++i) { const float z = acc[g][i] * r1; acc[g][i] = 0.5f * z * (1.f + erff(z * 0.70710678118654752f)) * gg[i]; }
    }
    float o[16];
#pragma unroll
    for (int j = 0; j < 16; ++j) o[j] = 0.f;
    const char* vb = (const char*)Vt + 16 * lane;
#pragma unroll
    for (int g = 0; g < 8; ++g) {
#pragma unroll
        for (int rr = 0; rr < 16; rr += 4) {
            u32x4_t w0[4], w1[4]; float ae[4];
#pragma unroll
            for (int q = 0; q < 4; ++q) {
                const int e = __builtin_amdgcn_readlane(ev[g], rr + q);
                ae[q] = __int_as_float(__builtin_amdgcn_readlane(__float_as_int(acc[g][(rr + q) & 3]), 16 * ((rr + q) >> 2)));
                const char* vp = vb + (size_t)(unsigned)e * 2048u;
                w0[q] = *(const u32x4_t*)vp; w1[q] = *(const u32x4_t*)(vp + 1024);
            }
#pragma unroll
            for (int q = 0; q < 4; ++q) {
                const float a = ae[q];
                const u32 ww[8] = {w0[q].x, w0[q].y, w0[q].z, w0[q].w, w1[q].x, w1[q].y, w1[q].z, w1[q].w};
#pragma unroll
                for (int j = 0; j < 8; ++j) { o[2 * j] = fmaf(a, __uint_as_float(ww[j] << 16), o[2 * j]); o[2 * j + 1] = fmaf(a, __uint_as_float(ww[j] & 0xffff0000u), o[2 * j + 1]); }
            }
        }
    }
    float* hp = H + (size_t)tok * DM + 8 * lane;
    float4 h0 = *(float4*)hp, h1 = *(float4*)(hp + 4), h2 = *(float4*)(hp + 512), h3 = *(float4*)(hp + 516);
    h0.x += o[0]; h0.y += o[1]; h0.z += o[2]; h0.w += o[3]; h1.x += o[4]; h1.y += o[5]; h1.z += o[6]; h1.w += o[7];
    h2.x += o[8]; h2.y += o[9]; h2.z += o[10]; h2.w += o[11]; h3.x += o[12]; h3.y += o[13]; h3.z += o[14]; h3.w += o[15];
    if (wr) { *(float4*)hp = h0; *(float4*)(hp + 4) = h1; *(float4*)(hp + 512) = h2; *(float4*)(hp + 516) = h3; }
    const float wa[8] = {h0.x, h0.y, h0.z, h0.w, h1.x, h1.y, h1.z, h1.w}, wb[8] = {h2.x, h2.y, h2.z, h2.w, h3.x, h3.y, h3.z, h3.w};
    bf16_t* hb = HB + (size_t)tok * DM + 8 * lane;
    float s = 0.f;
#pragma unroll
    for (int j = 0; j < 8; ++j) s += wa[j] * wa[j] + wb[j] * wb[j];
    s = wave_sum(s);
    if (wr) { *(uint4*)hb = pack8(wa); *(uint4*)(hb + 512) = pack8(wb); }
    if (lane == 0) { if (wr) rss2[tok] = s; else if (s == 123.456f) rss2[tok] = s; }
}
__device__ __forceinline__ void b_rowquant(int row, int lane, const float* __restrict__ src, const float* __restrict__ gain, unsigned char* __restrict__ dst8, float* __restrict__ scale) {
    const float4* sp = (const float4*)(src + (size_t)row * DM + 16 * lane);
    float v[16];
#pragma unroll
    for (int j = 0; j < 4; ++j) { const float4 t = sp[j]; v[4 * j] = t.x; v[4 * j + 1] = t.y; v[4 * j + 2] = t.z; v[4 * j + 3] = t.w; }
    if (gain) {
#pragma unroll
        for (int j = 0; j < 16; ++j) v[j] *= gain[16 * lane + j];
    }
    float am = 0.f;
#pragma unroll
    for (int j = 0; j < 16; ++j) am = fmaxf(am, fabsf(v[j]));
    am = wave_max(am);
    const float sc = am > 0.f ? am * (1.0f / 440.0f) : 1.0f, inv = 1.0f / sc;
    int w[4];
#pragma unroll
    for (int j = 0; j < 4; ++j) { int t = 0; t = __builtin_amdgcn_cvt_pk_fp8_f32(v[4 * j] * inv, v[4 * j + 1] * inv, t, false); t = __builtin_amdgcn_cvt_pk_fp8_f32(v[4 * j + 2] * inv, v[4 * j + 3] * inv, t, true); w[j] = t; }
    *(uint4*)(dst8 + ((size_t)(lane >> 3) * NEXP + row) * 128 + 16 * (lane & 7)) = make_uint4((u32)w[0], (u32)w[1], (u32)w[2], (u32)w[3]);
    if (lane == 0) scale[row] = sc;
}
__device__ __forceinline__ float gelu_as(float v) {
    const float av = fabsf(v), t = __builtin_amdgcn_rcpf(av * 0.2316418882f + 1.0f);
    float q = t * 0.5307027145f + (-0.7265760135f); q = q * t + 0.7107068705f; q = q * t + (-0.142248368f); q = q * t + 0.127414796f; q = q * t;
    const float e = __builtin_amdgcn_exp2f((v * v) * (-0.72134752044f));
    const float m = v * (q * e);
    return v < 0.f ? m : v - m;
}
typedef float f32x2_t __attribute__((ext_vector_type(2)));
#define MFMA8(a, b, c) __builtin_amdgcn_mfma_f32_16x16x32_fp8_fp8((a), (b), (c), 0, 0, 0)
__device__ __forceinline__ void peer_token8(int lane, int tok, LAS unsigned char* wb, const unsigned char* __restrict__ U8, const unsigned char* __restrict__ V8, const float* __restrict__ SU, const float* __restrict__ SV,
                                            const int* __restrict__ IDX, const float* __restrict__ GATE, float* __restrict__ H, bf16_t* __restrict__ HB, const float* __restrict__ rss1, float* __restrict__ rss2) {
    const int r = lane & 15, kq = lane >> 4;
    int ev[8];
#pragma unroll
    for (int g = 0; g < 8; ++g) ev[g] = IDX[(size_t)tok * 128 + 16 * g + r];
    const float r1 = rsqrtf(rss1[tok] * (1.f / DM) + 1e-6f);
    float sh;
    {
        const uint4 a0 = *(const uint4*)(HB + (size_t)tok * DM + 16 * lane), a1 = *(const uint4*)(HB + (size_t)tok * DM + 16 * lane + 8);
        const u32 ww[8] = {a0.x, a0.y, a0.z, a0.w, a1.x, a1.y, a1.z, a1.w};
        float v[16]; float am = 0.f;
#pragma unroll
        for (int j = 0; j < 8; ++j) { v[2 * j] = __uint_as_float(ww[j] << 16); v[2 * j + 1] = __uint_as_float(ww[j] & 0xffff0000u); am = fmaxf(am, fmaxf(fabsf(v[2 * j]), fabsf(v[2 * j + 1]))); }
        am = wave_max(am);
        sh = am > 0.f ? am * (1.0f / 440.0f) : 1.0f;
        const float inv = 1.0f / sh;
        u32x4_t w;
        { int t = 0; t = __builtin_amdgcn_cvt_pk_fp8_f32(v[0] * inv, v[1] * inv, t, false); t = __builtin_amdgcn_cvt_pk_fp8_f32(v[2] * inv, v[3] * inv, t, true); w.x = (u32)t; }
        { int t = 0; t = __builtin_amdgcn_cvt_pk_fp8_f32(v[4] * inv, v[5] * inv, t, false); t = __builtin_amdgcn_cvt_pk_fp8_f32(v[6] * inv, v[7] * inv, t, true); w.y = (u32)t; }
        { int t = 0; t = __builtin_amdgcn_cvt_pk_fp8_f32(v[8] * inv, v[9] * inv, t, false); t = __builtin_amdgcn_cvt_pk_fp8_f32(v[10] * inv, v[11] * inv, t, true); w.z = (u32)t; }
        { int t = 0; t = __builtin_amdgcn_cvt_pk_fp8_f32(v[12] * inv, v[13] * inv, t, false); t = __builtin_amdgcn_cvt_pk_fp8_f32(v[14] * inv, v[15] * inv, t, true); w.w = (u32)t; }
        *(LAS u32x4_t*)(wb + 16 * lane) = w;
    }
    f32x4_t acc[8];
#pragma unroll
    for (int g = 0; g < 8; ++g) acc[g] = (f32x4_t){0.f, 0.f, 0.f, 0.f};
    const unsigned char* ub = U8 + 16 * kq;
#pragma unroll 2
    for (int c = 0; c < 16; ++c) {
        const u32x4_t bq = *(const LAS u32x4_t*)(wb + 64 * c + 16 * kq);
        const long b0 = (long)(((unsigned long long)bq.y << 32) | bq.x), b1 = (long)(((unsigned long long)bq.w << 32) | bq.z);
#pragma unroll
        for (int g = 0; g < 8; ++g) {
            const u32x4_t a = *(const u32x4_t*)(ub + (size_t)(unsigned)ev[g] * 1024u + 64 * c);
            const long a0 = (long)(((unsigned long long)a.y << 32) | a.x), a1 = (long)(((unsigned long long)a.w << 32) | a.z);
            acc[g] = MFMA8(a0, b0, acc[g]); acc[g] = MFMA8(a1, b1, acc[g]);
        }
    }
    const float zs = sh * r1;
#pragma unroll
    for (int g = 0; g < 8; ++g) {
        const float4 gt = *(const float4*)(GATE + (size_t)tok * 128 + 16 * g + 4 * kq);
        const int4 ei = *(const int4*)(IDX + (size_t)tok * 128 + 16 * g + 4 * kq);
        const float gg[4] = {gt.x, gt.y, gt.z, gt.w}; const int ee[4] = {ei.x, ei.y, ei.z, ei.w};
#pragma unroll
        for (int i = 0; i < 4; ++i) { const float z = acc[g][i] * zs * SU[ee[i]]; acc[g][i] = gelu_as(z) * gg[i] * SV[ee[i]]; }
    }
    float o[16];
#pragma unroll
    for (int j = 0; j < 16; ++j) o[j] = 0.f;
    const unsigned char* vb = V8 + 16 * lane;
#pragma unroll
    for (int g = 0; g < 8; ++g) {
#pragma unroll
        for (int rr = 0; rr < 16; rr += 4) {
            u32x4_t w[4]; float ae[4];
#pragma unroll
            for (int q = 0; q < 4; ++q) {
                const int e = __builtin_amdgcn_readlane(ev[g], rr + q);
                ae[q] = __int_as_float(__builtin_amdgcn_readlane(__float_as_int(acc[g][(rr + q) & 3]), 16 * ((rr + q) >> 2)));
                w[q] = *(const u32x4_t*)(vb + (size_t)(unsigned)e * 1024u);
            }
#pragma unroll
            for (int q = 0; q < 4; ++q) {
                const float a = ae[q];
                const u32 ww[4] = {w[q].x, w[q].y, w[q].z, w[q].w};
#pragma unroll
                for (int j = 0; j < 4; ++j) {
                    const f32x2_t lo = __builtin_amdgcn_cvt_pk_f32_fp8((int)ww[j], false), hi2 = __builtin_amdgcn_cvt_pk_f32_fp8((int)ww[j], true);
                    o[4 * j] = fmaf(a, lo[0], o[4 * j]); o[4 * j + 1] = fmaf(a, lo[1], o[4 * j + 1]); o[4 * j + 2] = fmaf(a, hi2[0], o[4 * j + 2]); o[4 * j + 3] = fmaf(a, hi2[1], o[4 * j + 3]);
                }
            }
        }
    }
    float* hp = H + (size_t)tok * DM + 16 * lane;
    float hv[16]; float s = 0.f;
#pragma unroll
    for (int j = 0; j < 4; ++j) { const float4 t = *(const float4*)(hp + 4 * j); hv[4 * j] = t.x + o[4 * j]; hv[4 * j + 1] = t.y + o[4 * j + 1]; hv[4 * j + 2] = t.z + o[4 * j + 2]; hv[4 * j + 3] = t.w + o[4 * j + 3]; }
#pragma unroll
    for (int j = 0; j < 4; ++j) *(float4*)(hp + 4 * j) = make_float4(hv[4 * j], hv[4 * j + 1], hv[4 * j + 2], hv[4 * j + 3]);
#pragma unroll
    for (int j = 0; j < 16; ++j) s += hv[j] * hv[j];
    s = wave_sum(s);
    bf16_t* hb = HB + (size_t)tok * DM + 16 * lane;
    *(uint4*)hb = pack8(hv); *(uint4*)(hb + 8) = pack8(hv + 8);
    if (lane == 0) rss2[tok] = s;
}
constexpr int PL_ZP = 0;
constexpr int PL_EI = 65536;
constexpr int PL_SS = 131072;
__device__ __forceinline__ void b_tokquant(int tok, int lane, const bf16_t* __restrict__ HB, unsigned char* __restrict__ HB8, float* __restrict__ SH) {
    const uint4 a0 = *(const uint4*)(HB + (size_t)tok * DM + 16 * lane), a1 = *(const uint4*)(HB + (size_t)tok * DM + 16 * lane + 8);
    const u32 ww[8] = {a0.x, a0.y, a0.z, a0.w, a1.x, a1.y, a1.z, a1.w};
    float v[16]; float am = 0.f;
#pragma unroll
    for (int j = 0; j < 8; ++j) { v[2 * j] = __uint_as_float(ww[j] << 16); v[2 * j + 1] = __uint_as_float(ww[j] & 0xffff0000u); am = fmaxf(am, fmaxf(fabsf(v[2 * j]), fabsf(v[2 * j + 1]))); }
    am = wave_max(am);
    const float sh = am > 0.f ? am * (1.0f / 440.0f) : 1.0f, inv = 1.0f / sh;
    int w[4];
#pragma unroll
    for (int j = 0; j < 4; ++j) { int t = 0; t = __builtin_amdgcn_cvt_pk_fp8_f32(v[4 * j] * inv, v[4 * j + 1] * inv, t, false); t = __builtin_amdgcn_cvt_pk_fp8_f32(v[4 * j + 2] * inv, v[4 * j + 3] * inv, t, true); w[j] = t; }
    *(uint4*)(HB8 + (size_t)tok * DM + 16 * lane) = make_uint4((u32)w[0], (u32)w[1], (u32)w[2], (u32)w[3]);
    if (lane == 0) SH[tok] = sh;
}
__device__ __forceinline__ void peer_sliced(LAS unsigned char* lds, int lane, int wave, int tok0, const unsigned char* __restrict__ U8, const unsigned char* __restrict__ V8, const float* __restrict__ SU, const float* __restrict__ SV,
                                            const unsigned char* __restrict__ HB8, const float* __restrict__ SH, const int* __restrict__ IDX, const float* __restrict__ GATE,
                                            float* __restrict__ H, bf16_t* __restrict__ HB, const float* __restrict__ rss1, float* __restrict__ rss2) {
    LAS float* zp = (LAS float*)(lds + PL_ZP) + wave * (16 * 128);
    LAS int* ei = (LAS int*)(lds + PL_EI) + wave * (16 * 128);
    LAS float* ssl = (LAS float*)(lds + PL_SS) + wave * 16;
    const int tw = tok0 + 16 * wave;
#pragma unroll
    for (int i = 0; i < 8; ++i) { const int o = i * 256 + 4 * lane; *(LAS u32x4_t*)(ei + o) = *(const u32x4_t*)(IDX + (size_t)tw * 128 + o); }
    if (lane < 16) ssl[lane] = 0.f;
    const int r = lane & 15, kq = lane >> 4;
    {
        int lane_u = lane;
#define UV_LOAD(W_, TG_, EB_) do { \
        _Pragma("unroll") for (int q = 0; q < 2; ++q) { const u32x4_t ev_ = *(const LAS u32x4_t*)(ei + (8 * (TG_) + ju) * 128 + 8 * (EB_) + 4 * q); \
            W_[4 * q] = *(const u32x4_t*)(ub_ + (ev_.x * 128u + (unsigned)(16 * du))); W_[4 * q + 1] = *(const u32x4_t*)(ub_ + (ev_.y * 128u + (unsigned)(16 * du))); \
            W_[4 * q + 2] = *(const u32x4_t*)(ub_ + (ev_.z * 128u + (unsigned)(16 * du))); W_[4 * q + 3] = *(const u32x4_t*)(ub_ + (ev_.w * 128u + (unsigned)(16 * du))); } } while (0)
#define UV_DOT(W_, TG_, EB_) do { float v_[8]; \
        _Pragma("unroll") for (int k = 0; k < 8; ++k) { const u32 ww_[4] = {W_[k].x, W_[k].y, W_[k].z, W_[k].w}; float d0_ = 0.f, d1_ = 0.f; \
            _Pragma("unroll") for (int q = 0; q < 4; ++q) { \
                const f32x2_t lo_ = __builtin_amdgcn_cvt_pk_f32_fp8((int)ww_[q], false), hi_ = __builtin_amdgcn_cvt_pk_f32_fp8((int)ww_[q], true); \
                d0_ = fmaf(lo_[0], hv[4 * q], d0_); d1_ = fmaf(lo_[1], hv[4 * q + 1], d1_); d0_ = fmaf(hi_[0], hv[4 * q + 2], d0_); d1_ = fmaf(hi_[1], hv[4 * q + 3], d1_); } \
            v_[k] = d0_ + d1_; } \
        _Pragma("unroll") for (int k = 0; k < 4; ++k) { const float snd_ = (du & 4) ? v_[k] : v_[k + 4], kp_ = (du & 4) ? v_[k + 4] : v_[k]; v_[k] = kp_ + __shfl_xor(snd_, 4); } \
        _Pragma("unroll") for (int k = 0; k < 2; ++k) { const float snd_ = (du & 2) ? v_[k] : v_[k + 2], kp_ = (du & 2) ? v_[k + 2] : v_[k]; v_[k] = kp_ + __shfl_xor(snd_, 2); } \
        { const float snd_ = (du & 1) ? v_[0] : v_[1], kp_ = (du & 1) ? v_[1] : v_[0]; v_[0] = kp_ + __shfl_xor(snd_, 1); } \
        { LAS float* zq_ = zp + (8 * (TG_) + ju) * 128 + 8 * (EB_) + du; if (s_ == 0) *zq_ = v_[0]; else *zq_ += v_[0]; } \
        asm volatile("" ::: "memory"); } while (0)
#define UV_TG(TG_) do { float hv[16]; \
            { const bf16_t* hp_ = HB + (size_t)(tw + 8 * (TG_) + ju) * DM + 128 * s_ + 16 * du;        \
              const u32x4_t hq0 = *(const u32x4_t*)hp_, hq1 = *(const u32x4_t*)(hp_ + 8); \
              const u32 hw[8] = {hq0.x, hq0.y, hq0.z, hq0.w, hq1.x, hq1.y, hq1.z, hq1.w}; \
              _Pragma("unroll") for (int q = 0; q < 8; ++q) { hv[2 * q] = __uint_as_float(hw[q] << 16); hv[2 * q + 1] = __uint_as_float(hw[q] & 0xffff0000u); } } \
            u32x4_t wA[8], wB[8]; \
            UV_LOAD(wA, TG_, 0); \
            UV_LOAD(wB, TG_, 1);  UV_DOT(wA, TG_, 0);  UV_LOAD(wA, TG_, 2);  UV_DOT(wB, TG_, 1); \
            UV_LOAD(wB, TG_, 3);  UV_DOT(wA, TG_, 2);  UV_LOAD(wA, TG_, 4);  UV_DOT(wB, TG_, 3); \
            UV_LOAD(wB, TG_, 5);  UV_DOT(wA, TG_, 4);  UV_LOAD(wA, TG_, 6);  UV_DOT(wB, TG_, 5); \
            UV_LOAD(wB, TG_, 7);  UV_DOT(wA, TG_, 6);  UV_LOAD(wA, TG_, 8);  UV_DOT(wB, TG_, 7); \
            UV_LOAD(wB, TG_, 9);  UV_DOT(wA, TG_, 8);  UV_LOAD(wA, TG_, 10); UV_DOT(wB, TG_, 9); \
            UV_LOAD(wB, TG_, 11); UV_DOT(wA, TG_, 10); UV_LOAD(wA, TG_, 12); UV_DOT(wB, TG_, 11); \
            UV_LOAD(wB, TG_, 13); UV_DOT(wA, TG_, 12); UV_LOAD(wA, TG_, 14); UV_DOT(wB, TG_, 13); \
            UV_LOAD(wB, TG_, 15); UV_DOT(wA, TG_, 14); UV_DOT(wB, TG_, 15); } while (0)
#pragma unroll 1
        for (int s_ = 0; s_ < 8; ++s_) {
            asm volatile("" : "+v"(lane_u));
            const int ju = lane_u >> 3, du = lane_u & 7;
            const unsigned char* ub_ = U8 + (size_t)s_ * NEXP * 128;
            UV_TG(0);
            UV_TG(1);
        }
#undef UV_TG
#undef UV_LOAD
#undef UV_DOT
    }
#pragma unroll 1
    for (int i0 = 0; i0 < 16; i0 += 4) {
        float su_[8], sv_[8], gt_[8], zs_[4];
#pragma unroll
        for (int q = 0; q < 8; ++q) { const int i = i0 + (q >> 1), k = lane + 64 * (q & 1), e = ei[i * 128 + k]; su_[q] = SU[e]; sv_[q] = SV[e]; gt_[q] = GATE[(size_t)(tw + i) * 128 + k]; }
#pragma unroll
        for (int q = 0; q < 4; ++q) zs_[q] = rsqrtf(rss1[tw + i0 + q] * (1.f / DM) + 1e-6f);
#pragma unroll
        for (int q = 0; q < 8; ++q) { const int i = i0 + (q >> 1), k = lane + 64 * (q & 1);
            const float z = zp[i * 128 + k] * zs_[q >> 1] * su_[q];
            zp[i * 128 + k] = gelu_as(z) * gt_[q] * sv_[q]; }
    }
    const int j = lane >> 3, d = lane & 7;
#define V_LOAD(W_, st_) do { const int eb_ = (st_) & 15, tg_ = ((st_) >> 4) & 1, s_ = (st_) >> 5; const unsigned char* vb_ = V8 + (size_t)s_ * NEXP * 128; \
        _Pragma("unroll") for (int q = 0; q < 2; ++q) { const u32x4_t ev_ = *(const LAS u32x4_t*)(ei + (8 * tg_ + j) * 128 + 8 * eb_ + 4 * q); \
            W_[4 * q] = *(const u32x4_t*)(vb_ + (ev_.x * 128u + (unsigned)(16 * d))); W_[4 * q + 1] = *(const u32x4_t*)(vb_ + (ev_.y * 128u + (unsigned)(16 * d))); \
            W_[4 * q + 2] = *(const u32x4_t*)(vb_ + (ev_.z * 128u + (unsigned)(16 * d))); W_[4 * q + 3] = *(const u32x4_t*)(vb_ + (ev_.w * 128u + (unsigned)(16 * d))); } } while (0)
#define V_FMA(W_, st_) do { const int eb_ = (st_) & 15, tg_ = ((st_) >> 4) & 1; \
        float a_[8]; \
        _Pragma("unroll") for (int q = 0; q < 2; ++q) { const f32x4_t av_ = *(const LAS f32x4_t*)(zp + (8 * tg_ + j) * 128 + 8 * eb_ + 4 * q); a_[4 * q] = av_[0]; a_[4 * q + 1] = av_[1]; a_[4 * q + 2] = av_[2]; a_[4 * q + 3] = av_[3]; } \
        _Pragma("unroll") for (int k = 0; k < 8; ++k) { const u32 ww_[4] = {W_[k].x, W_[k].y, W_[k].z, W_[k].w}; \
            _Pragma("unroll") for (int q = 0; q < 4; ++q) { \
                const f32x2_t lo_ = __builtin_amdgcn_cvt_pk_f32_fp8((int)ww_[q], false), hi_ = __builtin_amdgcn_cvt_pk_f32_fp8((int)ww_[q], true); \
                o_[4 * q] = fmaf(a_[k], lo_[0], o_[4 * q]); o_[4 * q + 1] = fmaf(a_[k], lo_[1], o_[4 * q + 1]); o_[4 * q + 2] = fmaf(a_[k], hi_[0], o_[4 * q + 2]); o_[4 * q + 3] = fmaf(a_[k], hi_[1], o_[4 * q + 3]); } } } while (0)
#define V_HBLD(sg_) do { const int tg_ = (sg_) & 1, s_ = (sg_) >> 1; const bf16_t* hb_ = HB + (size_t)(tw + 8 * tg_ + j) * DM + 128 * s_ + 16 * d; \
        hbA_ = *(const u32x4_t*)hb_; hbB_ = *(const u32x4_t*)(hb_ + 8); } while (0)
#define V_FIN(sg_) do { const int tg_ = (sg_) & 1, s_ = (sg_) >> 1, i_ = 8 * tg_ + j, t_ = tw + i_; \
        bf16_t* hb_ = HB + (size_t)t_ * DM + 128 * s_ + 16 * d; \
        { \
            const u32 gw_[8] = {hbA_.x, hbA_.y, hbA_.z, hbA_.w, hbB_.x, hbB_.y, hbB_.z, hbB_.w};        \
            float hv_[16]; \
            _Pragma("unroll") for (int q = 0; q < 8; ++q) { hv_[2 * q] = __uint_as_float(gw_[q] << 16) + o_[2 * q]; hv_[2 * q + 1] = __uint_as_float(gw_[q] & 0xffff0000u) + o_[2 * q + 1]; } \
            *(uint4*)hb_ = pack8(hv_); *(uint4*)(hb_ + 8) = pack8(hv_ + 8); \
            float ss_ = 0.f; \
            _Pragma("unroll") for (int q = 0; q < 16; ++q) ss_ += hv_[q] * hv_[q]; \
            ss_ += __shfl_xor(ss_, 1); ss_ += __shfl_xor(ss_, 2); ss_ += __shfl_xor(ss_, 4); \
            if (d == 0) ssl[i_] += ss_; } \
        _Pragma("unroll") for (int q = 0; q < 16; ++q) o_[q] = 0.f; } while (0)
    {
        u32x4_t wA[8], wB[8], hbA_, hbB_; float o_[16];
#pragma unroll
        for (int q = 0; q < 16; ++q) o_[q] = 0.f;
        V_LOAD(wA, 0);
#pragma unroll 1
        for (int sg = 0; sg < 16; ++sg) {
            V_HBLD(sg);
#pragma unroll 1
            for (int eb = 0; eb < 16; eb += 2) {
                const int st = sg * 16 + eb;
                V_LOAD(wB, st + 1);
                V_FMA(wA, st);
                V_LOAD(wA, (st + 2 < 256 ? st + 2 : 255));
                V_FMA(wB, st + 1);
            }
            V_FIN(sg);
        }
    }
#undef V_LOAD
#undef V_FMA
#undef V_FIN
#undef V_HBLD
    if (lane < 16) rss2[tw + lane] = ssl[lane];
}
#define XB_TMO      128
#define XB_XCNT(j)  (256  + 64 * (j))
#define XB_XSUB(j)  (1280 + 64 * (j))
#define XB_XGEN(j)  (2304 + 64 * (j))
#define XB_TOP      3328
#define XB_TOPGEN   3392
#define XCD_BAR_WORDS 3456
#define XB_SPIN_CAP (1u << 28)
__device__ __forceinline__ unsigned xb_ld(unsigned* p)              { return __hip_atomic_load(p, __ATOMIC_RELAXED, __HIP_MEMORY_SCOPE_AGENT); }
__device__ __forceinline__ unsigned xb_add(unsigned* p, unsigned v) { return __hip_atomic_fetch_add(p, v, __ATOMIC_RELAXED, __HIP_MEMORY_SCOPE_AGENT); }
__device__ __forceinline__ unsigned xb_xcc_id() { return (unsigned)__builtin_amdgcn_s_getreg((3 << 11) | 20) & 0xFu; }
#define XB_SPIN(cond, bar) do { unsigned _sp = 0; while (cond) { __builtin_amdgcn_s_sleep(1); \
    if ((++_sp & 255u) == 0u) { if (xb_ld(&(bar)[XB_TMO])) break; if (_sp > XB_SPIN_CAP) { atomicAdd(&(bar)[XB_TMO], 1u); break; } } } } while (0)
struct XcdBarrier { unsigned* bar; unsigned x; volatile LAS unsigned* st; };
__device__ __forceinline__ XcdBarrier xcd_barrier_post(unsigned* bar, volatile LAS unsigned* st) {
    XcdBarrier b; b.bar = bar; b.x = xb_xcc_id(); b.st = st;
    if (threadIdx.x == 0) (void)xb_add(&bar[XB_XCNT(b.x)], 1u);
    return b;
}
__device__ __forceinline__ void xcd_barrier_complete(unsigned* bar, unsigned x, unsigned& nloc, unsigned& nx) {
    const unsigned G = gridDim.x * gridDim.y * gridDim.z;
    unsigned sum, cnt, mine, sp = 0u;
    for (;;) {
        sum = 0u; cnt = 0u; mine = 0u;
#pragma unroll
        for (unsigned j = 0; j < 16; ++j) { const unsigned c = xb_ld(&bar[XB_XCNT(j)]); sum += c; cnt += (c > 0u) ? 1u : 0u; mine = (j == x) ? c : mine; }
        if (sum == G) break;
        __builtin_amdgcn_s_sleep(1);
        if ((++sp & 255u) == 0u) { if (xb_ld(&bar[XB_TMO])) break; if (sp > XB_SPIN_CAP) { atomicAdd(&bar[XB_TMO], 1u); break; } }
    }
    nloc = mine > 0u ? mine : 1u; nx = cnt > 0u ? cnt : 1u;
}
__device__ __forceinline__ void xcd_barrier(const XcdBarrier& b) {
    asm volatile("s_waitcnt vmcnt(0)" ::: "memory");
    __syncthreads();
    if (threadIdx.x == 0) {
        unsigned* bar = b.bar;
        __builtin_amdgcn_s_waitcnt(0);
        unsigned nloc = b.st[0], nx = b.st[1];
        if (nloc == 0u) { xcd_barrier_complete(bar, b.x, nloc, nx); b.st[0] = nloc; b.st[1] = nx; }
        const unsigned old = xb_add(&bar[XB_XSUB(b.x)], 1u);
        const unsigned gen = old / nloc;
        if (old + 1u == (gen + 1u) * nloc) {
            __builtin_amdgcn_fence(__ATOMIC_RELEASE, "agent");
            asm volatile("s_waitcnt vmcnt(0)" ::: "memory");
            const unsigned og = xb_add(&bar[XB_TOP], 1u);
            const unsigned tg = og / nx;
            if (og + 1u == (tg + 1u) * nx) xb_add(&bar[XB_TOPGEN], 1u);
            else XB_SPIN(xb_ld(&bar[XB_TOPGEN]) == tg, bar);
            __builtin_amdgcn_fence(__ATOMIC_ACQUIRE, "agent");
            xb_add(&bar[XB_XGEN(b.x)], 1u);
            asm volatile("s_waitcnt vmcnt(0)" ::: "memory");
        } else {
            XB_SPIN(xb_ld(&bar[XB_XGEN(b.x)]) == gen, bar);
            __builtin_amdgcn_fence(__ATOMIC_ACQUIRE, "agent");
            asm volatile("s_waitcnt vmcnt(0)" ::: "memory");
        }
    }
    __syncthreads();
}

constexpr int NTHR = 512;
constexpr int LDS_BYTES = 147456;
constexpr int LDS_MISC = 147456 - 256;
constexpr size_t CTL_BAR_OFF = 65536;
struct Args { const float* in[21]; float* out; unsigned char* ws; };

__global__ void __launch_bounds__(NTHR, 2) mega_fwd(Args a) {
    extern __shared__ __attribute__((aligned(16))) unsigned char lds[];
    const float* x = a.in[0]; const float* p = a.in[1]; const float* attn_norm = a.in[2]; const float* w_in = a.in[3];
    const float* lq1 = a.in[4]; const float* lk1 = a.in[5]; const float* lq2 = a.in[6]; const float* lk2 = a.in[7];
    const float* subln = a.in[8]; const float* w_out = a.in[9]; const float* rel_bias = a.in[10]; const float* ffn_norm = a.in[11];
    const float* peer_query = a.in[12]; const float* peer_subkeys = a.in[13]; const float* peer_u = a.in[14]; const float* peer_v = a.in[15];
    const float* ple_norm = a.in[16]; const float* ple_gate_w = a.in[17]; const float* ple_gate_b = a.in[18]; const float* ple_proj = a.in[19];
    const float* final_norm = a.in[20];
    unsigned char* ws = a.ws;
    float* H = a.out;
    float* ctl = (float*)(ws + WS_CTL); float* rss = (float*)(ws + WS_RSS); float* cs = (float*)(ws + WS_CS);
    float* rss1 = rss, *rss2 = rss + 32768, *rss3 = rss + 65536;
    bf16_t* WIN = (bf16_t*)(ws + WS_WIN); bf16_t* WOUT = (bf16_t*)(ws + WS_WOUT); bf16_t* WQ = (bf16_t*)(ws + WS_WQ); bf16_t* WG = (bf16_t*)(ws + WS_WG); bf16_t* WP = (bf16_t*)(ws + WS_WP);
    bf16_t* SUBK = (bf16_t*)(ws + WS_SUBK); bf16_t* U = (bf16_t*)(ws + WS_U); bf16_t* Vt = (bf16_t*)(ws + WS_V);
    bf16_t* XN = (bf16_t*)(ws + WS_XN); bf16_t* HB = XN; bf16_t* PB = (bf16_t*)(ws + WS_PB);
    bf16_t* Q = (bf16_t*)(ws + WS_Q); bf16_t* Kb = (bf16_t*)(ws + WS_K); bf16_t* VV = (bf16_t*)(ws + WS_VV);
    bf16_t* RQ = (bf16_t*)(ws + WS_RQ); bf16_t* RK = (bf16_t*)(ws + WS_RK); bf16_t* RV = (bf16_t*)(ws + WS_RV); bf16_t* RG = (bf16_t*)(ws + WS_RG);
    bf16_t* QRY = (bf16_t*)(ws + WS_QRY); int* IDX = (int*)(ws + WS_IDX); float* GATE = (float*)(ws + WS_GATE);
    bf16_t* MIX = (bf16_t*)(ws + WS_MIX); bf16_t* PP = MIX;
    float* RAWROT = (float*)(ws + WS_MIX);

    const int G = gridDim.x, bx = blockIdx.x, wave_s = __builtin_amdgcn_readfirstlane(threadIdx.x >> 6), gn = G * NTHR;
#define TIDS() const int lane = lane_id(), wave = wave_s, t512 = wave_s * 64 + lane, half = wave_s >> 2, tid = t512 & 255, gtid = bx * NTHR + t512; (void)gtid; (void)tid; (void)wave; (void)half
#define sm ((char*)lds + half * 65536)
    volatile LAS unsigned* misc = (volatile LAS unsigned*)((LAS unsigned char*)lds + LDS_MISC);
    if (threadIdx.x < 64) misc[threadIdx.x] = 0u;
    __syncthreads();
    XcdBarrier bar = xcd_barrier_post((unsigned*)(ws + WS_CTL + CTL_BAR_OFF), misc + 8);
#define VLOOP(NBLK) for (int base_ = 2 * bx, bid = base_ + half; base_ < (NBLK); base_ += 2 * G, bid = base_ + half)
#define GRID_BAR() xcd_barrier(bar)

#define GEMM_PHASE(EPI, A_, B_, N_, K_, ...) do { int k_ = K_; asm volatile("" : "+s"(k_)); pg8::Gemm g_{A_, B_, M, N_, k_}; pg8::StaticOrder S_; S_.init(M, N_, G, bx); EpiRow8<EPI> E_{EPI{__VA_ARGS__}}; \
        pg8::gemm_phase<EpiRow8<EPI>, pg8::StaticOrder, true, true>((PG8_LAS unsigned char*)lds, g_, S_, E_, wave_s * 64 + lane_id()); } while (0)
    {   TIDS();
    for (int g = gtid; g < 4096 * 32; g += gn) b_tables(g, lq1, lk1, lq2, lk2, rel_bias, ctl, cs);
    {
        LAS float* scr = (LAS float*)((LAS unsigned char*)lds + wave * 16384);
        const int gw = bx * 8 + wave, ngw = G * 8;
        constexpr int I1 = (DM / 64) * (INW / 32), I2 = (DM / 64) * (DM / 32), I3 = (DM / 64) * (2048 / 32), I4 = I2, I5 = (256 / 64) * (DM / 32);
        for (int it = gw; it < I1 + I2 + I3 + I4 + I5; it += ngw) {
            int q = it;
            if (q < I1) { wave_transpose_item<true>(w_in, DM, INW, WIN, nullptr, scr, q, lane); continue; } q -= I1;
            if (q < I2) { wave_transpose_item<false>(w_out, DM, DM, WOUT, nullptr, scr, q, lane); continue; } q -= I2;
            if (q < I3) { wave_transpose_item<false>(peer_query, DM, 2048, WQ, ffn_norm, scr, q, lane); continue; } q -= I3;
            if (q < I4) { wave_transpose_item<false>(ple_gate_w, DM, DM, WG, ple_norm, scr, q, lane); continue; } q -= I4;
            wave_transpose_item<false>(ple_proj, 256, DM, WP, nullptr, scr, q, lane);
        }
    }
    b_convert(gtid, gn, peer_subkeys, SUBK, (size_t)16 * 128 * 128 / 4, nullptr, 1024);
    for (int row = bx * 8 + wave; row < NEXP; row += G * 8) { b_rowquant(row, lane, peer_u, ffn_norm, (unsigned char*)U, (float*)(ws + WS_SU)); b_rowquant(row, lane, peer_v, nullptr, (unsigned char*)Vt, (float*)(ws + WS_SV)); }
    b_convert(gtid, gn, p, PB, (size_t)M * 256 / 4, nullptr, 256);
    for (int row = bx * 8 + wave; row < M; row += G * 8) b_rmsnorm_bf16(row, lane, x, attn_norm, XN, 1e-6f);
    }
    GRID_BAR();
    { int k_ = DM; asm volatile("" : "+s"(k_)); pg8::Gemm g_{XN, WIN, M, INW, k_}; pg8::StaticOrder S_; S_.init(M, INW, G, bx); EpiInProjT E_{ws, cs};
      pg8::gemm_phase<EpiInProjT, pg8::StaticOrder, true, true>((PG8_LAS unsigned char*)lds, g_, S_, E_, wave_s * 64 + lane_id()); }
    GRID_BAR();
    {
        const int vcu = (G & 7) ? bx : (bx & 7) * (G >> 3) + (bx >> 3);
        bf16_t* RKT = (bf16_t*)(ws + WS_RKT); float* KVT = (float*)(ws + WS_KVT); bf16_t* ST = (bf16_t*)(ws + WS_ST);
        { TIDS(); for (int u = vcu; u < BATCH * 4 * 32; u += G) ret_kv_unit(t512, u >> 5, u & 31, RV, RKT, KVT); }
        GRID_BAR();
        { TIDS(); for (int e = gtid; e < BATCH * 4 * 8192; e += gn) ret_scan(e, KVT, ST);
        for (int v = vcu; v < 256; v += G) {
            const int bh = v >> 3, sidx = v & 7;
#pragma unroll 1
            for (int i = 0; i < 4; ++i) {
                const int qb = (i == 0) ? 31 - sidx : (i == 1) ? 16 + sidx : (i == 2) ? 15 - sidx : sidx;
                attn_unit<0>((LAS unsigned char*)lds, t512, bh >> 2, bh & 3, qb, Q, Kb, VV, ctl, subln, MIX);
            }
        }
#ifdef ATT_PROBE
        for (int v = vcu; v < 256; v += G) {
            const int bh = v >> 3, sidx = v & 7;
#pragma unroll 1
            for (int i = 0; i < 4; ++i) {
                const int qb = (i == 0) ? 31 - sidx : (i == 1) ? 16 + sidx : (i == 2) ? 15 - sidx : sidx;
                attn_unit<ATT_PROBE>((LAS unsigned char*)lds, t512, bh >> 2, bh & 3, qb, Q, Kb, VV, ctl, subln, MIX);
            }
        }
#endif
        }
        GRID_BAR();
        { TIDS(); ret_out_units((LAS unsigned char*)lds, t512, vcu, G, BATCH * 4 * 32, RQ, RK, RV, ST, RG, MIX); __syncthreads(); }
    }
    GRID_BAR();
    GEMM_PHASE(EpiOutProj, MIX, WOUT, DM, DM, x, H, HB, rss1);
    GRID_BAR();
    GEMM_PHASE(EpiQry, HB, WQ, 2048, DM, QRY, rss1);
    GRID_BAR();
    {   TIDS();
        const int head = bx & 7, nw = G >> 3, wq = bx >> 3;
        __syncthreads();
        for (int c16 = t512; c16 < 2 * 128 * 16; c16 += NTHR) { const int row = c16 >> 4, ch = c16 & 15;
            *(LAS u32x4_t*)((LAS unsigned char*)lds + row * SKROW + 16 * ch) = *(const u32x4_t*)(SUBK + ((size_t)head * 256 + row) * 128 + 8 * ch); }
        __syncthreads();
        {   bf16x8_t qf[8]; int tb = wq + nw * wave;
            { const bf16_t* q0 = QRY + (size_t)((tb < M / 32 ? tb : 0) * 32 + (lane & 31)) * 2048 + head * 256 + 8 * (lane >> 5);
#pragma unroll
              for (int ks = 0; ks < 8; ++ks) qf[ks] = *(const bf16x8_t*)(q0 + 16 * ks); }
#pragma unroll 1
            for (; tb < M / 32; tb += nw * 8) { const int tn = tb + nw * 8 < M / 32 ? tb + nw * 8 : tb;
                peer_topk_unit(lane, tb * 32, tn * 32, head, QRY, qf, (const LAS unsigned char*)lds, (LAS unsigned char*)lds + 2 * 128 * SKROW + wave * (32 * 144), IDX, GATE); } }
        __syncthreads();
    }
    GRID_BAR();
    {   TIDS(); __syncthreads(); for (int tb = bx; tb < M / 128; tb += G) peer_sliced((LAS unsigned char*)lds, lane, wave, tb * 128, (const unsigned char*)U, (const unsigned char*)Vt, (const float*)(ws + WS_SU), (const float*)(ws + WS_SV), (const unsigned char*)(ws + WS_HB8), (const float*)(ws + WS_SH), IDX, GATE, H, HB, rss1, rss2); __syncthreads(); }
    GRID_BAR();
    GEMM_PHASE(EpiPP, PB, WP, DM, 256, PP);
    GRID_BAR();
    GEMM_PHASE(EpiGate, HB, WG, DM, DM, HB, PP, ple_gate_b, rss2, rss3, QRY);
    GRID_BAR();
    {   TIDS(); for (size_t g = gtid; g < (size_t)M * DM / 8; g += gn) b_final(g, QRY, H, rss3, final_norm); }
}

extern "C" void kernel_launch(void* const* d_in, const int* in_sizes, int n_in, void* d_out, int out_size, void* d_ws, size_t ws_size, hipStream_t stream) {
    static int grid = 0;
    if (grid == 0) {
        int dev = 0, cus = 0;
        if (n_in != 21 || out_size != M * DM || ws_size < WS_END) { fprintf(stderr, "kernel_launch: unexpected problem shape (n_in %d out %d ws %zu)\n", n_in, out_size, ws_size); grid = -1; return; }
        if (hipGetDevice(&dev) != hipSuccess || hipDeviceGetAttribute(&cus, hipDeviceAttributeMultiprocessorCount, dev) != hipSuccess) { grid = -1; return; }
        if (hipFuncSetAttribute((const void*)mega_fwd, hipFuncAttributeMaxDynamicSharedMemorySize, LDS_BYTES) != hipSuccess) { fprintf(stderr, "kernel_launch: hipFuncSetAttribute failed\n"); grid = -1; return; }
        int per_cu = 0;
        if (hipOccupancyMaxActiveBlocksPerMultiprocessor(&per_cu, (const void*)mega_fwd, NTHR, LDS_BYTES) != hipSuccess || per_cu < 1) { fprintf(stderr, "kernel_launch: occupancy query says %d\n", per_cu); }
        (void)hipGetLastError();
        grid = cus;
    }
    if (grid < 0) return;
    if (hipMemsetAsync((char*)d_ws, 0, WS_RSS + 3 * 32768 * 4, stream) != hipSuccess) return;
    Args a{};
    for (int i = 0; i < 21; ++i) a.in[i] = (const float*)d_in[i];
    a.out = (float*)d_out; a.ws = (unsigned char*)d_ws;
    hipLaunchKernelGGL(mega_fwd, dim3(grid), dim3(NTHR), LDS_BYTES, stream, a);
}
```

```cpp
#include <hip/hip_runtime.h>
#include <cstdint>
#include <cstdio>

typedef unsigned short bf16_t;
typedef unsigned int u32;
#define LAS __attribute__((address_space(3)))

constexpr int BATCH = 8, SEQ = 4096, DM = 1024, M = BATCH * SEQ;
constexpr int INW = 3072;
constexpr int NEXP = 16384;
constexpr float LOG2E = 1.4426950408889634f;
constexpr float QSCALE = 0.125f * LOG2E;

constexpr size_t MiB = 1u << 20;
constexpr size_t WS_CTL = 0;
constexpr size_t WS_RSS = 1 * MiB;
constexpr size_t WS_CS = 2 * MiB;
constexpr size_t WS_WIN = 4 * MiB;
constexpr size_t WS_WOUT = 10 * MiB;
constexpr size_t WS_WQ = 12 * MiB;
constexpr size_t WS_WG = 16 * MiB;
constexpr size_t WS_WP = 18 * MiB;
constexpr size_t WS_SUBK = 18 * MiB + 512 * 1024;
constexpr size_t WS_U = 20 * MiB;
constexpr size_t WS_V = 52 * MiB;
constexpr size_t WS_XN = 84 * MiB;
constexpr size_t WS_PB = 148 * MiB;
constexpr size_t WS_BIG = 164 * MiB;
constexpr size_t WS_Q = WS_BIG, WS_K = WS_BIG + 32 * MiB, WS_VV = WS_BIG + 64 * MiB;
constexpr size_t WS_RQ = WS_BIG + 96 * MiB, WS_RK = WS_BIG + 112 * MiB, WS_RV = WS_BIG + 128 * MiB, WS_RG = WS_BIG + 160 * MiB;
constexpr size_t WS_QRY = WS_BIG;
constexpr size_t WS_IDX = WS_BIG + 128 * MiB;
constexpr size_t WS_GATE = WS_BIG + 144 * MiB;
constexpr size_t WS_MIX = 356 * MiB;
constexpr size_t WS_RKT = 420 * MiB;
constexpr size_t WS_KVT = 436 * MiB;
constexpr size_t WS_ST = 468 * MiB;
constexpr size_t WS_END = 484 * MiB;
constexpr size_t WS_HB8 = WS_MIX, WS_SH = WS_MIX + 32 * MiB;
constexpr size_t WS_SU = WS_U + 16 * MiB, WS_SV = WS_U + 16 * MiB + 65536;

__device__ __forceinline__ float bf2f(bf16_t v) { return __uint_as_float(((u32)v) << 16); }
__device__ __forceinline__ bf16_t f2bf(float f) { u32 u = __float_as_uint(f); return (bf16_t)((u + 0x7fffu + ((u >> 16) & 1u)) >> 16); }

__device__ __forceinline__ int lane_id() { int l; asm volatile("v_mbcnt_lo_u32_b32 %0, -1, 0\n\tv_mbcnt_hi_u32_b32 %0, -1, %0" : "=v"(l)); return l; }
__device__ __forceinline__ float wave_sum(float v) {
#pragma unroll
    for (int o = 1; o < 64; o <<= 1) v += __shfl_xor(v, o);
    return v;
}
__device__ __forceinline__ float wave_max(float v) {
#pragma unroll
    for (int o = 1; o < 64; o <<= 1) v = fmaxf(v, __shfl_xor(v, o));
    return v;
}

__host__ __device__ __forceinline__ int rot_dst_row(int n);
template <bool ROT> __device__ __forceinline__ void b_transpose_wt(int bid, int tid, char* sm, const float* __restrict__ W, int K, int N, bf16_t* __restrict__ WT, const float* __restrict__ gain) {
    float (*t)[33] = (float (*)[33])sm;
    const int nbx = N / 32; const int k0 = (bid / nbx) * 32, n0 = (bid % nbx) * 32, tx = tid & 31, ty = tid >> 5;
    __syncthreads();
    for (int i = ty; i < 32; i += 8) { float g = gain ? gain[k0 + i] : 1.f; t[i][tx] = W[(size_t)(k0 + i) * N + n0 + tx] * g; }
    __syncthreads();
    for (int i = ty; i < 32; i += 8) WT[(size_t)(ROT ? rot_dst_row(n0 + i) : (n0 + i)) * K + k0 + tx] = f2bf(t[tx][i]);
}
__device__ __forceinline__ void b_transpose_w(int bid, int tid, char* sm, const float* __restrict__ W, int K, int N, bf16_t* __restrict__ WT, const float* __restrict__ gain) {
    float (*t)[33] = (float (*)[33])sm;
    const int nbx = N / 32; const int k0 = (bid / nbx) * 32, n0 = (bid % nbx) * 32, tx = tid & 31, ty = tid >> 5;
    __syncthreads();
    for (int i = ty; i < 32; i += 8) { float g = gain ? gain[k0 + i] : 1.f; t[i][tx] = W[(size_t)(k0 + i) * N + n0 + tx] * g; }
    __syncthreads();
    for (int i = ty; i < 32; i += 8) WT[(size_t)(n0 + i) * K + k0 + tx] = f2bf(t[tx][i]);
}
__device__ __forceinline__ void b_convert(int gtid, int gn, const float* __restrict__ in, bf16_t* __restrict__ out, size_t n4, const float* __restrict__ gain, int period) {
    for (size_t i = (size_t)gtid; i < n4; i += (size_t)gn) {
        float4 v = ((const float4*)in)[i];
        if (gain) { const int c = (int)((i * 4) % period); v.x *= gain[c]; v.y *= gain[c + 1]; v.z *= gain[c + 2]; v.w *= gain[c + 3]; }
        ushort4 o; o.x = f2bf(v.x); o.y = f2bf(v.y); o.z = f2bf(v.z); o.w = f2bf(v.w);
        ((ushort4*)out)[i] = o;
    }
}
__device__ __forceinline__ void b_rmsnorm_bf16(int row, int lane, const float* __restrict__ x, const float* __restrict__ gain, bf16_t* __restrict__ out, float eps) {
    const float4* xr = (const float4*)(x + (size_t)row * DM);
    float4 v[4]; float s = 0.f;
#pragma unroll
    for (int j = 0; j < 4; ++j) { v[j] = xr[lane + 64 * j]; s += v[j].x * v[j].x + v[j].y * v[j].y + v[j].z * v[j].z + v[j].w * v[j].w; }
    s = wave_sum(s);
    const float r = rsqrtf(s * (1.f / DM) + eps);
#pragma unroll
    for (int j = 0; j < 4; ++j) {
        const float4 g = ((const float4*)gain)[lane + 64 * j];
        ushort4 o; o.x = f2bf(v[j].x * r * g.x); o.y = f2bf(v[j].y * r * g.y); o.z = f2bf(v[j].z * r * g.z); o.w = f2bf(v[j].w * r * g.w);
        ((ushort4*)(out + (size_t)row * DM))[lane + 64 * j] = o;
    }
}
__device__ __forceinline__ void sincos_acc(float ang, float& s, float& c) {
    const double x = (double)ang;
    const double k = rint(x * 0.63661977236758134308);
    double r = fma(-k, 1.57079632679489655800, x); r = fma(-k, 6.12323399573676603587e-17, r);
    const double r2 = r * r;
    double sp = r * (1.0 + r2 * (-1.0 / 6 + r2 * (1.0 / 120 + r2 * (-1.0 / 5040 + r2 * (1.0 / 362880 + r2 * (-1.0 / 39916800 + r2 * (1.0 / 6227020800.0)))))));
    double cp = 1.0 + r2 * (-0.5 + r2 * (1.0 / 24 + r2 * (-1.0 / 720 + r2 * (1.0 / 40320 + r2 * (-1.0 / 3628800 + r2 * (1.0 / 479001600.0 + r2 * (-1.0 / 87178291200.0)))))));
    const int q = ((int)(long long)k) & 3;
    double ss, cc;
    if (q == 0) { ss = sp; cc = cp; } else if (q == 1) { ss = cp; cc = -sp; } else if (q == 2) { ss = -sp; cc = -cp; } else { ss = -cp; cc = sp; }
    s = (float)ss; c = (float)cc;
}
__device__ __forceinline__ void b_tables(int gid, const float* lq1, const float* lk1, const float* lq2, const float* lk2, const float* __restrict__ rel_bias,
                                                float* __restrict__ ctl, float* __restrict__ cs) {
    if (gid == 0) {
        float a = 0.f, b = 0.f;
        for (int i = 0; i < 64; ++i) { a += lq1[i] * lk1[i]; b += lq2[i] * lk2[i]; }
        ctl[0] = expf(a) - expf(b) + 0.2f;
    }
    if (gid < 512) {
        const int h = gid >> 7, n = gid & 127;
        int bucket;
        if (n < 16) bucket = n;
        else { const float nf = (float)n; int lg = 16 + (int)(logf(nf / 16.0f) / 2.0794415416798357f * 16.0f); bucket = lg < 31 ? lg : 31; }
        ctl[64 + h * 128 + n] = rel_bias[bucket * 4 + h] * LOG2E;
    }
    if (gid < 4096 * 32) {
        const int pos = gid >> 5, i = gid & 31;
        const float freq = 1.0f / powf(10000.0f, (float)i / 32.0f);
        const float ang = (float)pos * freq;
        float s, c; sincos_acc(ang, s, c);
        cs[gid] = c; cs[4096 * 32 + gid] = s;
    }
}

namespace pg8 {
#define PG8_LAS __attribute__((address_space(3)))
typedef unsigned short bf16_t;
typedef short bf16x8 __attribute__((ext_vector_type(8)));
typedef float f32x4 __attribute__((ext_vector_type(4)));
typedef unsigned u32x4 __attribute__((ext_vector_type(4)));
constexpr int BM = 256, BK = 64, HALF = 128, HTB = HALF * BK * 2  , STAGE_BYTES = 8 * HTB, NXCD = 8, WGM = 8;

__host__ __device__ __forceinline__ int lds_byte(int r, int c) { const int st = (r >> 4) * 2 + (c >> 5), rr = r & 15, cc = c & 31, ob = rr * 64 + cc * 2; return st * 1024 + (ob ^ (((ob >> 9) & 1) << 5)); }
__host__ __device__ __forceinline__ void stage_rc(int b, int& R, int& C) { const int st = b / 1024, sb = b % 1024, swz = sb ^ (((sb >> 9) & 1) << 5); R = (st >> 1) * 16 + swz / 64; C = (st & 1) * 32 + (swz % 64) / 2; }
__host__ __device__ __forceinline__ int perm32(int rho) { const int n = rho >> 4, i = rho & 15; return 8 * (i >> 2) + 4 * n + (i & 3); }

struct Unit { int pm, pn; };
struct Gemm { const bf16_t* A; const bf16_t* Bt; int M, N, K; };

struct StaticOrder {
    int nM, nN, nwg, G, c;
    __host__ __device__ void init(int M, int N, int G_, int c_) { nM = M / BM; nN = N / BM; nwg = nM * nN; G = G_; c = c_; }
    __host__ __device__ bool next(int i, Unit& u) const {
        const long L = (long)i * G + c; if (L >= nwg) return false;
        int wgid = (int)L; { const int q = nwg / NXCD, r = nwg % NXCD, xcd = wgid % NXCD, off = wgid / NXCD; wgid = (xcd < r ? xcd * (q + 1) : r * (q + 1) + (xcd - r) * q) + off; }
        const int nig = WGM * nN, gid = wgid / nig, fm = gid * WGM, gsz = (nM - fm) < WGM ? (nM - fm) : WGM;
        u.pm = fm + ((wgid % nig) % gsz); u.pn = (wgid % nig) / gsz; return true;
    }
    __device__ __forceinline__ void a_ready(const Unit&) const {}
    __device__ __forceinline__ void done(const Unit&) const {}
};

__device__ __forceinline__ unsigned cvt_pk_bf16(float lo, float hi) { unsigned r; asm volatile("v_cvt_pk_bf16_f32 %0, %1, %2" : "=v"(r) : "v"(lo), "v"(hi)); return r; }
typedef float f32x2 __attribute__((ext_vector_type(2)));
template <class Epi, class Sched, bool ALIGN_EPI = false, bool SP2 = false>
__device__ __forceinline__ void gemm_phase(PG8_LAS unsigned char* lds, const Gemm g, const Sched& S, const Epi& E, const int tid) {
    const int wid = __builtin_amdgcn_readfirstlane(tid >> 6), lane = tid & 63, wr = wid >> 2, wc = wid & 3, fr = lane & 15, fq = lane >> 4;
    const int K = g.K, nt = K / BK;
    unsigned voffA[2], voffB[2];
#pragma unroll
    for (int i = 0; i < 2; ++i) { int R, C; stage_rc(tid * 16 + i * 8192, R, C); const int Rb = Epi::PERM ? ((R & ~31) + perm32(R & 31)) : R;
        voffA[i] = (unsigned)(R * K + C) * 2u; voffB[i] = (unsigned)(Rb * K + C) * 2u; }
    const size_t kstep = (size_t)(BK * 2);
    const size_t hstep = (size_t)HALF * K * 2;
    const size_t tstep = 2 * hstep;
    const unsigned ldsw = (unsigned)wid * 1024u;
    const int aoff = lds_byte(wr * 64 + fr, fq * 8), boff = lds_byte(wc * 32 + fr, fq * 8);
#define PG8_SA(b, h) (((b) * 2 + (h)) * HTB)
#define PG8_SB(b, h) ((4 + (b) * 2 + (h)) * HTB)
#define PG8_STAGE(bufoff, gbase, voff) do { _Pragma("unroll") for (int _i = 0; _i < 2; ++_i) \
        __builtin_amdgcn_global_load_lds((const unsigned*)((const char*)(gbase) + (voff)[_i]), (PG8_LAS unsigned*)(lds + (bufoff) + ldsw + _i * 8192), 16, 0, 0); } while (0)
#define PG8_LDA(dst, b, h) do { _Pragma("unroll") for (int m = 0; m < 4; ++m) _Pragma("unroll") for (int k = 0; k < 2; ++k) dst[m][k] = *(const PG8_LAS bf16x8*)(lds + PG8_SA(b, h) + aoff + m * 2048 + k * 1024); } while (0)
#define PG8_LDB(dst, b, h) do { _Pragma("unroll") for (int n = 0; n < 2; ++n) _Pragma("unroll") for (int k = 0; k < 2; ++k) dst[n][k] = *(const PG8_LAS bf16x8*)(lds + PG8_SB(b, h) + boff + n * 2048 + k * 1024); } while (0)
#define PG8_MMA(ai, bj, At, Bt) do { __builtin_amdgcn_s_setprio(1); _Pragma("unroll") for (int m = 0; m < 4; ++m) _Pragma("unroll") for (int n = 0; n < 2; ++n) _Pragma("unroll") for (int k = 0; k < 2; ++k) \
        acc[ai][bj][m][n] = __builtin_amdgcn_mfma_f32_16x16x32_bf16(Bt[n][k], At[m][k], acc[ai][bj][m][n], 0, 0, 0); __builtin_amdgcn_s_setprio(0); } while (0)
#define PG8_WAIT_V(n) asm volatile("s_waitcnt vmcnt(" #n ")" ::: "memory")
#define PG8_WAIT_L(n) asm volatile("s_waitcnt lgkmcnt(" #n ")" ::: "memory")
#define PG8_BAR __builtin_amdgcn_s_barrier()
#define PG8_SCHED __builtin_amdgcn_sched_barrier(0)
    Unit cur, nxt; int ui = 0;
    if (!S.next(0, cur)) return;
    f32x4 acc[2][2][4][2];
#pragma unroll
    for (int a = 0; a < 2; ++a)
#pragma unroll
        for (int b = 0; b < 2; ++b)
#pragma unroll
            for (int m = 0; m < 4; ++m)
#pragma unroll
                for (int n = 0; n < 2; ++n) acc[a][b][m][n] = (f32x4){0.f, 0.f, 0.f, 0.f};
    bf16x8 At[4][2], B0[2][2], B1[2][2];
    const char* cA = (const char*)g.A + (size_t)cur.pm * tstep; const char* cB = (const char*)g.Bt + (size_t)cur.pn * tstep;
    S.a_ready(cur);
    if constexpr (SP2) {
        PG8_STAGE(PG8_SB(0, 0), cB, voffB); PG8_STAGE(PG8_SB(0, 1), cB + hstep, voffB); PG8_STAGE(PG8_SA(0, 0), cA, voffA); PG8_STAGE(PG8_SA(0, 1), cA + hstep, voffA);
        if (wr == 1) PG8_BAR;
        PG8_WAIT_V(2); PG8_BAR;
        PG8_STAGE(PG8_SB(1, 0), cB + kstep, voffB); PG8_STAGE(PG8_SA(1, 0), cA + kstep, voffA); PG8_STAGE(PG8_SB(1, 1), cB + hstep + kstep, voffB);
        PG8_WAIT_V(6); PG8_BAR;
    } else {
        PG8_STAGE(PG8_SB(0, 0), cB, voffB); PG8_STAGE(PG8_SA(0, 0), cA, voffA); PG8_STAGE(PG8_SB(0, 1), cB + hstep, voffB); PG8_STAGE(PG8_SA(0, 1), cA + hstep, voffA);
        if (wr == 1) PG8_BAR;
        PG8_WAIT_V(4); PG8_BAR;
        PG8_STAGE(PG8_SB(1, 0), cB + kstep, voffB); PG8_STAGE(PG8_SA(1, 0), cA + kstep, voffA); PG8_STAGE(PG8_SB(1, 1), cB + hstep + kstep, voffB);
        PG8_WAIT_V(6); PG8_BAR;
    }
    for (;;) {
        const bool has_next = S.next(ui + 1, nxt);
        const char* nA = has_next ? (const char*)g.A + (size_t)nxt.pm * tstep : cA; const char* nB = has_next ? (const char*)g.Bt + (size_t)nxt.pn * tstep : cB;
        for (int t = 0; t < nt; t += 2) {
            const bool last = (t == nt - 2);
            const char* a1 = cA + (size_t)(t + 1) * kstep;
            const char* a2 = last ? nA : cA + (size_t)(t + 2) * kstep; const char* b2 = last ? nB : cB + (size_t)(t + 2) * kstep;
            const char* a3 = a2 + kstep; const char* b3 = b2 + kstep;
            if (last && has_next) S.a_ready(nxt);
            if constexpr (SP2) {
            PG8_LDB(B0, 0, 0); PG8_LDB(B1, 0, 1); PG8_SCHED; PG8_LDA(At, 0, 0); PG8_STAGE(PG8_SA(1, 1), a1 + hstep, voffA);
            PG8_WAIT_V(8); PG8_WAIT_L(0); PG8_BAR; PG8_MMA(0, 0, At, B0); PG8_MMA(0, 1, At, B1); PG8_BAR; PG8_SCHED;
            PG8_LDA(At, 0, 1); PG8_STAGE(PG8_SB(0, 0), b2, voffB); PG8_STAGE(PG8_SB(0, 1), b2 + hstep, voffB); PG8_STAGE(PG8_SA(0, 0), a2, voffA);
            PG8_WAIT_V(8); PG8_WAIT_L(0); PG8_BAR; PG8_MMA(1, 0, At, B0); PG8_MMA(1, 1, At, B1); PG8_BAR; PG8_SCHED;
            PG8_LDB(B0, 1, 0); PG8_LDB(B1, 1, 1); PG8_SCHED; PG8_LDA(At, 1, 0); PG8_STAGE(PG8_SA(0, 1), a2 + hstep, voffA);
            PG8_WAIT_V(8); PG8_WAIT_L(0); PG8_BAR; PG8_MMA(0, 0, At, B0); PG8_MMA(0, 1, At, B1); PG8_BAR; PG8_SCHED;
            PG8_LDA(At, 1, 1); PG8_STAGE(PG8_SB(1, 0), b3, voffB); PG8_STAGE(PG8_SB(1, 1), b3 + hstep, voffB); PG8_STAGE(PG8_SA(1, 0), a3, voffA);
            PG8_WAIT_V(8); PG8_WAIT_L(0); PG8_BAR; PG8_MMA(1, 0, At, B0); PG8_MMA(1, 1, At, B1); PG8_BAR; PG8_SCHED;
            } else {
            PG8_LDB(B0, 0, 0); PG8_SCHED; PG8_LDA(At, 0, 0); PG8_STAGE(PG8_SA(1, 1), a1 + hstep, voffA);
            PG8_WAIT_L(8); PG8_BAR; PG8_WAIT_L(0); PG8_MMA(0, 0, At, B0); PG8_BAR; PG8_SCHED;
            PG8_LDB(B1, 0, 1); PG8_STAGE(PG8_SB(0, 0), b2, voffB);
            PG8_BAR; PG8_WAIT_L(0); PG8_MMA(0, 1, At, B1); PG8_BAR;
            PG8_LDA(At, 0, 1); PG8_STAGE(PG8_SA(0, 0), a2, voffA);
            PG8_BAR; PG8_WAIT_L(0); PG8_MMA(1, 0, At, B0); PG8_BAR; PG8_SCHED;
            PG8_STAGE(PG8_SB(0, 1), b2 + hstep, voffB);
            PG8_WAIT_V(6); PG8_BAR; PG8_MMA(1, 1, At, B1); PG8_BAR;
            PG8_LDB(B0, 1, 0); PG8_SCHED; PG8_LDA(At, 1, 0); PG8_STAGE(PG8_SA(0, 1), a2 + hstep, voffA);
            PG8_WAIT_L(8); PG8_BAR; PG8_WAIT_L(0); PG8_MMA(0, 0, At, B0); PG8_BAR; PG8_SCHED;
            PG8_LDB(B1, 1, 1); PG8_STAGE(PG8_SB(1, 0), b3, voffB);
            PG8_BAR; PG8_WAIT_L(0); PG8_MMA(0, 1, At, B1); PG8_BAR;
            PG8_LDA(At, 1, 1); PG8_STAGE(PG8_SA(1, 0), a3, voffA);
            PG8_BAR; PG8_WAIT_L(0); PG8_MMA(1, 0, At, B0); PG8_BAR; PG8_SCHED;
            PG8_STAGE(PG8_SB(1, 1), b3 + hstep, voffB);
            PG8_WAIT_V(6); PG8_BAR; PG8_MMA(1, 1, At, B1); PG8_BAR;
            }
        }
        if constexpr (ALIGN_EPI) { if (wr == 0) PG8_BAR; }
        if constexpr (!Epi::AFTER_DRAIN) { E(acc, cur, wr, wc, fr, fq); S.done(cur); }
        if (!has_next) break;
#pragma unroll
        for (int a = 0; a < 2; ++a)
#pragma unroll
            for (int b = 0; b < 2; ++b)
#pragma unroll
                for (int m = 0; m < 4; ++m)
#pragma unroll
                    for (int n = 0; n < 2; ++n) acc[a][b][m][n] = (f32x4){0.f, 0.f, 0.f, 0.f};
        cur = nxt; cA = nA; cB = nB; ++ui;
        if constexpr (ALIGN_EPI) { if (wr == 1) PG8_BAR; }
    }
    PG8_WAIT_V(0);
    if constexpr (!ALIGN_EPI) { if (wr == 0) PG8_BAR; }
    PG8_BAR;
    if constexpr (Epi::AFTER_DRAIN) { E.fused(acc, cur, wr, wc, fr, fq, lds, wid, lane); S.done(cur); }
#undef PG8_SA
#undef PG8_SB
#undef PG8_STAGE
#undef PG8_LDA
#undef PG8_LDB
#undef PG8_MMA
#undef PG8_WAIT_V
#undef PG8_WAIT_L
#undef PG8_BAR
#undef PG8_SCHED
}
}

template <class E> struct EpiRow8 {
    static constexpr bool PERM = true, AFTER_DRAIN = false;
    E e;
    __device__ __forceinline__ void operator()(const pg8::f32x4 (&acc)[2][2][4][2], const pg8::Unit& u, int wr, int wc, int fr, int fq) const {
        const int row0 = u.pm * 256 + wr * 64 + fr, col0 = u.pn * 256 + wc * 32 + 8 * fq;
#pragma unroll
        for (int ai = 0; ai < 2; ++ai)
#pragma unroll
            for (int m = 0; m < 4; ++m) {
                const int row = row0 + ai * 128 + m * 16; float s = 0.f;
#pragma unroll
                for (int bj = 0; bj < 2; ++bj) {
                    const float v[8] = {acc[ai][bj][m][0][0], acc[ai][bj][m][0][1], acc[ai][bj][m][0][2], acc[ai][bj][m][0][3], acc[ai][bj][m][1][0], acc[ai][bj][m][1][1], acc[ai][bj][m][1][2], acc[ai][bj][m][1][3]};
                    s += e.row8(row, col0 + bj * 128, v);
                }
                if (E::ROWSUM) { s += __shfl_xor(s, 16); s += __shfl_xor(s, 32); if (fq == 0) e.rowsum(row, s); }
            }
    }
};
__device__ __forceinline__ uint4 pack8_asm(const float* w) { uint4 o; o.x = pg8::cvt_pk_bf16(w[0], w[1]); o.y = pg8::cvt_pk_bf16(w[2], w[3]); o.z = pg8::cvt_pk_bf16(w[4], w[5]); o.w = pg8::cvt_pk_bf16(w[6], w[7]); return o; }

template <class Epi>
__device__ __forceinline__ void b_gemm(int bid, int tid, char* sm, int nbx, const bf16_t* __restrict__ A, const bf16_t* __restrict__ Bt, int K, const Epi& epi) {
    float (*As)[132] = (float (*)[132])sm;
    float (*Bs)[132] = (float (*)[132])(sm + 16 * 132 * 4);
    const int tx = tid & 15, ty = tid >> 4;
    const int row0 = (bid / nbx) * 128, col0 = (bid % nbx) * 128;
    const int lr = tid >> 1, lk = (tid & 1) * 8;
    const bf16_t* ap = A + (size_t)(row0 + lr) * K + lk;
    const bf16_t* bp = Bt + (size_t)(col0 + lr) * K + lk;
    float acc[8][8];
#pragma unroll
    for (int i = 0; i < 8; ++i)
#pragma unroll
        for (int j = 0; j < 8; ++j) acc[i][j] = 0.f;
    for (int k0 = 0; k0 < K; k0 += 16) {
        const uint4 av = *(const uint4*)(ap + k0), bv = *(const uint4*)(bp + k0);
        __syncthreads();
        const u32 aw[4] = {av.x, av.y, av.z, av.w}, bw[4] = {bv.x, bv.y, bv.z, bv.w};
#pragma unroll
        for (int j = 0; j < 4; ++j) {
            As[lk + 2 * j][lr] = __uint_as_float(aw[j] << 16); As[lk + 2 * j + 1][lr] = __uint_as_float(aw[j] & 0xffff0000u);
            Bs[lk + 2 * j][lr] = __uint_as_float(bw[j] << 16); Bs[lk + 2 * j + 1][lr] = __uint_as_float(bw[j] & 0xffff0000u);
        }
        __syncthreads();
#pragma unroll 2
        for (int k = 0; k < 16; ++k) {
            float a[8], b[8];
            const float4 a0 = *(const float4*)&As[k][ty * 8], a1 = *(const float4*)&As[k][ty * 8 + 4];
            const float4 b0 = *(const float4*)&Bs[k][tx * 8], b1 = *(const float4*)&Bs[k][tx * 8 + 4];
            a[0] = a0.x; a[1] = a0.y; a[2] = a0.z; a[3] = a0.w; a[4] = a1.x; a[5] = a1.y; a[6] = a1.z; a[7] = a1.w;
            b[0] = b0.x; b[1] = b0.y; b[2] = b0.z; b[3] = b0.w; b[4] = b1.x; b[5] = b1.y; b[6] = b1.z; b[7] = b1.w;
#pragma unroll
            for (int i = 0; i < 8; ++i)
#pragma unroll
                for (int j = 0; j < 8; ++j) acc[i][j] = fmaf(a[i], b[j], acc[i][j]);
        }
    }
#pragma unroll
    for (int i = 0; i < 8; ++i) { const float s_ = epi.row8(row0 + ty * 8 + i, col0 + tx * 8, acc[i]); if (Epi::ROWSUM) epi.rowsum(row0 + ty * 8 + i, s_); }
}

struct EpiInProj {
    static constexpr bool ROWSUM = false;
    __device__ __forceinline__ void rowsum(int, float) const {}
    bf16_t *Q, *Kb, *V, *RQ, *RK, *RV, *RG; const float* cs;
    __device__ __forceinline__ float row8(int row, int col, const float* v) const {
        bf16_t* dst; float sc = 1.f; int c = col; bool silu = false;
        if (col < 512) { dst = Q + (size_t)row * 512; sc = QSCALE; }
        else if (col < 1024) { dst = Kb + (size_t)row * 512; c = col - 512; }
        else if (col < 1536) { dst = V + (size_t)row * 512; c = col - 1024; }
        else if (col < 1792) { dst = RQ + (size_t)row * 256; c = col - 1536; }
        else if (col < 2048) { dst = RK + (size_t)row * 256; c = col - 1792; }
        else if (col < 2560) { dst = RV + (size_t)row * 512; c = col - 2048; }
        else { dst = RG + (size_t)row * 512; c = col - 2560; silu = true; }
        const bool rot = (col >= 1536 && col < 2048);
        if (rot) {
            float* raw = rawrot + (size_t)row * 512 + (col - 1536);
#pragma unroll
            for (int j = 0; j < 8; ++j) raw[j] = v[j];
            return 0.f;
        }
        ushort4 o0, o1; float w[8];
#pragma unroll
        for (int j = 0; j < 8; ++j) { float x = v[j] * sc; if (silu) x = x / (1.f + __expf(-x)); w[j] = x; }
        o0.x = f2bf(w[0]); o0.y = f2bf(w[1]); o0.z = f2bf(w[2]); o0.w = f2bf(w[3]); o1.x = f2bf(w[4]); o1.y = f2bf(w[5]); o1.z = f2bf(w[6]); o1.w = f2bf(w[7]);
        *(ushort4*)(dst + c) = o0; *(ushort4*)(dst + c + 4) = o1;
        return 0.f;
    }
    float* rawrot;
};
__device__ __forceinline__ void b_rotary(size_t gid, const float* __restrict__ raw, const float* __restrict__ cs, bf16_t* __restrict__ RQ, bf16_t* __restrict__ RK) {
    const int row = (int)(gid >> 9), c = (int)(gid & 511);
    const int which = c >> 8, cc = c & 255, d = cc & 63, i = d & 31, pos = row & (SEQ - 1);
    const float co = cs[pos * 32 + i], si = cs[4096 * 32 + pos * 32 + i];
    const float* r = raw + (size_t)row * 512 + which * 256 + (cc & ~63);
    const float x1 = r[i], x2 = r[i + 32];
    float o = (d < 32) ? (x1 * co - x2 * si) : (x1 * si + x2 * co);
    if (which) { o *= 0.125f; RK[(size_t)row * 256 + cc] = f2bf(o); } else RQ[(size_t)row * 256 + cc] = f2bf(o);
}

__device__ __forceinline__ void b_mix_naive(int bid, int tid, char* sm, const bf16_t* __restrict__ Q, const bf16_t* __restrict__ Kb, const bf16_t* __restrict__ V,
                                                   const bf16_t* __restrict__ RQ, const bf16_t* __restrict__ RK, const bf16_t* __restrict__ RV, const bf16_t* __restrict__ RG,
                                                   const float* __restrict__ ctl, const float* __restrict__ subln, bf16_t* __restrict__ MIX, int mode) {
    float* q1 = (float*)sm; float* q2 = q1 + 64; float* w = q2 + 64; float* w2 = w + SEQ; float* red = w2 + SEQ; float* part = red + 8;
    const int lane = tid & 63, wid = (tid >> 6) & 3;
    __syncthreads();
    const int h = bid & 3, row = bid >> 2, t = row & (SEQ - 1), rb = row - t;
    if (mode == 0) { if (tid < 64) { q1[tid] = bf2f(Q[(size_t)row * 512 + h * 64 + tid]); q2[tid] = bf2f(Q[(size_t)row * 512 + 256 + h * 64 + tid]); } }
    else { if (tid < 64) q1[tid] = bf2f(RQ[(size_t)row * 256 + h * 64 + tid]); }
    __syncthreads();
    float m1 = -INFINITY, m2 = -INFINITY;
    const float lg = (mode == 1) ? log2f(1.0f - exp2f(-5.0f - (float)h)) : 0.f;
    for (int j = tid; j <= t; j += 256) {
        if (mode == 0) {
            const bf16_t* k1 = Kb + (size_t)(rb + j) * 512 + h * 64; const bf16_t* k2 = k1 + 256;
            float s1 = 0.f, s2 = 0.f;
            for (int d = 0; d < 64; d += 8) {
                const uint4 a = *(const uint4*)(k1 + d), b2 = *(const uint4*)(k2 + d);
                const u32 aw[4] = {a.x, a.y, a.z, a.w}, bw[4] = {b2.x, b2.y, b2.z, b2.w};
#pragma unroll
                for (int e = 0; e < 4; ++e) {
                    s1 += q1[d + 2 * e] * __uint_as_float(aw[e] << 16) + q1[d + 2 * e + 1] * __uint_as_float(aw[e] & 0xffff0000u);
                    s2 += q2[d + 2 * e] * __uint_as_float(bw[e] << 16) + q2[d + 2 * e + 1] * __uint_as_float(bw[e] & 0xffff0000u);
                }
            }
            int dist = t - j; if (dist > 127) dist = 127;
            const float b = ctl[64 + h * 128 + dist];
            s1 += b; s2 += b; w[j] = s1; w2[j] = s2; m1 = fmaxf(m1, s1); m2 = fmaxf(m2, s2);
        } else {
            const bf16_t* k1 = RK + (size_t)(rb + j) * 256 + h * 64;
            float s1 = 0.f;
            for (int d = 0; d < 64; d += 8) {
                const uint4 a = *(const uint4*)(k1 + d);
                const u32 aw[4] = {a.x, a.y, a.z, a.w};
#pragma unroll
                for (int e = 0; e < 4; ++e) s1 += q1[d + 2 * e] * __uint_as_float(aw[e] << 16) + q1[d + 2 * e + 1] * __uint_as_float(aw[e] & 0xffff0000u);
            }
            w[j] = s1 * exp2f((float)(t - j) * lg);
        }
    }
    if (mode == 0) {
        m1 = wave_max(m1); m2 = wave_max(m2);
        if (lane == 0) { red[wid] = m1; red[4 + wid] = m2; }
        __syncthreads();
        m1 = fmaxf(fmaxf(red[0], red[1]), fmaxf(red[2], red[3])); m2 = fmaxf(fmaxf(red[4], red[5]), fmaxf(red[6], red[7]));
        __syncthreads();
        float l1 = 0.f, l2 = 0.f;
        for (int j = tid; j <= t; j += 256) { const float e1 = exp2f(w[j] - m1), e2 = exp2f(w2[j] - m2); w[j] = e1; w2[j] = e2; l1 += e1; l2 += e2; }
        l1 = wave_sum(l1); l2 = wave_sum(l2);
        if (lane == 0) { red[wid] = l1; red[4 + wid] = l2; }
        __syncthreads();
        l1 = red[0] + red[1] + red[2] + red[3]; l2 = red[4] + red[5] + red[6] + red[7];
        const float lam = ctl[0];
        const float i1 = 1.f / l1, i2 = lam / l2;
        for (int j = tid; j <= t; j += 256) w[j] = w[j] * i1 - w2[j] * i2;
    }
    __syncthreads();
    const bf16_t* vs = (mode == 0 ? V : RV) + (size_t)rb * 512 + h * 128 + (tid & 127);
    float acc = 0.f;
    for (int j = (tid >> 7); j <= t; j += 2) acc += w[j] * bf2f(vs[(size_t)j * 512]);
    if (tid >= 128) part[tid - 128] = acc;
    __syncthreads();
    float o = 0.f, ss = 0.f;
    if (tid < 128) { o = acc + part[tid]; ss = o * o; }
    ss = wave_sum(ss);
    if (lane == 0) red[wid] = ss;
    __syncthreads();
    if (tid < 128) {
        const float tot = red[0] + red[1];
        float r;
        if (mode == 0) { r = o * rsqrtf(tot * (1.f / 128) + 1e-5f) * subln[tid] * 0.8f; MIX[(size_t)row * DM + h * 128 + tid] = f2bf(r); }
        else { r = o * rsqrtf(tot * (1.f / 128) + 1e-6f) * bf2f(RG[(size_t)row * 512 + h * 128 + tid]); MIX[(size_t)row * DM + 512 + h * 128 + tid] = f2bf(r); }
    }
}

typedef float f32x2c_t __attribute__((ext_vector_type(2)));
typedef __bf16 bf16x2c_t __attribute__((ext_vector_type(2)));
__device__ __forceinline__ u32 pk2f(float lo, float hi) { const f32x2c_t v = {lo, hi}; return __builtin_bit_cast(u32, __builtin_convertvector(v, bf16x2c_t)); }
__device__ __forceinline__ uint4 pack8(const float* w) { uint4 o; o.x = pk2f(w[0], w[1]); o.y = pk2f(w[2], w[3]); o.z = pk2f(w[4], w[5]); o.w = pk2f(w[6], w[7]); return o; }
template <bool ROT> __device__ __forceinline__ void wave_transpose_item(const float* __restrict__ W, int K, int N, bf16_t* __restrict__ WT, const float* __restrict__ gain, LAS float* scr, int item, int lane) {
    const int nblk = N / 32, kb = item / nblk, nb = item % nblk, k0 = 64 * kb, n0 = 32 * nb;
#pragma unroll 8
    for (int i = 0; i < 32; ++i) { const int kk = 2 * i + (lane >> 5); const float g = gain ? gain[k0 + kk] : 1.f; scr[kk * 33 + (lane & 31)] = W[(size_t)(k0 + kk) * N + n0 + (lane & 31)] * g; }
    asm volatile("s_waitcnt lgkmcnt(0)" ::: "memory");
    const int c = lane & 7;
#pragma unroll
    for (int j = 0; j < 4; ++j) { const int n = (lane >> 3) + 8 * j; const LAS float* sp = scr + (8 * c) * 33 + n;
        uint4 o; o.x = pk2f(sp[0 * 33], sp[1 * 33]); o.y = pk2f(sp[2 * 33], sp[3 * 33]); o.z = pk2f(sp[4 * 33], sp[5 * 33]); o.w = pk2f(sp[6 * 33], sp[7 * 33]);
        *(uint4*)(WT + (size_t)(ROT ? rot_dst_row(n0 + n) : (n0 + n)) * K + k0 + 8 * c) = o; }
    asm volatile("s_waitcnt lgkmcnt(0)" ::: "memory");
}
typedef short bf16x8_t __attribute__((ext_vector_type(8)));
typedef float f32x16_t __attribute__((ext_vector_type(16)));
typedef unsigned u32x4_t __attribute__((ext_vector_type(4)));
typedef unsigned u32x2_t __attribute__((ext_vector_type(2)));
typedef float f32x4_t __attribute__((ext_vector_type(4)));
#define MFMA32(a, b, c) __builtin_amdgcn_mfma_f32_32x32x16_bf16((a), (b), (c), 0, 0, 0)
__device__ __forceinline__ int crow(int r, int hi) { return (r & 3) + 8 * (r >> 2) + 4 * hi; }
__device__ __forceinline__ bf16x8_t pack_p(const f32x16_t& p, int s) {
    u32x4_t w; w.x = pk2f(p[8 * s + 0], p[8 * s + 1]); w.y = pk2f(p[8 * s + 2], p[8 * s + 3]); w.z = pk2f(p[8 * s + 4], p[8 * s + 5]); w.w = pk2f(p[8 * s + 6], p[8 * s + 7]);
    return __builtin_bit_cast(bf16x8_t, w);
}
constexpr int KROW = 144;
constexpr int VROW = 144;
constexpr int AL_K = 0;
constexpr int AL_V = AL_K + 2 * 2 * 64 * KROW;
constexpr int AL_X = 0;
constexpr int AL_ALS = AL_V + 2 * 128 * VROW;
constexpr int AL_TAB = AL_ALS + 8 * 32 * 4;
constexpr int AL_Q = AL_TAB + 1536;
constexpr int AL_END = AL_Q + 8 * 32 * KROW;
static_assert(AL_ALS >= 65536 && AL_END <= 131072, "attention LDS map");

template <int MODE>
__device__ __forceinline__ void attn_unit(LAS unsigned char* lds, int tid, int b, int h, int qb, const bf16_t* __restrict__ Q, const bf16_t* __restrict__ Kb, const bf16_t* __restrict__ VT,
                                          const float* __restrict__ ctl, const float* __restrict__ subln, bf16_t* __restrict__ MIX) {
    asm volatile("" : "+v"(tid));
    const int lane = tid & 63, wave = __builtin_amdgcn_readfirstlane(tid >> 6), map = wave >> 2, qs = wave & 3, ql = lane & 31, hi = lane >> 5;
    const int q0 = qb * 128, q0w = q0 + 32 * qs, nt = 2 * (qb + 1);
    const size_t rowbase = (size_t)b * SEQ;
    LAS float* als = (LAS float*)(lds + AL_ALS) + wave * 32;
    LAS float* tab = (LAS float*)(lds + AL_TAB);
    if (tid < 384) { const int d_ = tid - 128; tab[tid] = d_ < 0 ? 0.f : ctl[64 + h * 128 + (d_ > 127 ? 127 : d_)] - ctl[64 + h * 128 + 127]; }
    LAS unsigned char* qlds = lds + AL_Q + wave * (32 * KROW) + ql * KROW + 16 * hi;
    {
        const bf16_t* qp = Q + (rowbase + q0w + ql) * 512 + map * 256 + h * 64 + 8 * hi;
        bf16x8_t qtmp[4];
#pragma unroll
        for (int ks = 0; ks < 4; ++ks) qtmp[ks] = *(const bf16x8_t*)(qp + 16 * ks);
#pragma unroll
        for (int ks = 0; ks < 4; ++ks) *(LAS bf16x8_t*)(qlds + 32 * ks) = qtmp[ks];
    }
    const int kkey = (tid >> 3) & 63, kc = tid & 7;
    const bf16_t* kg = Kb + (rowbase + kkey) * 512 + h * 64 + 8 * kc;
    const bf16_t* vg = VT + ((size_t)(b * 4 + h) * 128 + (tid >> 3)) * SEQ + 8 * kc;
    const int klds = AL_K + kkey * KROW + 16 * kc, vlds = AL_V + (tid >> 3) * VROW + 16 * kc;
    u32x4_t sk0, sk1, sv0, sv1;
#define ATT_LOADK(t) do { sk0 = *(const u32x4_t*)(kg + (size_t)(t) * 64 * 512); sk1 = *(const u32x4_t*)(kg + (size_t)(t) * 64 * 512 + 256); } while (0)
#define ATT_LOADV(t) do { sv0 = *(const u32x4_t*)(vg + (t) * 64); sv1 = *(const u32x4_t*)(vg + (size_t)64 * SEQ + (t) * 64); } while (0)
#define ATT_STOREK(buf) do { *(LAS u32x4_t*)(lds + klds + (buf) * (2 * 64 * KROW)) = sk0; *(LAS u32x4_t*)(lds + klds + (buf) * (2 * 64 * KROW) + 64 * KROW) = sk1; } while (0)
#define ATT_STOREV(buf) do { *(LAS u32x4_t*)(lds + vlds + (buf) * (128 * VROW)) = sv0; *(LAS u32x4_t*)(lds + vlds + (buf) * (128 * VROW) + 64 * VROW) = sv1; } while (0)
#define ATT_QK(P_, KB_, C0_) do { const LAS unsigned char* kb_ = lds + AL_K + (KB_) * (2 * 64 * KROW) + map * (64 * KROW) + ql * KROW + 16 * hi; \
        _Pragma("unroll") for (int blk = 0; blk < 2; ++blk) { \
            _Pragma("unroll") for (int ks = 0; ks < 4; ++ks) { const bf16x8_t a_ = *(const LAS bf16x8_t*)(kb_ + blk * 32 * KROW + 32 * ks); const bf16x8_t q_ = *(const LAS bf16x8_t*)(qlds + 32 * ks); \
                if (ks == 0) P_[blk] = MFMA32(a_, q_, C0_); else P_[blk] = MFMA32(a_, q_, P_[blk]); } } } while (0)
#define ATT_VLD(W_, VB_, G_) do { const LAS unsigned char* vq_ = lds + AL_V + (VB_) * (128 * VROW) + ql * VROW + 16 * hi + 32 * (G_); \
        _Pragma("unroll") for (int cb = 0; cb < 4; ++cb) W_[cb] = *(const LAS u32x4_t*)(vq_ + cb * 32 * VROW); } while (0)
#define ATT_EXPC(P_, G_, C_, W_) do { const float x0_ = P_[(G_) >> 1][8 * ((G_) & 1) + 2 * (C_)], x1_ = P_[(G_) >> 1][8 * ((G_) & 1) + 2 * (C_) + 1]; \
        const float a_ = (MODE & 4) ? x0_ : __builtin_amdgcn_exp2f(x0_), b_ = (MODE & 4) ? x1_ : __builtin_amdgcn_exp2f(x1_); \
        W_[C_] = pk2f(a_, b_); ls0_ += a_; ls1_ += b_; } while (0)
#define ATT_SLOT(P_, G_, CB_, WC_, VC_, WN_) do { \
        if (!(MODE & 16)) o[CB_] = MFMA32(__builtin_bit_cast(bf16x8_t, WC_), __builtin_bit_cast(bf16x8_t, VC_[CB_]), o[CB_]); \
        if ((G_) < 3) { ATT_EXPC(P_, ((G_) + 1) & 3, CB_, WN_); asm volatile("" : "+v"(ls0_), "+v"(ls1_)); }        \
        __builtin_amdgcn_sched_barrier(0); } while (0)
#define ATT_SMPV(P_, PN_, KT_, VB_) do { \
        u32x4_t vA_[4], vB_[4]; \
        ATT_VLD(vA_, VB_, 0); \
        if ((KT_) + 4 >= nt) { const int db_ = q0w + ql - 64 * (KT_) - 4 * hi;        \
            const LAS float* tp_ = tab + (128 - 59) + db_; \
            _Pragma("unroll") for (int blk = 0; blk < 2; ++blk) { float bs_[16]; \
                _Pragma("unroll") for (int r = 0; r < 16; ++r) bs_[r] = tp_[59 - (32 * blk + (r & 3) + 8 * (r >> 2))]; \
                _Pragma("unroll") for (int r = 0; r < 16; ++r) asm volatile("" : "+v"(bs_[r])); \
                _Pragma("unroll") for (int r = 0; r < 16; ++r) P_[blk][r] = db_ < (32 * blk + (r & 3) + 8 * (r >> 2)) ? -INFINITY : P_[blk][r] + bs_[r]; } } \
        float rm_ = P_[0][0]; \
        _Pragma("unroll") for (int r = 1; r < 16; ++r) rm_ = fmaxf(rm_, P_[0][r]); \
        _Pragma("unroll") for (int r = 0; r < 16; ++r) rm_ = fmaxf(rm_, P_[1][r]); \
        rm_ = fmaxf(rm_, __shfl_xor(rm_, 32)); \
          \
          \
        if (__any(rm_ > 8.0f || ((KT_) == 0 && rm_ < -8.0f))) { \
            const float dl_ = (KT_) == 0 ? rm_ : fmaxf(rm_, 0.f); \
            const float alpha_ = __builtin_amdgcn_exp2f(-dl_); \
            l *= alpha_; \
            if (hi == 0) als[ql] = alpha_; \
            asm volatile("s_waitcnt lgkmcnt(0)" ::: "memory"); \
            float al_[16]; \
            _Pragma("unroll") for (int r = 0; r < 16; ++r) al_[r] = als[crow(r, hi)]; \
            _Pragma("unroll") for (int cb = 0; cb < 4; ++cb) _Pragma("unroll") for (int r = 0; r < 16; ++r) o[cb][r] *= al_[r]; \
            _Pragma("unroll") for (int blk = 0; blk < 2; ++blk) _Pragma("unroll") for (int r = 0; r < 16; ++r) { P_[blk][r] -= dl_; PN_[blk][r] -= dl_; } \
            _Pragma("unroll") for (int r = 0; r < 16; ++r) negm[r] -= dl_; } \
        float ls0_ = 0.f, ls1_ = 0.f; \
        u32x4_t wE_, wO_;        \
        ATT_EXPC(P_, 0, 0, wE_); ATT_EXPC(P_, 0, 1, wE_); ATT_EXPC(P_, 0, 2, wE_); ATT_EXPC(P_, 0, 3, wE_); ATT_VLD(vB_, VB_, 1); \
        __builtin_amdgcn_sched_barrier(0); \
        ATT_SLOT(P_, 0, 0, wE_, vA_, wO_); ATT_SLOT(P_, 0, 1, wE_, vA_, wO_); ATT_SLOT(P_, 0, 2, wE_, vA_, wO_); ATT_SLOT(P_, 0, 3, wE_, vA_, wO_); \
        ATT_VLD(vA_, VB_, 2); \
        ATT_SLOT(P_, 1, 0, wO_, vB_, wE_); ATT_SLOT(P_, 1, 1, wO_, vB_, wE_); ATT_SLOT(P_, 1, 2, wO_, vB_, wE_); ATT_SLOT(P_, 1, 3, wO_, vB_, wE_); \
        ATT_VLD(vB_, VB_, 3); \
        ATT_SLOT(P_, 2, 0, wE_, vA_, wO_); ATT_SLOT(P_, 2, 1, wE_, vA_, wO_); ATT_SLOT(P_, 2, 2, wE_, vA_, wO_); ATT_SLOT(P_, 2, 3, wE_, vA_, wO_); \
        ATT_SLOT(P_, 3, 0, wO_, vB_, wE_); ATT_SLOT(P_, 3, 1, wO_, vB_, wE_); ATT_SLOT(P_, 3, 2, wO_, vB_, wE_); ATT_SLOT(P_, 3, 3, wO_, vB_, wE_); \
        l += ls0_ + ls1_; } while (0)
#define ATT_ITER(PC_, PN_, KT_) do { \
        { const int tk_ = (KT_) + 2 < nt ? (KT_) + 2 : nt - 1, tv_ = (KT_) + 1 < nt ? (KT_) + 1 : nt - 1;     \
          if (!(MODE & 8)) { ATT_LOADK(tk_); ATT_LOADV(tv_); } }                                                                  \
        if (!(MODE & 32)) ATT_QK(PN_, ((KT_) + 1) & 1, negm); \
        __builtin_amdgcn_sched_barrier(0); \
        ATT_SMPV(PC_, PN_, (KT_), (KT_) & 1); \
        if (!(MODE & 8)) { ATT_STOREK((KT_) & 1); ATT_STOREV(((KT_) + 1) & 1); } \
        if (!(MODE & 2)) __syncthreads(); } while (0)
    ATT_LOADK(0); ATT_LOADV(0);
    __syncthreads();
    ATT_STOREK(0); ATT_STOREV(0);
    ATT_LOADK(1);
    ATT_STOREK(1);
    __syncthreads();
    f32x16_t o[4];
#pragma unroll
    for (int cb = 0; cb < 4; ++cb) o[cb] = (f32x16_t){0.f, 0.f, 0.f, 0.f, 0.f, 0.f, 0.f, 0.f, 0.f, 0.f, 0.f, 0.f, 0.f, 0.f, 0.f, 0.f};
    float l = 0.f;
    f32x16_t pA[2], pB[2];
    f32x16_t negm;
    {
        const f32x16_t zero16 = (f32x16_t){0.f, 0.f, 0.f, 0.f, 0.f, 0.f, 0.f, 0.f, 0.f, 0.f, 0.f, 0.f, 0.f, 0.f, 0.f, 0.f};
        ATT_QK(pA, 0, zero16);
        float m0 = pA[0][0];
#pragma unroll
        for (int r = 1; r < 16; ++r) m0 = fmaxf(m0, pA[0][r]);
#pragma unroll
        for (int r = 0; r < 16; ++r) m0 = fmaxf(m0, pA[1][r]);
        m0 = fmaxf(m0, __shfl_xor(m0, 32));
#pragma unroll
        for (int r = 0; r < 16; ++r) { pA[0][r] -= m0; pA[1][r] -= m0; negm[r] = -m0; }
    }
#pragma unroll 1
    for (int kt = 0; kt < nt; kt += 2) {
        ATT_ITER(pA, pB, kt);
        ATT_ITER(pB, pA, kt + 1);
    }
#undef ATT_LOADK
#undef ATT_LOADV
#undef ATT_STOREK
#undef ATT_STOREV
#undef ATT_QK
#undef ATT_SMPV
#undef ATT_VLD
#undef ATT_EXPC
#undef ATT_SLOT
#undef ATT_ITER
    l += __shfl_xor(l, 32);
    if (hi == 0) als[ql] = 1.0f / l;
    asm volatile("s_waitcnt lgkmcnt(0)" ::: "memory");
    float il[16];
#pragma unroll
    for (int r = 0; r < 16; ++r) il[r] = als[crow(r, hi)];
    LAS float* xo = (LAS float*)(lds + AL_X) + qs * (32 * 128);
    if (map == 1) {
#pragma unroll
        for (int cb = 0; cb < 4; ++cb)
#pragma unroll
            for (int r = 0; r < 16; ++r) xo[crow(r, hi) * 128 + 32 * cb + ql] = o[cb][r] * il[r];
    }
    __syncthreads();
    if (map == 0) {
        const float lam = ctl[0];
        float ss[16];
#pragma unroll
        for (int r = 0; r < 16; ++r) ss[r] = 0.f;
#pragma unroll
        for (int cb = 0; cb < 4; ++cb)
#pragma unroll
            for (int r = 0; r < 16; ++r) { const float d = o[cb][r] * il[r] - lam * xo[crow(r, hi) * 128 + 32 * cb + ql]; o[cb][r] = d; ss[r] += d * d; }
#pragma unroll
        for (int r = 0; r < 16; ++r) {
            float s = ss[r];
            s += __shfl_xor(s, 1); s += __shfl_xor(s, 2); s += __shfl_xor(s, 4); s += __shfl_xor(s, 8); s += __shfl_xor(s, 16);
            ss[r] = rsqrtf(s * (1.f / 128) + 1e-5f) * 0.8f;
        }
#pragma unroll
        for (int cb = 0; cb < 4; ++cb) {
            const float g = subln[32 * cb + ql];
#pragma unroll
            for (int r = 0; r < 16; ++r) if (!(MODE & 1)) MIX[(rowbase + q0w + crow(r, hi)) * DM + h * 128 + 32 * cb + ql] = f2bf(o[cb][r] * ss[r] * g);
        }
    }
    __syncthreads();
}

__device__ __forceinline__ void ret_kv_unit(int tid, int bh, int n, const bf16_t* __restrict__ RVT, const bf16_t* __restrict__ RKT, float* __restrict__ KVT) {
    const int lane = tid & 63, wave = tid >> 6, rb = wave & 3, cbk = wave >> 2, ql = lane & 31, hi = lane >> 5, h = bh & 3;
    const float lg = log2f(1.0f - exp2f(-5.0f - (float)h));
    const bf16_t* ap = RVT + ((size_t)bh * 128 + 32 * rb + ql) * SEQ + 128 * n + 8 * hi;
    const bf16_t* bp = RKT + ((size_t)bh * 64 + 32 * cbk + ql) * SEQ + 128 * n + 8 * hi;
    f32x16_t acc = (f32x16_t){0.f, 0.f, 0.f, 0.f, 0.f, 0.f, 0.f, 0.f, 0.f, 0.f, 0.f, 0.f, 0.f, 0.f, 0.f, 0.f};
#pragma unroll
    for (int s = 0; s < 8; ++s) {
        const bf16x8_t a = *(const bf16x8_t*)(ap + 16 * s);
        const uint4 kw = *(const uint4*)(bp + 16 * s);
        const u32 kk[4] = {kw.x, kw.y, kw.z, kw.w};
        u32x4_t w;
        u32 ww[4];
#pragma unroll
        for (int e = 0; e < 4; ++e) {
            const int key = 16 * s + 8 * hi + 2 * e;
            const float z0 = exp2f((float)(127 - key) * lg), z1 = exp2f((float)(126 - key) * lg);
            ww[e] = pk2f(__uint_as_float(kk[e] << 16) * z0, __uint_as_float(kk[e] & 0xffff0000u) * z1);
        }
        w.x = ww[0]; w.y = ww[1]; w.z = ww[2]; w.w = ww[3];
        acc = MFMA32(a, __builtin_bit_cast(bf16x8_t, w), acc);
    }
    float* out = KVT + ((size_t)(bh * 32 + n) * 128 + 32 * rb) * 64 + 32 * cbk + ql;
#pragma unroll
    for (int r = 0; r < 16; ++r) out[crow(r, hi) * 64] = acc[r];
}
__device__ __forceinline__ void ret_scan(int e, const float* __restrict__ KVT, bf16_t* __restrict__ ST) {
    const int bh = e >> 13, idx = e & 8191, h = bh & 3;
    const float cd = exp2f(128.0f * log2f(1.0f - exp2f(-5.0f - (float)h)));
    float s = 0.f;
    for (int n = 0; n < 32; ++n) {
        ST[((size_t)(bh * 32 + n) << 13) + idx] = f2bf(s);
        s = s * cd + KVT[((size_t)(bh * 32 + n) << 13) + idx];
    }
}
constexpr int RVROW = 272;
constexpr int RL_K = 0;
constexpr int RL_V = RL_K + 128 * KROW;
constexpr int RL_S = RL_V + 128 * RVROW;
constexpr int RL_DT = RL_S + 128 * KROW;
constexpr int RL_BUF = RL_DT + 512;
constexpr int RL_SS = 2 * RL_BUF;
constexpr int RL_END = RL_SS + 4 * 2 * 32 * 4;
static_assert(RL_END <= 147456 - 256, "retention LDS map");
__device__ __forceinline__ void ret_out_units(LAS unsigned char* lds0, int tid, int u0, int ustep, int nunits, const bf16_t* __restrict__ RQ, const bf16_t* __restrict__ RK, const bf16_t* __restrict__ RVT,
                                              const bf16_t* __restrict__ ST, const bf16_t* __restrict__ RG, bf16_t* __restrict__ MIX) {
    asm volatile("" : "+v"(tid));
    const int lane = tid & 63, wave = __builtin_amdgcn_readfirstlane(tid >> 6), qs = wave & 3, dvh = wave >> 2, ql = lane & 31, hi = lane >> 5;
    u32x4_t rk[2], rv[4], rs[2];
#define RL_LOAD(U_) do { const int bh_ = (U_) >> 5, n_ = (U_) & 31; const size_t r0_ = (size_t)(bh_ >> 2) * SEQ + 128 * n_; \
        _Pragma("unroll") for (int q = 0; q < 2; ++q) { const int i_ = tid + 512 * q, key = i_ >> 3, c = i_ & 7; rk[q] = *(const u32x4_t*)(RK + (r0_ + key) * 256 + (bh_ & 3) * 64 + 8 * c); } \
        _Pragma("unroll") for (int q = 0; q < 4; ++q) { const int i_ = tid + 512 * q, dv = i_ >> 4, c = i_ & 15; rv[q] = *(const u32x4_t*)(RVT + ((size_t)bh_ * 128 + dv) * SEQ + 128 * n_ + 8 * c); } \
        _Pragma("unroll") for (int q = 0; q < 2; ++q) { const int i_ = tid + 512 * q, dv = i_ >> 3, c = i_ & 7; rs[q] = *(const u32x4_t*)(ST + ((size_t)(U_) << 13) + dv * 64 + 8 * c); } } while (0)
#define RL_STORE(L_) do { \
        _Pragma("unroll") for (int q = 0; q < 2; ++q) { const int i_ = tid + 512 * q, key = i_ >> 3, c = i_ & 7; *(LAS u32x4_t*)((L_) + RL_K + key * KROW + 16 * c) = rk[q]; } \
        _Pragma("unroll") for (int q = 0; q < 4; ++q) { const int i_ = tid + 512 * q, dv = i_ >> 4, c = i_ & 15; *(LAS u32x4_t*)((L_) + RL_V + dv * RVROW + 16 * c) = rv[q]; } \
        _Pragma("unroll") for (int q = 0; q < 2; ++q) { const int i_ = tid + 512 * q, dv = i_ >> 3, c = i_ & 7; *(LAS u32x4_t*)((L_) + RL_S + dv * KROW + 16 * c) = rs[q]; } } while (0)
    RL_LOAD(u0 < nunits ? u0 : 0);
    int it = 0;
#pragma unroll 1
  for (int u = u0; u < nunits; u += ustep, ++it) {
    LAS unsigned char* lds = lds0 + (it & 1) * RL_BUF;
    const int bh = u >> 5, n = u & 31, b = bh >> 2, h = bh & 3;
    const size_t row0 = (size_t)b * SEQ + 128 * n;
    const float lg = log2f(1.0f - exp2f(-5.0f - (float)h));
    __syncthreads();
    RL_STORE(lds);
    if (tid < 128) ((LAS float*)(lds + RL_DT))[tid] = exp2f((float)tid * lg);
    bf16x8_t qf[4];
    {
        const bf16_t* qp = RQ + (row0 + 32 * qs + ql) * 256 + h * 64 + 8 * hi;
#pragma unroll
        for (int ks = 0; ks < 4; ++ks) qf[ks] = *(const bf16x8_t*)(qp + 16 * ks);
    }
    __syncthreads();
    { const int un_ = u + ustep < nunits ? u + ustep : u; RL_LOAD(un_); }
    const LAS float* dt = (const LAS float*)(lds + RL_DT);
    f32x16_t o[2];
    o[0] = (f32x16_t){0.f, 0.f, 0.f, 0.f, 0.f, 0.f, 0.f, 0.f, 0.f, 0.f, 0.f, 0.f, 0.f, 0.f, 0.f, 0.f}; o[1] = o[0];
    const int qloc = 32 * qs + ql;
    for (int kb = 0; kb <= qs; ++kb) {
        f32x16_t p = (f32x16_t){0.f, 0.f, 0.f, 0.f, 0.f, 0.f, 0.f, 0.f, 0.f, 0.f, 0.f, 0.f, 0.f, 0.f, 0.f, 0.f};
        const LAS unsigned char* kp = lds + RL_K + (32 * kb + ql) * KROW + 16 * hi;
#pragma unroll
        for (int ks = 0; ks < 4; ++ks) { const bf16x8_t a = *(const LAS bf16x8_t*)(kp + 32 * ks); p = MFMA32(a, qf[ks], p); }
#pragma unroll
        for (int r = 0; r < 16; ++r) { const int dist = qloc - (32 * kb + crow(r, hi)); p[r] = dist < 0 ? 0.f : p[r] * dt[dist < 0 ? 0 : dist]; }
#pragma unroll
        for (int s = 0; s < 2; ++s) {
            const bf16x8_t pa = pack_p(p, s);
#pragma unroll
            for (int cbl = 0; cbl < 2; ++cbl) {
                const LAS unsigned char* vp = lds + RL_V + (64 * dvh + 32 * cbl + ql) * RVROW + (32 * kb + 16 * s) * 2 + 8 * hi;
                const u32x2_t lo = *(const LAS u32x2_t*)vp, hi2 = *(const LAS u32x2_t*)(vp + 16);
                u32x4_t w; w.x = lo.x; w.y = lo.y; w.z = hi2.x; w.w = hi2.y;
                o[cbl] = MFMA32(pa, __builtin_bit_cast(bf16x8_t, w), o[cbl]);
            }
        }
    }
    if (n > 0) {
        const float xi = exp2f((float)(qloc + 1) * lg);
#pragma unroll
        for (int ks = 0; ks < 4; ++ks) {
            u32x4_t qw = __builtin_bit_cast(u32x4_t, qf[ks]);
            u32 qq[4] = {qw.x, qw.y, qw.z, qw.w};
#pragma unroll
            for (int e = 0; e < 4; ++e) qq[e] = pk2f(__uint_as_float(qq[e] << 16) * xi, __uint_as_float(qq[e] & 0xffff0000u) * xi);
            qw.x = qq[0]; qw.y = qq[1]; qw.z = qq[2]; qw.w = qq[3];
            const bf16x8_t qx = __builtin_bit_cast(bf16x8_t, qw);
#pragma unroll
            for (int cbl = 0; cbl < 2; ++cbl) {
                const bf16x8_t bs = *(const LAS bf16x8_t*)(lds + RL_S + (64 * dvh + 32 * cbl + ql) * KROW + 32 * ks + 16 * hi);
                o[cbl] = MFMA32(qx, bs, o[cbl]);
            }
        }
    }
    float ss[16];
#pragma unroll
    for (int r = 0; r < 16; ++r) {
        float s = o[0][r] * o[0][r] + o[1][r] * o[1][r];
        s += __shfl_xor(s, 1); s += __shfl_xor(s, 2); s += __shfl_xor(s, 4); s += __shfl_xor(s, 8); s += __shfl_xor(s, 16);
        ss[r] = s;
    }
    LAS float* sx = (LAS float*)(lds0 + RL_SS);
    if (ql == 0) {
#pragma unroll
        for (int r = 0; r < 16; ++r) sx[(qs * 2 + dvh) * 32 + crow(r, hi)] = ss[r];
    }
    __syncthreads();
#pragma unroll
    for (int r = 0; r < 16; ++r) ss[r] = rsqrtf((sx[(qs * 2) * 32 + crow(r, hi)] + sx[(qs * 2 + 1) * 32 + crow(r, hi)]) * (1.f / 128) + 1e-6f);
    {
        LAS float* wt = (LAS float*)(lds + wave * 8704);
#pragma unroll
        for (int cbl = 0; cbl < 2; ++cbl)
#pragma unroll
            for (int r = 0; r < 16; ++r) wt[crow(r, hi) * 68 + 32 * cbl + ql] = o[cbl][r] * ss[r];
#pragma unroll
        for (int ps = 0; ps < 4; ++ps) {
            const int rr = 8 * ps + (lane >> 3), c8 = 8 * (lane & 7);
            const f32x4_t a0 = *(const LAS f32x4_t*)(wt + rr * 68 + c8), a1 = *(const LAS f32x4_t*)(wt + rr * 68 + c8 + 4);
            const size_t row = row0 + 32 * qs + rr; const int col = h * 128 + 64 * dvh + c8;
            const uint4 gw = *(const uint4*)(RG + row * 512 + col);
            const float w8[8] = {a0[0] * __uint_as_float(gw.x << 16), a0[1] * __uint_as_float(gw.x & 0xffff0000u), a0[2] * __uint_as_float(gw.y << 16), a0[3] * __uint_as_float(gw.y & 0xffff0000u),
                                 a1[0] * __uint_as_float(gw.z << 16), a1[1] * __uint_as_float(gw.z & 0xffff0000u), a1[2] * __uint_as_float(gw.w << 16), a1[3] * __uint_as_float(gw.w & 0xffff0000u)};
            *(uint4*)(MIX + row * DM + 512 + col) = pack8(w8);
        }
    }
  }
#undef RL_LOAD
#undef RL_STORE
}
__host__ __device__ __forceinline__ int rot_dst_row(int n) {
    if (n < 1536 || n >= 2048) return n;
    const int o = (n - 1536) & 255, base = n - o, head = o >> 6, d = o & 63, half = d >> 5, p = d & 31;
    return base + 8 * (head * 8 + (p >> 2)) + (p & 3) + 4 * half;
}
struct EpiInProjT {
    static constexpr bool PERM = true, AFTER_DRAIN = false;
    unsigned char* ws; const float* cs;
#define EPI_FOREACH(...) _Pragma("unroll") for (int ai = 0; ai < 2; ++ai) _Pragma("unroll") for (int m = 0; m < 4; ++m) { const int row = row0 + ai * 128 + m * 16; \
        _Pragma("unroll") for (int bj = 0; bj < 2; ++bj) { const int lc = lc0 + bj * 128; \
            const float v[8] = {acc[ai][bj][m][0][0], acc[ai][bj][m][0][1], acc[ai][bj][m][0][2], acc[ai][bj][m][0][3], acc[ai][bj][m][1][0], acc[ai][bj][m][1][1], acc[ai][bj][m][1][2], acc[ai][bj][m][1][3]}; __VA_ARGS__ } \
        asm volatile("" ::: "memory"); }
    __device__ __forceinline__ void operator()(const pg8::f32x4 (&acc)[2][2][4][2], const pg8::Unit& u, int wr, int wc, int fr, int fq) const {
        const int pn = __builtin_amdgcn_readfirstlane(u.pn);
        const int row0 = u.pm * 256 + wr * 64 + fr, lc0 = wc * 32 + 8 * fq;
        if (pn < 4) {
            const float sc = pn < 2 ? QSCALE : 1.f;
            bf16_t* base = (bf16_t*)(ws + (pn < 2 ? WS_Q : WS_K)) + (pn & 1) * 256;
            EPI_FOREACH({ const float w[8] = {v[0] * sc, v[1] * sc, v[2] * sc, v[3] * sc, v[4] * sc, v[5] * sc, v[6] * sc, v[7] * sc}; *(uint4*)(base + (size_t)row * 512 + lc) = pack8(w); })
        } else if (pn == 6 || pn == 7) {
            const bool isk = pn == 7; const float sc = isk ? 0.125f : 1.f;
            bf16_t* base = (bf16_t*)(ws + (isk ? WS_RK : WS_RQ));
            EPI_FOREACH({ const int j = lc >> 3, head = j >> 3, p = 4 * (j & 7), pos = row & (SEQ - 1);
                const float4 co = *(const float4*)(cs + pos * 32 + p), si = *(const float4*)(cs + 4096 * 32 + pos * 32 + p);
                uint2 a, b;
                a.x = pk2f((v[0] * co.x - v[4] * si.x) * sc, (v[1] * co.y - v[5] * si.y) * sc); a.y = pk2f((v[2] * co.z - v[6] * si.z) * sc, (v[3] * co.w - v[7] * si.w) * sc);
                b.x = pk2f((v[0] * si.x + v[4] * co.x) * sc, (v[1] * si.y + v[5] * co.y) * sc); b.y = pk2f((v[2] * si.z + v[6] * co.z) * sc, (v[3] * si.w + v[7] * co.w) * sc);
                bf16_t* dst = base + (size_t)row * 256 + head * 64 + p;
                *(uint2*)dst = a; *(uint2*)(dst + 32) = b;
                if (isk) {
                    bf16_t* kt = (bf16_t*)(ws + WS_RKT) + ((size_t)((row >> 12) * 4 + head) * 64 + p) * SEQ + pos;
                    const u32 wv[4] = {a.x, a.y, b.x, b.y};
                    _Pragma("unroll") for (int q = 0; q < 4; ++q) { *kt = (bf16_t)wv[q]; kt += SEQ; asm volatile("" : "+v"(kt)); *kt = (bf16_t)(wv[q] >> 16); kt += (q == 1 ? (size_t)29 * SEQ : (size_t)SEQ); asm volatile("" : "+v"(kt)); }
                } })
        } else if (pn >= 10) {
            bf16_t* base = (bf16_t*)(ws + WS_RG) + (pn - 10) * 256;
            EPI_FOREACH({ float w[8]; _Pragma("unroll") for (int q = 0; q < 8; ++q) w[q] = v[q] / (1.f + __expf(-v[q])); *(uint4*)(base + (size_t)row * 512 + lc) = pack8(w); })
        } else {
            bf16_t* base = (bf16_t*)(ws + (pn >= 8 ? WS_RV : WS_VV));
            const int cb = (pn & 1) * 256;
            EPI_FOREACH({ const int c = cb + lc, tp = row & (SEQ - 1), tq = pn >= 8 ? tp : ((tp & ~12) | ((tp & 4) << 1) | ((tp & 8) >> 1));
                bf16_t* vt = base + ((size_t)((row >> 12) * 4 + (c >> 7)) * 128 + (c & 127)) * SEQ + tq;
                _Pragma("unroll") for (int q = 0; q < 8; q += 2) { const u32 w = pk2f(v[q], v[q + 1]); *vt = (bf16_t)w; vt += SEQ; asm volatile("" : "+v"(vt)); *vt = (bf16_t)(w >> 16); vt += SEQ; asm volatile("" : "+v"(vt)); } })
        }
    }
#undef EPI_FOREACH
};

struct EpiOutProj {
    static constexpr bool ROWSUM = true;
    const float* x; float* H; bf16_t* HB; float* rss;
    __device__ __forceinline__ void rowsum(int row, float s) const { atomicAdd(rss + row, s); }
    __device__ __forceinline__ float row8(int row, int col, const float* v) const {
        const float4 x0 = *(const float4*)(x + (size_t)row * DM + col), x1 = *(const float4*)(x + (size_t)row * DM + col + 4);
        const float hh[8] = {x0.x + v[0], x0.y + v[1], x0.z + v[2], x0.w + v[3], x1.x + v[4], x1.y + v[5], x1.z + v[6], x1.w + v[7]};
        *(uint4*)(HB + (size_t)row * DM + col) = pack8(hh);
        float s = 0.f;
#pragma unroll
        for (int j = 0; j < 8; ++j) s += hh[j] * hh[j];
        return s;
    }
};
struct EpiQry {
    static constexpr bool ROWSUM = false;
    bf16_t* QRY; const float* rss;
    __device__ __forceinline__ void rowsum(int, float) const {}
    __device__ __forceinline__ float row8(int row, int col, const float* v) const {
        const float r = rsqrtf(rss[row] * (1.f / DM) + 1e-6f);
        const float w[8] = {v[0] * r, v[1] * r, v[2] * r, v[3] * r, v[4] * r, v[5] * r, v[6] * r, v[7] * r};
        *(uint4*)(QRY + (size_t)row * 2048 + col) = pack8(w);
        return 0.f;
    }
};
struct EpiPP {
    static constexpr bool ROWSUM = false;
    bf16_t* PP;
    __device__ __forceinline__ void rowsum(int, float) const {}
    __device__ __forceinline__ float row8(int row, int col, const float* v) const { *(uint4*)(PP + (size_t)row * DM + col) = pack8(v); return 0.f; }
};
struct EpiGate {
    static constexpr bool ROWSUM = true;
    const bf16_t* HBr; const bf16_t* PP; const float* bg; const float* rss2; float* rss3; bf16_t* H3B;
    __device__ __forceinline__ void rowsum(int row, float s) const { atomicAdd(rss3 + row, s); }
    __device__ __forceinline__ float row8(int row, int col, const float* v) const {
        const float r = rsqrtf(rss2[row] * (1.f / DM) + 1e-6f);
        const uint4 pw = *(const uint4*)(PP + (size_t)row * DM + col), hw = *(const uint4*)(HBr + (size_t)row * DM + col);
        const float4 b0 = *(const float4*)(bg + col), b1 = *(const float4*)(bg + col + 4);
        const float hv[8] = {__uint_as_float(hw.x << 16), __uint_as_float(hw.x & 0xffff0000u), __uint_as_float(hw.y << 16), __uint_as_float(hw.y & 0xffff0000u),
                             __uint_as_float(hw.z << 16), __uint_as_float(hw.z & 0xffff0000u), __uint_as_float(hw.w << 16), __uint_as_float(hw.w & 0xffff0000u)};
        const float bb[8] = {b0.x, b0.y, b0.z, b0.w, b1.x, b1.y, b1.z, b1.w};
        const float pp[8] = {__uint_as_float(pw.x << 16), __uint_as_float(pw.x & 0xffff0000u), __uint_as_float(pw.y << 16), __uint_as_float(pw.y & 0xffff0000u),
                             __uint_as_float(pw.z << 16), __uint_as_float(pw.z & 0xffff0000u), __uint_as_float(pw.w << 16), __uint_as_float(pw.w & 0xffff0000u)};
        float o[8], s = 0.f;
#pragma unroll
        for (int j = 0; j < 8; ++j) { const float g = 1.f / (1.f + __expf(-(v[j] * r + bb[j]))); o[j] = hv[j] + g * pp[j]; s += o[j] * o[j]; }
        *(uint4*)(H3B + (size_t)row * DM + col) = pack8(o);
        return s;
    }
};

__device__ __forceinline__ void b_peer_topk(int tok, int tid, char* sm, const bf16_t* __restrict__ QRY, const bf16_t* __restrict__ SUBK, int* __restrict__ IDX, float* __restrict__ GATE) {
    float* q = (float*)sm; float* sc = q + 2048; float (*tv)[16] = (float (*)[16])(sc + 2048); int (*ti)[16] = (int (*)[16])(sc + 2048 + 256);
    __syncthreads();
    for (int i = tid; i < 2048; i += 256) q[i] = bf2f(QRY[(size_t)tok * 2048 + i]);
    __syncthreads();
    for (int s = tid; s < 2048; s += 256) {
        const int hc = s >> 7;
        const bf16_t* kr = SUBK + (size_t)s * 128; const float* qq = q + hc * 128;
        float a = 0.f;
        for (int d = 0; d < 128; ++d) a += qq[d] * bf2f(kr[d]);
        sc[s] = a;
    }
    __syncthreads();
    if (tid < 16) {
        float* s = sc + tid * 128;
        for (int r = 0; r < 16; ++r) {
            float best = -INFINITY; int bi = 0;
            for (int k = 0; k < 128; ++k) { const float x = s[k]; if (x > best) { best = x; bi = k; } }
            tv[tid][r] = best; ti[tid][r] = bi; s[bi] = -INFINITY;
        }
    }
    __syncthreads();
    if (tid < 8) {
        const int h = tid;
        unsigned used[8] = {0, 0, 0, 0, 0, 0, 0, 0};
        float ts[16]; int te[16];
        for (int r = 0; r < 16; ++r) {
            float best = -INFINITY; int bc = 0;
            for (int c = 0; c < 256; ++c) {
                if (used[c >> 5] & (1u << (c & 31))) continue;
                const float x = tv[2 * h][c >> 4] + tv[2 * h + 1][c & 15];
                if (x > best) { best = x; bc = c; }
            }
            used[bc >> 5] |= 1u << (bc & 31);
            ts[r] = best; te[r] = ti[2 * h][bc >> 4] * 128 + ti[2 * h + 1][bc & 15];
        }
        float mx = ts[0], sum = 0.f;
        for (int r = 0; r < 16; ++r) { ts[r] = __expf(ts[r] - mx); sum += ts[r]; }
        for (int r = 0; r < 16; ++r) { IDX[(size_t)tok * 128 + h * 16 + r] = te[r]; GATE[(size_t)tok * 128 + h * 16 + r] = ts[r] / sum; }
    }
}
__device__ __forceinline__ void b_peer_gather(int tok, int tid, char* sm, const bf16_t* __restrict__ U, const bf16_t* __restrict__ Vt, const int* __restrict__ IDX, const float* __restrict__ GATE,
                                                     float* __restrict__ H, bf16_t* __restrict__ HB, const float* __restrict__ rss1, float* __restrict__ rss2) {
    float* hrow = (float*)sm; float* a = hrow + 1024; int* ex = (int*)(a + 128); float* red = (float*)(ex + 128);
    const int lane = tid & 63, wid = (tid >> 6) & 3;
    __syncthreads();
    for (int i = tid; i < 1024; i += 256) hrow[i] = bf2f(HB[(size_t)tok * DM + i]);
    if (tid < 128) ex[tid] = IDX[(size_t)tok * 128 + tid];
    __syncthreads();
    const float r1 = rsqrtf(rss1[tok] * (1.f / DM) + 1e-6f);
    for (int e = wid * 32; e < wid * 32 + 32; ++e) {
        const bf16_t* ur = U + (size_t)ex[e] * DM + lane * 16;
        float d = 0.f;
#pragma unroll
        for (int j = 0; j < 16; ++j) d += bf2f(ur[j]) * hrow[lane * 16 + j];
        d = wave_sum(d);
        if (lane == 0) { const float z = d * r1; a[e] = 0.5f * z * (1.f + erff(z * 0.70710678118654752f)) * GATE[(size_t)tok * 128 + e]; }
    }
    __syncthreads();
    float acc[4] = {0.f, 0.f, 0.f, 0.f};
    for (int e = 0; e < 128; ++e) {
        const ushort4 v = *(const ushort4*)(Vt + (size_t)ex[e] * DM + tid * 4);
        const float ae = a[e];
        acc[0] += ae * bf2f(v.x); acc[1] += ae * bf2f(v.y); acc[2] += ae * bf2f(v.z); acc[3] += ae * bf2f(v.w);
    }
    float4 hv = *(float4*)(H + (size_t)tok * DM + tid * 4);
    hv.x += acc[0]; hv.y += acc[1]; hv.z += acc[2]; hv.w += acc[3];
    *(float4*)(H + (size_t)tok * DM + tid * 4) = hv;
    ushort4 o; o.x = f2bf(hv.x); o.y = f2bf(hv.y); o.z = f2bf(hv.z); o.w = f2bf(hv.w);
    __syncthreads();
    *(ushort4*)(HB + (size_t)tok * DM + tid * 4) = o;
    float s = hv.x * hv.x + hv.y * hv.y + hv.z * hv.z + hv.w * hv.w;
    s = wave_sum(s);
    if (lane == 0) red[wid] = s;
    __syncthreads();
    if (tid == 0) rss2[tok] = red[0] + red[1] + red[2] + red[3];
}
__device__ __forceinline__ void b_final(size_t i, const bf16_t* __restrict__ H3B, float* __restrict__ OUT, const float* __restrict__ rss3, const float* __restrict__ gain) {
    const int row = (int)(i >> 7), c = (int)(i & 127) * 8;
    const float r = rsqrtf(rss3[row] * (1.f / DM) + 1e-6f);
    const uint4 w = ((const uint4*)H3B)[i]; const float4 g0 = *(const float4*)(gain + c), g1 = *(const float4*)(gain + c + 4);
    float4 a, b2;
    a.x = __uint_as_float(w.x << 16) * r * g0.x; a.y = __uint_as_float(w.x & 0xffff0000u) * r * g0.y; a.z = __uint_as_float(w.y << 16) * r * g0.z; a.w = __uint_as_float(w.y & 0xffff0000u) * r * g0.w;
    b2.x = __uint_as_float(w.z << 16) * r * g1.x; b2.y = __uint_as_float(w.z & 0xffff0000u) * r * g1.y; b2.z = __uint_as_float(w.w << 16) * r * g1.z; b2.w = __uint_as_float(w.w & 0xffff0000u) * r * g1.w;
    ((float4*)OUT)[2 * i] = a; ((float4*)OUT)[2 * i + 1] = b2;
}

__device__ __forceinline__ u32 f2ord(float x) { const u32 u = __float_as_uint(x); return (u & 0x80000000u) ? ~u : (u | 0x80000000u); }
__device__ __forceinline__ float ord2f(u32 o) { const u32 u = (o & 0x80000000u) ? (o & 0x7fffffffu) : ~o; return __uint_as_float(u); }
__device__ __forceinline__ u32 umax3(u32 a, u32 b, u32 c) { return max(max(a, b), c); }
#define CE_(a_, b_) do { const u32 hi_ = max(a_, b_), lo_ = min(a_, b_); a_ = hi_; b_ = lo_; } while (0)
#define TOPK_NET() do { CE_(k[0], k[13]); CE_(k[1], k[12]); CE_(k[2], k[15]); CE_(k[3], k[14]); CE_(k[4], k[8]); CE_(k[5], k[6]); CE_(k[7], k[11]); CE_(k[9], k[10]); CE_(k[16], k[29]); CE_(k[17], k[28]); CE_(k[18], k[31]); CE_(k[19], k[30]); CE_(k[20], k[24]); CE_(k[21], k[22]); CE_(k[23], k[27]); CE_(k[25], k[26]); CE_(k[32], k[45]); CE_(k[33], k[44]); CE_(k[34], k[47]); CE_(k[35], k[46]); CE_(k[36], k[40]); CE_(k[37], k[38]); CE_(k[39], k[43]); CE_(k[41], k[42]); CE_(k[48], k[61]); CE_(k[49], k[60]); CE_(k[50], k[63]); CE_(k[51], k[62]); CE_(k[52], k[56]); CE_(k[53], k[54]); CE_(k[55], k[59]); CE_(k[57], k[58]); CE_(k[0], k[5]); CE_(k[1], k[7]); CE_(k[2], k[9]); CE_(k[3], k[4]); CE_(k[6], k[13]); CE_(k[8], k[14]); CE_(k[10], k[15]); CE_(k[11], k[12]); CE_(k[16], k[21]); CE_(k[17], k[23]); CE_(k[18], k[25]); CE_(k[19], k[20]); CE_(k[22], k[29]); CE_(k[24], k[30]); CE_(k[26], k[31]); CE_(k[27], k[28]); CE_(k[32], k[37]); CE_(k[33], k[39]); CE_(k[34], k[41]); CE_(k[35], k[36]); CE_(k[38], k[45]); CE_(k[40], k[46]); CE_(k[42], k[47]); CE_(k[43], k[44]); CE_(k[48], k[53]); CE_(k[49], k[55]); CE_(k[50], k[57]); CE_(k[51], k[52]); CE_(k[54], k[61]); CE_(k[56], k[62]); CE_(k[58], k[63]); CE_(k[59], k[60]); CE_(k[0], k[1]); CE_(k[2], k[3]); CE_(k[4], k[5]); CE_(k[6], k[8]); CE_(k[7], k[9]); CE_(k[10], k[11]); CE_(k[12], k[13]); CE_(k[14], k[15]); CE_(k[16], k[17]); CE_(k[18], k[19]); CE_(k[20], k[21]); CE_(k[22], k[24]); CE_(k[23], k[25]); CE_(k[26], k[27]); CE_(k[28], k[29]); CE_(k[30], k[31]); CE_(k[32], k[33]); CE_(k[34], k[35]); CE_(k[36], k[37]); CE_(k[38], k[40]); CE_(k[39], k[41]); CE_(k[42], k[43]); CE_(k[44], k[45]); CE_(k[46], k[47]); CE_(k[48], k[49]); CE_(k[50], k[51]); CE_(k[52], k[53]); CE_(k[54], k[56]); CE_(k[55], k[57]); CE_(k[58], k[59]); CE_(k[60], k[61]); CE_(k[62], k[63]); CE_(k[0], k[2]); CE_(k[1], k[3]); CE_(k[4], k[10]); CE_(k[5], k[11]); CE_(k[6], k[7]); CE_(k[8], k[9]); CE_(k[12], k[14]); CE_(k[13], k[15]); CE_(k[16], k[18]); CE_(k[17], k[19]); CE_(k[20], k[26]); CE_(k[21], k[27]); CE_(k[22], k[23]); CE_(k[24], k[25]); CE_(k[28], k[30]); CE_(k[29], k[31]); CE_(k[32], k[34]); CE_(k[33], k[35]); CE_(k[36], k[42]); CE_(k[37], k[43]); CE_(k[38], k[39]); CE_(k[40], k[41]); CE_(k[44], k[46]); CE_(k[45], k[47]); CE_(k[48], k[50]); CE_(k[49], k[51]); CE_(k[52], k[58]); CE_(k[53], k[59]); CE_(k[54], k[55]); CE_(k[56], k[57]); CE_(k[60], k[62]); CE_(k[61], k[63]); CE_(k[1], k[2]); CE_(k[3], k[12]); CE_(k[4], k[6]); CE_(k[5], k[7]); CE_(k[8], k[10]); CE_(k[9], k[11]); CE_(k[13], k[14]); CE_(k[17], k[18]); CE_(k[19], k[28]); CE_(k[20], k[22]); CE_(k[21], k[23]); CE_(k[24], k[26]); CE_(k[25], k[27]); CE_(k[29], k[30]); CE_(k[33], k[34]); CE_(k[35], k[44]); CE_(k[36], k[38]); CE_(k[37], k[39]); CE_(k[40], k[42]); CE_(k[41], k[43]); CE_(k[45], k[46]); CE_(k[49], k[50]); CE_(k[51], k[60]); CE_(k[52], k[54]); CE_(k[53], k[55]); CE_(k[56], k[58]); CE_(k[57], k[59]); CE_(k[61], k[62]); CE_(k[1], k[4]); CE_(k[2], k[6]); CE_(k[5], k[8]); CE_(k[7], k[10]); CE_(k[9], k[13]); CE_(k[11], k[14]); CE_(k[17], k[20]); CE_(k[18], k[22]); CE_(k[21], k[24]); CE_(k[23], k[26]); CE_(k[25], k[29]); CE_(k[27], k[30]); CE_(k[33], k[36]); CE_(k[34], k[38]); CE_(k[37], k[40]); CE_(k[39], k[42]); CE_(k[41], k[45]); CE_(k[43], k[46]); CE_(k[49], k[52]); CE_(k[50], k[54]); CE_(k[53], k[56]); CE_(k[55], k[58]); CE_(k[57], k[61]); CE_(k[59], k[62]); CE_(k[2], k[4]); CE_(k[3], k[6]); CE_(k[9], k[12]); CE_(k[11], k[13]); CE_(k[18], k[20]); CE_(k[19], k[22]); CE_(k[25], k[28]); CE_(k[27], k[29]); CE_(k[34], k[36]); CE_(k[35], k[38]); CE_(k[41], k[44]); CE_(k[43], k[45]); CE_(k[50], k[52]); CE_(k[51], k[54]); CE_(k[57], k[60]); CE_(k[59], k[61]); CE_(k[3], k[5]); CE_(k[6], k[8]); CE_(k[7], k[9]); CE_(k[10], k[12]); CE_(k[19], k[21]); CE_(k[22], k[24]); CE_(k[23], k[25]); CE_(k[26], k[28]); CE_(k[35], k[37]); CE_(k[38], k[40]); CE_(k[39], k[41]); CE_(k[42], k[44]); CE_(k[51], k[53]); CE_(k[54], k[56]); CE_(k[55], k[57]); CE_(k[58], k[60]); CE_(k[3], k[4]); CE_(k[5], k[6]); CE_(k[7], k[8]); CE_(k[9], k[10]); CE_(k[11], k[12]); CE_(k[19], k[20]); CE_(k[21], k[22]); CE_(k[23], k[24]); CE_(k[25], k[26]); CE_(k[27], k[28]); CE_(k[35], k[36]); CE_(k[37], k[38]); CE_(k[39], k[40]); CE_(k[41], k[42]); CE_(k[43], k[44]); CE_(k[51], k[52]); CE_(k[53], k[54]); CE_(k[55], k[56]); CE_(k[57], k[58]); CE_(k[59], k[60]); CE_(k[6], k[7]); CE_(k[8], k[9]); CE_(k[22], k[23]); CE_(k[24], k[25]); CE_(k[38], k[39]); CE_(k[40], k[41]); CE_(k[54], k[55]); CE_(k[56], k[57]); k[0] = max(k[0], k[31]); k[1] = max(k[1], k[30]); k[2] = max(k[2], k[29]); k[3] = max(k[3], k[28]); k[4] = max(k[4], k[27]); k[5] = max(k[5], k[26]); k[6] = max(k[6], k[25]); k[7] = max(k[7], k[24]); k[8] = max(k[8], k[23]); k[9] = max(k[9], k[22]); k[10] = max(k[10], k[21]); k[11] = max(k[11], k[20]); k[12] = max(k[12], k[19]); k[13] = max(k[13], k[18]); k[14] = max(k[14], k[17]); k[15] = max(k[15], k[16]); CE_(k[0], k[8]); CE_(k[1], k[9]); CE_(k[2], k[10]); CE_(k[3], k[11]); CE_(k[4], k[12]); CE_(k[5], k[13]); CE_(k[6], k[14]); CE_(k[7], k[15]); CE_(k[0], k[4]); CE_(k[1], k[5]); CE_(k[2], k[6]); CE_(k[3], k[7]); CE_(k[8], k[12]); CE_(k[9], k[13]); CE_(k[10], k[14]); CE_(k[11], k[15]); CE_(k[0], k[2]); CE_(k[1], k[3]); CE_(k[4], k[6]); CE_(k[5], k[7]); CE_(k[8], k[10]); CE_(k[9], k[11]); CE_(k[12], k[14]); CE_(k[13], k[15]); CE_(k[0], k[1]); CE_(k[2], k[3]); CE_(k[4], k[5]); CE_(k[6], k[7]); CE_(k[8], k[9]); CE_(k[10], k[11]); CE_(k[12], k[13]); CE_(k[14], k[15]); k[32] = max(k[32], k[63]); k[33] = max(k[33], k[62]); k[34] = max(k[34], k[61]); k[35] = max(k[35], k[60]); k[36] = max(k[36], k[59]); k[37] = max(k[37], k[58]); k[38] = max(k[38], k[57]); k[39] = max(k[39], k[56]); k[40] = max(k[40], k[55]); k[41] = max(k[41], k[54]); k[42] = max(k[42], k[53]); k[43] = max(k[43], k[52]); k[44] = max(k[44], k[51]); k[45] = max(k[45], k[50]); k[46] = max(k[46], k[49]); k[47] = max(k[47], k[48]); CE_(k[32], k[40]); CE_(k[33], k[41]); CE_(k[34], k[42]); CE_(k[35], k[43]); CE_(k[36], k[44]); CE_(k[37], k[45]); CE_(k[38], k[46]); CE_(k[39], k[47]); CE_(k[32], k[36]); CE_(k[33], k[37]); CE_(k[34], k[38]); CE_(k[35], k[39]); CE_(k[40], k[44]); CE_(k[41], k[45]); CE_(k[42], k[46]); CE_(k[43], k[47]); CE_(k[32], k[34]); CE_(k[33], k[35]); CE_(k[36], k[38]); CE_(k[37], k[39]); CE_(k[40], k[42]); CE_(k[41], k[43]); CE_(k[44], k[46]); CE_(k[45], k[47]); CE_(k[32], k[33]); CE_(k[34], k[35]); CE_(k[36], k[37]); CE_(k[38], k[39]); CE_(k[40], k[41]); CE_(k[42], k[43]); CE_(k[44], k[45]); CE_(k[46], k[47]); k[0] = max(k[0], k[47]); k[1] = max(k[1], k[46]); k[2] = max(k[2], k[45]); k[3] = max(k[3], k[44]); k[4] = max(k[4], k[43]); k[5] = max(k[5], k[42]); k[6] = max(k[6], k[41]); k[7] = max(k[7], k[40]); k[8] = max(k[8], k[39]); k[9] = max(k[9], k[38]); k[10] = max(k[10], k[37]); k[11] = max(k[11], k[36]); k[12] = max(k[12], k[35]); k[13] = max(k[13], k[34]); k[14] = max(k[14], k[33]); k[15] = max(k[15], k[32]); CE_(k[0], k[8]); CE_(k[1], k[9]); CE_(k[2], k[10]); CE_(k[3], k[11]); CE_(k[4], k[12]); CE_(k[5], k[13]); CE_(k[6], k[14]); CE_(k[7], k[15]); CE_(k[0], k[4]); CE_(k[1], k[5]); CE_(k[2], k[6]); CE_(k[3], k[7]); CE_(k[8], k[12]); CE_(k[9], k[13]); CE_(k[10], k[14]); CE_(k[11], k[15]); CE_(k[0], k[2]); CE_(k[1], k[3]); CE_(k[4], k[6]); CE_(k[5], k[7]); CE_(k[8], k[10]); CE_(k[9], k[11]); CE_(k[12], k[14]); CE_(k[13], k[15]); CE_(k[0], k[1]); CE_(k[2], k[3]); CE_(k[4], k[5]); CE_(k[6], k[7]); CE_(k[8], k[9]); CE_(k[10], k[11]); CE_(k[12], k[13]); CE_(k[14], k[15]); } while (0)
#define TOPK_XMERGE(T_) do { u32 pp_[16]; _Pragma("unroll") for (int i_ = 0; i_ < 16; ++i_) pp_[i_] = (u32)__shfl_xor((int)k[i_], 32); T_[0] = max(k[0], pp_[15]); T_[1] = max(k[1], pp_[14]); T_[2] = max(k[2], pp_[13]); T_[3] = max(k[3], pp_[12]); T_[4] = max(k[4], pp_[11]); T_[5] = max(k[5], pp_[10]); T_[6] = max(k[6], pp_[9]); T_[7] = max(k[7], pp_[8]); T_[8] = max(k[8], pp_[7]); T_[9] = max(k[9], pp_[6]); T_[10] = max(k[10], pp_[5]); T_[11] = max(k[11], pp_[4]); T_[12] = max(k[12], pp_[3]); T_[13] = max(k[13], pp_[2]); T_[14] = max(k[14], pp_[1]); T_[15] = max(k[15], pp_[0]); CE_(T_[0], T_[8]); CE_(T_[1], T_[9]); CE_(T_[2], T_[10]); CE_(T_[3], T_[11]); CE_(T_[4], T_[12]); CE_(T_[5], T_[13]); CE_(T_[6], T_[14]); CE_(T_[7], T_[15]); CE_(T_[0], T_[4]); CE_(T_[1], T_[5]); CE_(T_[2], T_[6]); CE_(T_[3], T_[7]); CE_(T_[8], T_[12]); CE_(T_[9], T_[13]); CE_(T_[10], T_[14]); CE_(T_[11], T_[15]); CE_(T_[0], T_[2]); CE_(T_[1], T_[3]); CE_(T_[4], T_[6]); CE_(T_[5], T_[7]); CE_(T_[8], T_[10]); CE_(T_[9], T_[11]); CE_(T_[12], T_[14]); CE_(T_[13], T_[15]); CE_(T_[0], T_[1]); CE_(T_[2], T_[3]); CE_(T_[4], T_[5]); CE_(T_[6], T_[7]); CE_(T_[8], T_[9]); CE_(T_[10], T_[11]); CE_(T_[12], T_[13]); CE_(T_[14], T_[15]); } while (0)
constexpr int SKROW = 272;
__device__ __forceinline__ void peer_topk_unit(int lane, int tok0, int tokn, int head, const bf16_t* __restrict__ QRY, bf16x8_t (&qf)[8], const LAS unsigned char* sk, LAS unsigned char* tl, int* __restrict__ IDX, float* __restrict__ GATE) {
    const int ql = lane & 31, hi = lane >> 5;
    bool bad = false; (void)bad;
    u32 top[2][16];
#pragma unroll
    for (int c = 0; c < 2; ++c) {
        const LAS unsigned char* kp = sk + (c * 128 + ql) * SKROW + 16 * hi;
        f32x16_t sc[4];
#pragma unroll
        for (int kb = 0; kb < 4; ++kb) sc[kb] = (f32x16_t){0.f, 0.f, 0.f, 0.f, 0.f, 0.f, 0.f, 0.f, 0.f, 0.f, 0.f, 0.f, 0.f, 0.f, 0.f, 0.f};
#pragma unroll
        for (int ks = 0; ks < 8; ++ks) {
#pragma unroll
            for (int kb = 0; kb < 4; ++kb) { const bf16x8_t a = *(const LAS bf16x8_t*)(kp + kb * 32 * SKROW + 32 * ks); sc[kb] = MFMA32(a, qf[ks], sc[kb]); }
        }
        {
            const bf16_t* qn = QRY + (size_t)((c == 0 ? tok0 : tokn) + ql) * 2048 + head * 256 + (c == 0 ? 128 : 0) + 8 * hi;
#pragma unroll
            for (int ks = 0; ks < 8; ++ks) qf[ks] = *(const bf16x8_t*)(qn + 16 * ks);
        }
        u32 k[64];
#pragma unroll
        for (int kb = 0; kb < 4; ++kb)
#pragma unroll
            for (int r = 0; r < 16; ++r) k[kb * 16 + r] = (f2ord(sc[kb][r]) & ~127u) | (u32)(127 - (32 * kb + crow(r, hi)));
#ifdef PROBE_TOPK_CHECK
        u32 k2[64];
#pragma unroll
        for (int i = 0; i < 64; ++i) k2[i] = k[i];
        u32 told[16];
#pragma unroll
        for (int rd = 0; rd < 16; ++rd) {
            u32 b = umax3(k2[0], k2[1], k2[2]);
#pragma unroll
            for (int i = 3; i + 1 < 64; i += 2) b = umax3(b, k2[i], k2[i + 1]);
            b = max(b, k2[63]);
            const u32 g = max(b, (u32)__shfl_xor((int)b, 32));
            told[rd] = g;
#pragma unroll
            for (int i = 0; i < 64; ++i) k2[i] = (k2[i] == g) ? 0u : k2[i];
        }
#endif
        TOPK_NET();
        TOPK_XMERGE(top[c]);
#ifdef PROBE_TOPK_CHECK
#pragma unroll
        for (int rd = 0; rd < 16; ++rd) bad |= (told[rd] != top[c][rd]);
#endif
    }
    float va[16], vb[16];
#pragma unroll
    for (int i = 0; i < 16; ++i) { va[i] = ord2f(top[0][i] & ~127u); vb[i] = ord2f(top[1][i] & ~127u); }
    LAS u32* tlr = (LAS u32*)(tl + ql * 144);
    {
        u32 w_[16];
#pragma unroll
        for (int i = 0; i < 16; ++i) w_[i] = hi ? top[1][i] : top[0][i];
#pragma unroll
        for (int q = 0; q < 4; ++q) { u32x4_t t4; t4.x = w_[4 * q]; t4.y = w_[4 * q + 1]; t4.z = w_[4 * q + 2]; t4.w = w_[4 * q + 3]; *(LAS u32x4_t*)(tlr + 16 * hi + 4 * q) = t4; }
    }
    float sv[16]; u32 oe[8];
    {
        u32 k[64];
#pragma unroll
        for (int t = 0; t < 25; ++t) {
            constexpr int CI[50] = {0, 0, 0, 0, 0, 0, 0, 0, 0, 0, 0, 0, 0, 0, 0, 0, 1, 1, 1, 1, 1, 1, 1, 1, 2, 2, 2, 2, 2, 3, 3, 3, 3, 4, 4, 4, 5, 5, 6, 6, 7, 7, 8, 9, 10, 11, 12, 13, 14, 15};
            constexpr int CJ[50] = {0, 1, 2, 3, 4, 5, 6, 7, 8, 9, 10, 11, 12, 13, 14, 15, 0, 1, 2, 3, 4, 5, 6, 7, 0, 1, 2, 3, 4, 0, 1, 2, 3, 0, 1, 2, 0, 1, 0, 1, 0, 1, 0, 0, 0, 0, 0, 0, 0, 0};
            const int i0 = CI[2 * t], j0 = CJ[2 * t], i1 = CI[2 * t + 1], j1 = CJ[2 * t + 1];
            const u32 key0 = (f2ord(va[i0] + vb[j0]) & ~255u) | (u32)(255 - (i0 * 16 + j0)), key1 = (f2ord(va[i1] + vb[j1]) & ~255u) | (u32)(255 - (i1 * 16 + j1));
            k[t] = hi ? key1 : key0;
        }
#pragma unroll
        for (int t = 25; t < 64; ++t) k[t] = 0u;
        TOPK_NET();
        u32 g[16];
        TOPK_XMERGE(g);
#pragma unroll
        for (int rd = 0; rd < 16; ++rd) sv[rd] = ord2f(g[rd] & ~255u);
#pragma unroll
        for (int q = 0; q < 8; ++q) {
            const u32 key = hi ? g[8 + q] : g[q], ci = 255u - (key & 255u);
            const u32 e1 = 127u - (tlr[ci >> 4] & 127u), e2 = 127u - (tlr[16 + (ci & 15u)] & 127u);
            oe[q] = e1 * 128u + e2;
        }
    }
    const float mx = sv[0]; float sum = 0.f;
#pragma unroll
    for (int rd = 0; rd < 16; ++rd) { sv[rd] = __expf(sv[rd] - mx); sum += sv[rd]; }
    const float inv = 1.0f / sum;
    float og[8];
#pragma unroll
    for (int q = 0; q < 8; ++q) og[q] = (hi ? sv[8 + q] : sv[q]) * inv;
    const size_t o = (size_t)(tok0 + ql) * 128 + head * 16 + 8 * hi;
    *(uint4*)(IDX + o) = make_uint4(oe[0], oe[1], oe[2], oe[3]); *(uint4*)(IDX + o + 4) = make_uint4(oe[4], oe[5], oe[6], oe[7]);
#ifdef PROBE_TOPK_CHECK
    if (bad) { og[0] = __builtin_nanf(""); }
#endif
    *(float4*)(GATE + o) = make_float4(og[0], og[1], og[2], og[3]); *(float4*)(GATE + o + 4) = make_float4(og[4], og[5], og[6], og[7]);
}

#define MFMA16(a, b, c) __builtin_amdgcn_mfma_f32_16x16x32_bf16((a), (b), (c), 0, 0, 0)
__device__ __forceinline__ void peer_token(int lane, int tok, const bf16_t* __restrict__ U, const bf16_t* __restrict__ Vt, const int* __restrict__ IDX, const float* __restrict__ GATE,
                                           float* __restrict__ H, bf16_t* __restrict__ HB, const float* __restrict__ rss1, float* __restrict__ rss2, const bool wr = true) {
    const int r = lane & 15, kq = lane >> 4;
    int ev[8];
#pragma unroll
    for (int g = 0; g < 8; ++g) ev[g] = IDX[(size_t)tok * 128 + 16 * g + r];
    const float r1 = rsqrtf(rss1[tok] * (1.f / DM) + 1e-6f);
    const bf16_t* hrow = HB + (size_t)tok * DM + 8 * kq;
    f32x4_t acc[8];
#pragma unroll
    for (int g = 0; g < 8; ++g) acc[g] = (f32x4_t){0.f, 0.f, 0.f, 0.f};
    const char* ub = (const char*)U + 16 * kq;
#pragma unroll 4
    for (int ks = 0; ks < 32; ++ks) {
        const bf16x8_t bfr = *(const bf16x8_t*)(hrow + 32 * ks);
#pragma unroll
        for (int g = 0; g < 8; ++g) { const bf16x8_t a = *(const bf16x8_t*)(ub + (size_t)(unsigned)ev[g] * 2048u + 64 * ks); acc[g] = MFMA16(a, bfr, acc[g]); }
    }
#pragma unroll
    for (int g = 0; g < 8; ++g) {
        const float4 gt = *(const float4*)(GATE + (size_t)tok * 128 + 16 * g + 4 * kq);
        const float gg[4] = {gt.x, gt.y, gt.z, gt.w};
#pragma unroll
        for (int i = 0; i < 4; ++i) { const float z = acc[g][i] * r1; acc[g][i] = 0.5f * z * (1.f + erff(z * 0.70710678118654752f)) * gg[i]; }
    }
    float o[16];
#pragma unroll
    for (int j = 0; j < 16; ++j) o[j] = 0.f;
    const char* vb = (const char*)Vt + 16 * lane;
#pragma unroll
    for (int g = 0; g < 8; ++g) {
#pragma unroll
        for (int rr = 0; rr < 16; rr += 4) {
            u32x4_t w0[4], w1[4]; float ae[4];
#pragma unroll
            for (int q = 0; q < 4; ++q) {
                const int e = __builtin_amdgcn_readlane(ev[g], rr + q);
                ae[q] = __int_as_float(__builtin_amdgcn_readlane(__float_as_int(acc[g][(rr + q) & 3]), 16 * ((rr + q) >> 2)));
                const char* vp = vb + (size_t)(unsigned)e * 2048u;
                w0[q] = *(const u32x4_t*)vp; w1[q] = *(const u32x4_t*)(vp + 1024);
            }
#pragma unroll
            for (int q = 0; q < 4; ++q) {
                const float a = ae[q];
                const u32 ww[8] = {w0[q].x, w0[q].y, w0[q].z, w0[q].w, w1[q].x, w1[q].y, w1[q].z, w1[q].w};
#pragma unroll
                for (int j = 0; j < 8; ++j) { o[2 * j] = fmaf(a, __uint_as_float(ww[j] << 16), o[2 * j]); o[2 * j + 1] = fmaf(a, __uint_as_float(ww[j] & 0xffff0000u), o[2 * j + 1]); }
            }
        }
    }
    float* hp = H + (size_t)tok * DM + 8 * lane;
    float4 h0 = *(float4*)hp, h1 = *(float4*)(hp + 4), h2 = *(float4*)(hp + 512), h3 = *(float4*)(hp + 516);
    h0.x += o[0]; h0.y += o[1]; h0.z += o[2]; h0.w += o[3]; h1.x += o[4]; h1.y += o[5]; h1.z += o[6]; h1.w += o[7];
    h2.x += o[8]; h2.y += o[9]; h2.z += o[10]; h2.w += o[11]; h3.x += o[12]; h3.y += o[13]; h3.z += o[14]; h3.w += o[15];
    if (wr) { *(float4*)hp = h0; *(float4*)(hp + 4) = h1; *(float4*)(hp + 512) = h2; *(float4*)(hp + 516) = h3; }
    const float wa[8] = {h0.x, h0.y, h0.z, h0.w, h1.x, h1.y, h1.z, h1.w}, wb[8] = {h2.x, h2.y, h2.z, h2.w, h3.x, h3.y, h3.z, h3.w};
    bf16_t* hb = HB + (size_t)tok * DM + 8 * lane;
    float s = 0.f;
#pragma unroll
    for (int j = 0; j < 8; ++j) s += wa[j] * wa[j] + wb[j] * wb[j];
    s = wave_sum(s);
    if (wr) { *(uint4*)hb = pack8(wa); *(uint4*)(hb + 512) = pack8(wb); }
    if (lane == 0) { if (wr) rss2[tok] = s; else if (s == 123.456f) rss2[tok] = s; }
}
__device__ __forceinline__ void b_rowquant(int row, int lane, const float* __restrict__ src, const float* __restrict__ gain, unsigned char* __restrict__ dst8, float* __restrict__ scale) {
    const float4* sp = (const float4*)(src + (size_t)row * DM + 16 * lane);
    float v[16];
#pragma unroll
    for (int j = 0; j < 4; ++j) { const float4 t = sp[j]; v[4 * j] = t.x; v[4 * j + 1] = t.y; v[4 * j + 2] = t.z; v[4 * j + 3] = t.w; }
    if (gain) {
#pragma unroll
        for (int j = 0; j < 16; ++j) v[j] *= gain[16 * lane + j];
    }
    float am = 0.f;
#pragma unroll
    for (int j = 0; j < 16; ++j) am = fmaxf(am, fabsf(v[j]));
    am = wave_max(am);
    const float sc = am > 0.f ? am * (1.0f / 440.0f) : 1.0f, inv = 1.0f / sc;
    int w[4];
#pragma unroll
    for (int j = 0; j < 4; ++j) { int t = 0; t = __builtin_amdgcn_cvt_pk_fp8_f32(v[4 * j] * inv, v[4 * j + 1] * inv, t, false); t = __builtin_amdgcn_cvt_pk_fp8_f32(v[4 * j + 2] * inv, v[4 * j + 3] * inv, t, true); w[j] = t; }
    *(uint4*)(dst8 + ((size_t)(lane >> 3) * NEXP + row) * 128 + 16 * (lane & 7)) = make_uint4((u32)w[0], (u32)w[1], (u32)w[2], (u32)w[3]);
    if (lane == 0) scale[row] = sc;
}
__device__ __forceinline__ float gelu_as(float v) {
    const float av = fabsf(v), t = __builtin_amdgcn_rcpf(av * 0.2316418882f + 1.0f);
    float q = t * 0.5307027145f + (-0.7265760135f); q = q * t + 0.7107068705f; q = q * t + (-0.142248368f); q = q * t + 0.127414796f; q = q * t;
    const float e = __builtin_amdgcn_exp2f((v * v) * (-0.72134752044f));
    const float m = v * (q * e);
    return v < 0.f ? m : v - m;
}
typedef float f32x2_t __attribute__((ext_vector_type(2)));
#define MFMA8(a, b, c) __builtin_amdgcn_mfma_f32_16x16x32_fp8_fp8((a), (b), (c), 0, 0, 0)
__device__ __forceinline__ void peer_token8(int lane, int tok, LAS unsigned char* wb, const unsigned char* __restrict__ U8, const unsigned char* __restrict__ V8, const float* __restrict__ SU, const float* __restrict__ SV,
                                            const int* __restrict__ IDX, const float* __restrict__ GATE, float* __restrict__ H, bf16_t* __restrict__ HB, const float* __restrict__ rss1, float* __restrict__ rss2) {
    const int r = lane & 15, kq = lane >> 4;
    int ev[8];
#pragma unroll
    for (int g = 0; g < 8; ++g) ev[g] = IDX[(size_t)tok * 128 + 16 * g + r];
    const float r1 = rsqrtf(rss1[tok] * (1.f / DM) + 1e-6f);
    float sh;
    {
        const uint4 a0 = *(const uint4*)(HB + (size_t)tok * DM + 16 * lane), a1 = *(const uint4*)(HB + (size_t)tok * DM + 16 * lane + 8);
        const u32 ww[8] = {a0.x, a0.y, a0.z, a0.w, a1.x, a1.y, a1.z, a1.w};
        float v[16]; float am = 0.f;
#pragma unroll
        for (int j = 0; j < 8; ++j) { v[2 * j] = __uint_as_float(ww[j] << 16); v[2 * j + 1] = __uint_as_float(ww[j] & 0xffff0000u); am = fmaxf(am, fmaxf(fabsf(v[2 * j]), fabsf(v[2 * j + 1]))); }
        am = wave_max(am);
        sh = am > 0.f ? am * (1.0f / 440.0f) : 1.0f;
        const float inv = 1.0f / sh;
        u32x4_t w;
        { int t = 0; t = __builtin_amdgcn_cvt_pk_fp8_f32(v[0] * inv, v[1] * inv, t, false); t = __builtin_amdgcn_cvt_pk_fp8_f32(v[2] * inv, v[3] * inv, t, true); w.x = (u32)t; }
        { int t = 0; t = __builtin_amdgcn_cvt_pk_fp8_f32(v[4] * inv, v[5] * inv, t, false); t = __builtin_amdgcn_cvt_pk_fp8_f32(v[6] * inv, v[7] * inv, t, true); w.y = (u32)t; }
        { int t = 0; t = __builtin_amdgcn_cvt_pk_fp8_f32(v[8] * inv, v[9] * inv, t, false); t = __builtin_amdgcn_cvt_pk_fp8_f32(v[10] * inv, v[11] * inv, t, true); w.z = (u32)t; }
        { int t = 0; t = __builtin_amdgcn_cvt_pk_fp8_f32(v[12] * inv, v[13] * inv, t, false); t = __builtin_amdgcn_cvt_pk_fp8_f32(v[14] * inv, v[15] * inv, t, true); w.w = (u32)t; }
        *(LAS u32x4_t*)(wb + 16 * lane) = w;
    }
    f32x4_t acc[8];
#pragma unroll
    for (int g = 0; g < 8; ++g) acc[g] = (f32x4_t){0.f, 0.f, 0.f, 0.f};
    const unsigned char* ub = U8 + 16 * kq;
#pragma unroll 2
    for (int c = 0; c < 16; ++c) {
        const u32x4_t bq = *(const LAS u32x4_t*)(wb + 64 * c + 16 * kq);
        const long b0 = (long)(((unsigned long long)bq.y << 32) | bq.x), b1 = (long)(((unsigned long long)bq.w << 32) | bq.z);
#pragma unroll
        for (int g = 0; g < 8; ++g) {
            const u32x4_t a = *(const u32x4_t*)(ub + (size_t)(unsigned)ev[g] * 1024u + 64 * c);
            const long a0 = (long)(((unsigned long long)a.y << 32) | a.x), a1 = (long)(((unsigned long long)a.w << 32) | a.z);
            acc[g] = MFMA8(a0, b0, acc[g]); acc[g] = MFMA8(a1, b1, acc[g]);
        }
    }
    const float zs = sh * r1;
#pragma unroll
    for (int g = 0; g < 8; ++g) {
        const float4 gt = *(const float4*)(GATE + (size_t)tok * 128 + 16 * g + 4 * kq);
        const int4 ei = *(const int4*)(IDX + (size_t)tok * 128 + 16 * g + 4 * kq);
        const float gg[4] = {gt.x, gt.y, gt.z, gt.w}; const int ee[4] = {ei.x, ei.y, ei.z, ei.w};
#pragma unroll
        for (int i = 0; i < 4; ++i) { const float z = acc[g][i] * zs * SU[ee[i]]; acc[g][i] = gelu_as(z) * gg[i] * SV[ee[i]]; }
    }
    float o[16];
#pragma unroll
    for (int j = 0; j < 16; ++j) o[j] = 0.f;
    const unsigned char* vb = V8 + 16 * lane;
#pragma unroll
    for (int g = 0; g < 8; ++g) {
#pragma unroll
        for (int rr = 0; rr < 16; rr += 4) {
            u32x4_t w[4]; float ae[4];
#pragma unroll
            for (int q = 0; q < 4; ++q) {
                const int e = __builtin_amdgcn_readlane(ev[g], rr + q);
                ae[q] = __int_as_float(__builtin_amdgcn_readlane(__float_as_int(acc[g][(rr + q) & 3]), 16 * ((rr + q) >> 2)));
                w[q] = *(const u32x4_t*)(vb + (size_t)(unsigned)e * 1024u);
            }
#pragma unroll
            for (int q = 0; q < 4; ++q) {
                const float a = ae[q];
                const u32 ww[4] = {w[q].x, w[q].y, w[q].z, w[q].w};
#pragma unroll
                for (int j = 0; j < 4; ++j) {
                    const f32x2_t lo = __builtin_amdgcn_cvt_pk_f32_fp8((int)ww[j], false), hi2 = __builtin_amdgcn_cvt_pk_f32_fp8((int)ww[j], true);
                    o[4 * j] = fmaf(a, lo[0], o[4 * j]); o[4 * j + 1] = fmaf(a, lo[1], o[4 * j + 1]); o[4 * j + 2] = fmaf(a, hi2[0], o[4 * j + 2]); o[4 * j + 3] = fmaf(a, hi2[1], o[4 * j + 3]);
                }
            }
        }
    }
    float* hp = H + (size_t)tok * DM + 16 * lane;
    float hv[16]; float s = 0.f;
#pragma unroll
    for (int j = 0; j < 4; ++j) { const float4 t = *(const float4*)(hp + 4 * j); hv[4 * j] = t.x + o[4 * j]; hv[4 * j + 1] = t.y + o[4 * j + 1]; hv[4 * j + 2] = t.z + o[4 * j + 2]; hv[4 * j + 3] = t.w + o[4 * j + 3]; }
#pragma unroll
    for (int j = 0; j < 4; ++j) *(float4*)(hp + 4 * j) = make_float4(hv[4 * j], hv[4 * j + 1], hv[4 * j + 2], hv[4 * j + 3]);
#pragma unroll
    for (int j = 0; j < 16; ++j) s += hv[j] * hv[j];
    s = wave_sum(s);
    bf16_t* hb = HB + (size_t)tok * DM + 16 * lane;
    *(uint4*)hb = pack8(hv); *(uint4*)(hb + 8) = pack8(hv + 8);
    if (lane == 0) rss2[tok] = s;
}
constexpr int PL_ZP = 0;
constexpr int PL_EI = 65536;
constexpr int PL_SS = 131072;
__device__ __forceinline__ void b_tokquant(int tok, int lane, const bf16_t* __restrict__ HB, unsigned char* __restrict__ HB8, float* __restrict__ SH) {
    const uint4 a0 = *(const uint4*)(HB + (size_t)tok * DM + 16 * lane), a1 = *(const uint4*)(HB + (size_t)tok * DM + 16 * lane + 8);
    const u32 ww[8] = {a0.x, a0.y, a0.z, a0.w, a1.x, a1.y, a1.z, a1.w};
    float v[16]; float am = 0.f;
#pragma unroll
    for (int j = 0; j < 8; ++j) { v[2 * j] = __uint_as_float(ww[j] << 16); v[2 * j + 1] = __uint_as_float(ww[j] & 0xffff0000u); am = fmaxf(am, fmaxf(fabsf(v[2 * j]), fabsf(v[2 * j + 1]))); }
    am = wave_max(am);
    const float sh = am > 0.f ? am * (1.0f / 440.0f) : 1.0f, inv = 1.0f / sh;
    int w[4];
#pragma unroll
    for (int j = 0; j < 4; ++j) { int t = 0; t = __builtin_amdgcn_cvt_pk_fp8_f32(v[4 * j] * inv, v[4 * j + 1] * inv, t, false); t = __builtin_amdgcn_cvt_pk_fp8_f32(v[4 * j + 2] * inv, v[4 * j + 3] * inv, t, true); w[j] = t; }
    *(uint4*)(HB8 + (size_t)tok * DM + 16 * lane) = make_uint4((u32)w[0], (u32)w[1], (u32)w[2], (u32)w[3]);
    if (lane == 0) SH[tok] = sh;
}
__device__ __forceinline__ void peer_sliced(LAS unsigned char* lds, int lane, int wave, int tok0, const unsigned char* __restrict__ U8, const unsigned char* __restrict__ V8, const float* __restrict__ SU, const float* __restrict__ SV,
                                            const unsigned char* __restrict__ HB8, const float* __restrict__ SH, const int* __restrict__ IDX, const float* __restrict__ GATE,
                                            float* __restrict__ H, bf16_t* __restrict__ HB, const float* __restrict__ rss1, float* __restrict__ rss2) {
    LAS float* zp = (LAS float*)(lds + PL_ZP) + wave * (16 * 128);
    LAS int* ei = (LAS int*)(lds + PL_EI) + wave * (16 * 128);
    LAS float* ssl = (LAS float*)(lds + PL_SS) + wave * 16;
    const int tw = tok0 + 16 * wave;
#pragma unroll
    for (int i = 0; i < 8; ++i) { const int o = i * 256 + 4 * lane; *(LAS u32x4_t*)(ei + o) = *(const u32x4_t*)(IDX + (size_t)tw * 128 + o); }
    if (lane < 16) ssl[lane] = 0.f;
    const int r = lane & 15, kq = lane >> 4;
    {
        int lane_u = lane;
#define UV_LOAD(W_, TG_, EB_) do { \
        _Pragma("unroll") for (int q = 0; q < 2; ++q) { const u32x4_t ev_ = *(const LAS u32x4_t*)(ei + (8 * (TG_) + ju) * 128 + 8 * (EB_) + 4 * q); \
            W_[4 * q] = *(const u32x4_t*)(ub_ + (ev_.x * 128u + (unsigned)(16 * du))); W_[4 * q + 1] = *(const u32x4_t*)(ub_ + (ev_.y * 128u + (unsigned)(16 * du))); \
            W_[4 * q + 2] = *(const u32x4_t*)(ub_ + (ev_.z * 128u + (unsigned)(16 * du))); W_[4 * q + 3] = *(const u32x4_t*)(ub_ + (ev_.w * 128u + (unsigned)(16 * du))); } } while (0)
#define UV_DOT(W_, TG_, EB_) do { float v_[8]; \
        _Pragma("unroll") for (int k = 0; k < 8; ++k) { const u32 ww_[4] = {W_[k].x, W_[k].y, W_[k].z, W_[k].w}; float d0_ = 0.f, d1_ = 0.f; \
            _Pragma("unroll") for (int q = 0; q < 4; ++q) { \
                const f32x2_t lo_ = __builtin_amdgcn_cvt_pk_f32_fp8((int)ww_[q], false), hi_ = __builtin_amdgcn_cvt_pk_f32_fp8((int)ww_[q], true); \
                d0_ = fmaf(lo_[0], hv[4 * q], d0_); d1_ = fmaf(lo_[1], hv[4 * q + 1], d1_); d0_ = fmaf(hi_[0], hv[4 * q + 2], d0_); d1_ = fmaf(hi_[1], hv[4 * q + 3], d1_); } \
            v_[k] = d0_ + d1_; } \
        _Pragma("unroll") for (int k = 0; k < 4; ++k) { const float snd_ = (du & 4) ? v_[k] : v_[k + 4], kp_ = (du & 4) ? v_[k + 4] : v_[k]; v_[k] = kp_ + __shfl_xor(snd_, 4); } \
        _Pragma("unroll") for (int k = 0; k < 2; ++k) { const float snd_ = (du & 2) ? v_[k] : v_[k + 2], kp_ = (du & 2) ? v_[k + 2] : v_[k]; v_[k] = kp_ + __shfl_xor(snd_, 2); } \
        { const float snd_ = (du & 1) ? v_[0] : v_[1], kp_ = (du & 1) ? v_[1] : v_[0]; v_[0] = kp_ + __shfl_xor(snd_, 1); } \
        { LAS float* zq_ = zp + (8 * (TG_) + ju) * 128 + 8 * (EB_) + du; if (s_ == 0) *zq_ = v_[0]; else *zq_ += v_[0]; } \
        asm volatile("" ::: "memory"); } while (0)
#define UV_TG(TG_) do { float hv[16]; \
            { const bf16_t* hp_ = HB + (size_t)(tw + 8 * (TG_) + ju) * DM + 128 * s_ + 16 * du;        \
              const u32x4_t hq0 = *(const u32x4_t*)hp_, hq1 = *(const u32x4_t*)(hp_ + 8); \
              const u32 hw[8] = {hq0.x, hq0.y, hq0.z, hq0.w, hq1.x, hq1.y, hq1.z, hq1.w}; \
              _Pragma("unroll") for (int q = 0; q < 8; ++q) { hv[2 * q] = __uint_as_float(hw[q] << 16); hv[2 * q + 1] = __uint_as_float(hw[q] & 0xffff0000u); } } \
            u32x4_t wA[8], wB[8]; \
            UV_LOAD(wA, TG_, 0); \
            UV_LOAD(wB, TG_, 1);  UV_DOT(wA, TG_, 0);  UV_LOAD(wA, TG_, 2);  UV_DOT(wB, TG_, 1); \
            UV_LOAD(wB, TG_, 3);  UV_DOT(wA, TG_, 2);  UV_LOAD(wA, TG_, 4);  UV_DOT(wB, TG_, 3); \
            UV_LOAD(wB, TG_, 5);  UV_DOT(wA, TG_, 4);  UV_LOAD(wA, TG_, 6);  UV_DOT(wB, TG_, 5); \
            UV_LOAD(wB, TG_, 7);  UV_DOT(wA, TG_, 6);  UV_LOAD(wA, TG_, 8);  UV_DOT(wB, TG_, 7); \
            UV_LOAD(wB, TG_, 9);  UV_DOT(wA, TG_, 8);  UV_LOAD(wA, TG_, 10); UV_DOT(wB, TG_, 9); \
            UV_LOAD(wB, TG_, 11); UV_DOT(wA, TG_, 10); UV_LOAD(wA, TG_, 12); UV_DOT(wB, TG_, 11); \
            UV_LOAD(wB, TG_, 13); UV_DOT(wA, TG_, 12); UV_LOAD(wA, TG_, 14); UV_DOT(wB, TG_, 13); \
            UV_LOAD(wB, TG_, 15); UV_DOT(wA, TG_, 14); UV_DOT(wB, TG_, 15); } while (0)
#pragma unroll 1
        for (int s_ = 0; s_ < 8; ++s_) {
            asm volatile("" : "+v"(lane_u));
            const int ju = lane_u >> 3, du = lane_u & 7;
            const unsigned char* ub_ = U8 + (size_t)s_ * NEXP * 128;
            UV_TG(0);
            UV_TG(1);
        }
#undef UV_TG
#undef UV_LOAD
#undef UV_DOT
    }
#pragma unroll 1
    for (int i0 = 0; i0 < 16; i0 += 4) {
        float su_[8], sv_[8], gt_[8], zs_[4];
#pragma unroll
        for (int q = 0; q < 8; ++q) { const int i = i0 + (q >> 1), k = lane + 64 * (q & 1), e = ei[i * 128 + k]; su_[q] = SU[e]; sv_[q] = SV[e]; gt_[q] = GATE[(size_t)(tw + i) * 128 + k]; }
#pragma unroll
        for (int q = 0; q < 4; ++q) zs_[q] = rsqrtf(rss1[tw + i0 + q] * (1.f / DM) + 1e-6f);
#pragma unroll
        for (int q = 0; q < 8; ++q) { const int i = i0 + (q >> 1), k = lane + 64 * (q & 1);
            const float z = zp[i * 128 + k] * zs_[q >> 1] * su_[q];
            zp[i * 128 + k] = gelu_as(z) * gt_[q] * sv_[q]; }
    }
    const int j = lane >> 3, d = lane & 7;
#define V_LOAD(W_, st_) do { const int eb_ = (st_) & 15, tg_ = ((st_) >> 4) & 1, s_ = (st_) >> 5; const unsigned char* vb_ = V8 + (size_t)s_ * NEXP * 128; \
        _Pragma("unroll") for (int q = 0; q < 2; ++q) { const u32x4_t ev_ = *(const LAS u32x4_t*)(ei + (8 * tg_ + j) * 128 + 8 * eb_ + 4 * q); \
            W_[4 * q] = *(const u32x4_t*)(vb_ + (ev_.x * 128u + (unsigned)(16 * d))); W_[4 * q + 1] = *(const u32x4_t*)(vb_ + (ev_.y * 128u + (unsigned)(16 * d))); \
            W_[4 * q + 2] = *(const u32x4_t*)(vb_ + (ev_.z * 128u + (unsigned)(16 * d))); W_[4 * q + 3] = *(const u32x4_t*)(vb_ + (ev_.w * 128u + (unsigned)(16 * d))); } } while (0)
#define V_FMA(W_, st_) do { const int eb_ = (st_) & 15, tg_ = ((st_) >> 4) & 1; \
        float a_[8]; \
        _Pragma("unroll") for (int q = 0; q < 2; ++q) { const f32x4_t av_ = *(const LAS f32x4_t*)(zp + (8 * tg_ + j) * 128 + 8 * eb_ + 4 * q); a_[4 * q] = av_[0]; a_[4 * q + 1] = av_[1]; a_[4 * q + 2] = av_[2]; a_[4 * q + 3] = av_[3]; } \
        _Pragma("unroll") for (int k = 0; k < 8; ++k) { const u32 ww_[4] = {W_[k].x, W_[k].y, W_[k].z, W_[k].w}; \
            _Pragma("unroll") for (int q = 0; q < 4; ++q) { \
                const f32x2_t lo_ = __builtin_amdgcn_cvt_pk_f32_fp8((int)ww_[q], false), hi_ = __builtin_amdgcn_cvt_pk_f32_fp8((int)ww_[q], true); \
                o_[4 * q] = fmaf(a_[k], lo_[0], o_[4 * q]); o_[4 * q + 1] = fmaf(a_[k], lo_[1], o_[4 * q + 1]); o_[4 * q + 2] = fmaf(a_[k], hi_[0], o_[4 * q + 2]); o_[4 * q + 3] = fmaf(a_[k], hi_[1], o_[4 * q + 3]); } } } while (0)
#define V_HBLD(sg_) do { const int tg_ = (sg_) & 1, s_ = (sg_) >> 1; const bf16_t* hb_ = HB + (size_t)(tw + 8 * tg_ + j) * DM + 128 * s_ + 16 * d; \
        hbA_ = *(const u32x4_t*)hb_; hbB_ = *(const u32x4_t*)(hb_ + 8); } while (0)
#define V_FIN(sg_) do { const int tg_ = (sg_) & 1, s_ = (sg_) >> 1, i_ = 8 * tg_ + j, t_ = tw + i_; \
        bf16_t* hb_ = HB + (size_t)t_ * DM + 128 * s_ + 16 * d; \
        { \
            const u32 gw_[8] = {hbA_.x, hbA_.y, hbA_.z, hbA_.w, hbB_.x, hbB_.y, hbB_.z, hbB_.w};        \
            float hv_[16]; \
            _Pragma("unroll") for (int q = 0; q < 8; ++q) { hv_[2 * q] = __uint_as_float(gw_[q] << 16) + o_[2 * q]; hv_[2 * q + 1] = __uint_as_float(gw_[q] & 0xffff0000u) + o_[2 * q + 1]; } \
            *(uint4*)hb_ = pack8(hv_); *(uint4*)(hb_ + 8) = pack8(hv_ + 8); \
            float ss_ = 0.f; \
            _Pragma("unroll") for (int q = 0; q < 16; ++q) ss_ += hv_[q] * hv_[q]; \
            ss_ += __shfl_xor(ss_, 1); ss_ += __shfl_xor(ss_, 2); ss_ += __shfl_xor(ss_, 4); \
            if (d == 0) ssl[i_] += ss_; } \
        _Pragma("unroll") for (int q = 0; q < 16; ++q) o_[q] = 0.f; } while (0)
    {
        u32x4_t wA[8], wB[8], hbA_, hbB_; float o_[16];
#pragma unroll
        for (int q = 0; q < 16; ++q) o_[q] = 0.f;
        V_LOAD(wA, 0);
#pragma unroll 1
        for (int sg = 0; sg < 16; ++sg) {
            V_HBLD(sg);
#pragma unroll 1
            for (int eb = 0; eb < 16; eb += 2) {
                const int st = sg * 16 + eb;
                V_LOAD(wB, st + 1);
                V_FMA(wA, st);
                V_LOAD(wA, (st + 2 < 256 ? st + 2 : 255));
                V_FMA(wB, st + 1);
            }
            V_FIN(sg);
        }
    }
#undef V_LOAD
#undef V_FMA
#undef V_FIN
#undef V_HBLD
    if (lane < 16) rss2[tw + lane] = ssl[lane];
}
#define XB_TMO      128
#define XB_XCNT(j)  (256  + 64 * (j))
#define XB_XSUB(j)  (1280 + 64 * (j))
#define XB_XGEN(j)  (2304 + 64 * (j))
#define XB_TOP      3328
#define XB_TOPGEN   3392
#define XCD_BAR_WORDS 3456
#define XB_SPIN_CAP (1u << 28)
__device__ __forceinline__ unsigned xb_ld(unsigned* p)              { return __hip_atomic_load(p, __ATOMIC_RELAXED, __HIP_MEMORY_SCOPE_AGENT); }
__device__ __forceinline__ unsigned xb_add(unsigned* p, unsigned v) { return __hip_atomic_fetch_add(p, v, __ATOMIC_RELAXED, __HIP_MEMORY_SCOPE_AGENT); }
__device__ __forceinline__ unsigned xb_xcc_id() { return (unsigned)__builtin_amdgcn_s_getreg((3 << 11) | 20) & 0xFu; }
#define XB_SPIN(cond, bar) do { unsigned _sp = 0; while (cond) { __builtin_amdgcn_s_sleep(1); \
    if ((++_sp & 255u) == 0u) { if (xb_ld(&(bar)[XB_TMO])) break; if (_sp > XB_SPIN_CAP) { atomicAdd(&(bar)[XB_TMO], 1u); break; } } } } while (0)
struct XcdBarrier { unsigned* bar; unsigned x; volatile LAS unsigned* st; };
__device__ __forceinline__ XcdBarrier xcd_barrier_post(unsigned* bar, volatile LAS unsigned* st) {
    XcdBarrier b; b.bar = bar; b.x = xb_xcc_id(); b.st = st;
    if (threadIdx.x == 0) (void)xb_add(&bar[XB_XCNT(b.x)], 1u);
    return b;
}
__device__ __forceinline__ void xcd_barrier_complete(unsigned* bar, unsigned x, unsigned& nloc, unsigned& nx) {
    const unsigned G = gridDim.x * gridDim.y * gridDim.z;
    unsigned sum, cnt, mine, sp = 0u;
    for (;;) {
        sum = 0u; cnt = 0u; mine = 0u;
#pragma unroll
        for (unsigned j = 0; j < 16; ++j) { const unsigned c = xb_ld(&bar[XB_XCNT(j)]); sum += c; cnt += (c > 0u) ? 1u : 0u; mine = (j == x) ? c : mine; }
        if (sum == G) break;
        __builtin_amdgcn_s_sleep(1);
        if ((++sp & 255u) == 0u) { if (xb_ld(&bar[XB_TMO])) break; if (sp > XB_SPIN_CAP) { atomicAdd(&bar[XB_TMO], 1u); break; } }
    }
    nloc = mine > 0u ? mine : 1u; nx = cnt > 0u ? cnt : 1u;
}
__device__ __forceinline__ void xcd_barrier(const XcdBarrier& b) {
    asm volatile("s_waitcnt vmcnt(0)" ::: "memory");
    __syncthreads();
    if (threadIdx.x == 0) {
        unsigned* bar = b.bar;
        __builtin_amdgcn_s_waitcnt(0);
        unsigned nloc = b.st[0], nx = b.st[1];
        if (nloc == 0u) { xcd_barrier_complete(bar, b.x, nloc, nx); b.st[0] = nloc; b.st[1] = nx; }
        const unsigned old = xb_add(&bar[XB_XSUB(b.x)], 1u);
        const unsigned gen = old / nloc;
        if (old + 1u == (gen + 1u) * nloc) {
            __builtin_amdgcn_fence(__ATOMIC_RELEASE, "agent");
            asm volatile("s_waitcnt vmcnt(0)" ::: "memory");
            const unsigned og = xb_add(&bar[XB_TOP], 1u);
            const unsigned tg = og / nx;
            if (og + 1u == (tg + 1u) * nx) xb_add(&bar[XB_TOPGEN], 1u);
            else XB_SPIN(xb_ld(&bar[XB_TOPGEN]) == tg, bar);
            __builtin_amdgcn_fence(__ATOMIC_ACQUIRE, "agent");
            xb_add(&bar[XB_XGEN(b.x)], 1u);
            asm volatile("s_waitcnt vmcnt(0)" ::: "memory");
        } else {
            XB_SPIN(xb_ld(&bar[XB_XGEN(b.x)]) == gen, bar);
            __builtin_amdgcn_fence(__ATOMIC_ACQUIRE, "agent");
            asm volatile("s_waitcnt vmcnt(0)" ::: "memory");
        }
    }
    __syncthreads();
}

constexpr int NTHR = 512;
constexpr int LDS_BYTES = 147456;
constexpr int LDS_MISC = 147456 - 256;
constexpr size_t CTL_BAR_OFF = 65536;
struct Args { const float* in[21]; float* out; unsigned char* ws; };

__global__ void __launch_bounds__(NTHR, 2) mega_fwd(Args a) {
    extern __shared__ __attribute__((aligned(16))) unsigned char lds[];
    const float* x = a.in[0]; const float* p = a.in[1]; const float* attn_norm = a.in[2]; const float* w_in = a.in[3];
    const float* lq1 = a.in[4]; const float* lk1 = a.in[5]; const float* lq2 = a.in[6]; const float* lk2 = a.in[7];
    const float* subln = a.in[8]; const float* w_out = a.in[9]; const float* rel_bias = a.in[10]; const float* ffn_norm = a.in[11];
    const float* peer_query = a.in[12]; const float* peer_subkeys = a.in[13]; const float* peer_u = a.in[14]; const float* peer_v = a.in[15];
    const float* ple_norm = a.in[16]; const float* ple_gate_w = a.in[17]; const float* ple_gate_b = a.in[18]; const float* ple_proj = a.in[19];
    const float* final_norm = a.in[20];
    unsigned char* ws = a.ws;
    float* H = a.out;
    float* ctl = (float*)(ws + WS_CTL); float* rss = (float*)(ws + WS_RSS); float* cs = (float*)(ws + WS_CS);
    float* rss1 = rss, *rss2 = rss + 32768, *rss3 = rss + 65536;
    bf16_t* WIN = (bf16_t*)(ws + WS_WIN); bf16_t* WOUT = (bf16_t*)(ws + WS_WOUT); bf16_t* WQ = (bf16_t*)(ws + WS_WQ); bf16_t* WG = (bf16_t*)(ws + WS_WG); bf16_t* WP = (bf16_t*)(ws + WS_WP);
    bf16_t* SUBK = (bf16_t*)(ws + WS_SUBK); bf16_t* U = (bf16_t*)(ws + WS_U); bf16_t* Vt = (bf16_t*)(ws + WS_V);
    bf16_t* XN = (bf16_t*)(ws + WS_XN); bf16_t* HB = XN; bf16_t* PB = (bf16_t*)(ws + WS_PB);
    bf16_t* Q = (bf16_t*)(ws + WS_Q); bf16_t* Kb = (bf16_t*)(ws + WS_K); bf16_t* VV = (bf16_t*)(ws + WS_VV);
    bf16_t* RQ = (bf16_t*)(ws + WS_RQ); bf16_t* RK = (bf16_t*)(ws + WS_RK); bf16_t* RV = (bf16_t*)(ws + WS_RV); bf16_t* RG = (bf16_t*)(ws + WS_RG);
    bf16_t* QRY = (bf16_t*)(ws + WS_QRY); int* IDX = (int*)(ws + WS_IDX); float* GATE = (float*)(ws + WS_GATE);
    bf16_t* MIX = (bf16_t*)(ws + WS_MIX); bf16_t* PP = MIX;
    float* RAWROT = (float*)(ws + WS_MIX);

    const int G = gridDim.x, bx = blockIdx.x, wave_s = __builtin_amdgcn_readfirstlane(threadIdx.x >> 6), gn = G * NTHR;
#define TIDS() const int lane = lane_id(), wave = wave_s, t512 = wave_s * 64 + lane, half = wave_s >> 2, tid = t512 & 255, gtid = bx * NTHR + t512; (void)gtid; (void)tid; (void)wave; (void)half
#define sm ((char*)lds + half * 65536)
    volatile LAS unsigned* misc = (volatile LAS unsigned*)((LAS unsigned char*)lds + LDS_MISC);
    if (threadIdx.x < 64) misc[threadIdx.x] = 0u;
    __syncthreads();
    XcdBarrier bar = xcd_barrier_post((unsigned*)(ws + WS_CTL + CTL_BAR_OFF), misc + 8);
#define VLOOP(NBLK) for (int base_ = 2 * bx, bid = base_ + half; base_ < (NBLK); base_ += 2 * G, bid = base_ + half)
#define GRID_BAR() xcd_barrier(bar)

#define GEMM_PHASE(EPI, A_, B_, N_, K_, ...) do { int k_ = K_; asm volatile("" : "+s"(k_)); pg8::Gemm g_{A_, B_, M, N_, k_}; pg8::StaticOrder S_; S_.init(M, N_, G, bx); EpiRow8<EPI> E_{EPI{__VA_ARGS__}}; \
        pg8::gemm_phase<EpiRow8<EPI>, pg8::StaticOrder, true, true>((PG8_LAS unsigned char*)lds, g_, S_, E_, wave_s * 64 + lane_id()); } while (0)
    {   TIDS();
    for (int g = gtid; g < 4096 * 32; g += gn) b_tables(g, lq1, lk1, lq2, lk2, rel_bias, ctl, cs);
    {
        LAS float* scr = (LAS float*)((LAS unsigned char*)lds + wave * 16384);
        const int gw = bx * 8 + wave, ngw = G * 8;
        constexpr int I1 = (DM / 64) * (INW / 32), I2 = (DM / 64) * (DM / 32), I3 = (DM / 64) * (2048 / 32), I4 = I2, I5 = (256 / 64) * (DM / 32);
        for (int it = gw; it < I1 + I2 + I3 + I4 + I5; it += ngw) {
            int q = it;
            if (q < I1) { wave_transpose_item<true>(w_in, DM, INW, WIN, nullptr, scr, q, lane); continue; } q -= I1;
            if (q < I2) { wave_transpose_item<false>(w_out, DM, DM, WOUT, nullptr, scr, q, lane); continue; } q -= I2;
            if (q < I3) { wave_transpose_item<false>(peer_query, DM, 2048, WQ, ffn_norm, scr, q, lane); continue; } q -= I3;
            if (q < I4) { wave_transpose_item<false>(ple_gate_w, DM, DM, WG, ple_norm, scr, q, lane); continue; } q -= I4;
            wave_transpose_item<false>(ple_proj, 256, DM, WP, nullptr, scr, q, lane);
        }
    }
    b_convert(gtid, gn, peer_subkeys, SUBK, (size_t)16 * 128 * 128 / 4, nullptr, 1024);
    for (int row = bx * 8 + wave; row < NEXP; row += G * 8) { b_rowquant(row, lane, peer_u, ffn_norm, (unsigned char*)U, (float*)(ws + WS_SU)); b_rowquant(row, lane, peer_v, nullptr, (unsigned char*)Vt, (float*)(ws + WS_SV)); }
    b_convert(gtid, gn, p, PB, (size_t)M * 256 / 4, nullptr, 256);
    for (int row = bx * 8 + wave; row < M; row += G * 8) b_rmsnorm_bf16(row, lane, x, attn_norm, XN, 1e-6f);
    }
    GRID_BAR();
    { int k_ = DM; asm volatile("" : "+s"(k_)); pg8::Gemm g_{XN, WIN, M, INW, k_}; pg8::StaticOrder S_; S_.init(M, INW, G, bx); EpiInProjT E_{ws, cs};
      pg8::gemm_phase<EpiInProjT, pg8::StaticOrder, true, true>((PG8_LAS unsigned char*)lds, g_, S_, E_, wave_s * 64 + lane_id()); }
    GRID_BAR();
    {
        const int vcu = (G & 7) ? bx : (bx & 7) * (G >> 3) + (bx >> 3);
        bf16_t* RKT = (bf16_t*)(ws + WS_RKT); float* KVT = (float*)(ws + WS_KVT); bf16_t* ST = (bf16_t*)(ws + WS_ST);
        { TIDS(); for (int u = vcu; u < BATCH * 4 * 32; u += G) ret_kv_unit(t512, u >> 5, u & 31, RV, RKT, KVT); }
        GRID_BAR();
        { TIDS(); for (int e = gtid; e < BATCH * 4 * 8192; e += gn) ret_scan(e, KVT, ST);
        for (int v = vcu; v < 256; v += G) {
            const int bh = v >> 3, sidx = v & 7;
#pragma unroll 1
            for (int i = 0; i < 4; ++i) {
                const int qb = (i == 0) ? 31 - sidx : (i == 1) ? 16 + sidx : (i == 2) ? 15 - sidx : sidx;
                attn_unit<0>((LAS unsigned char*)lds, t512, bh >> 2, bh & 3, qb, Q, Kb, VV, ctl, subln, MIX);
            }
        }
#ifdef ATT_PROBE
        for (int v = vcu; v < 256; v += G) {
            const int bh = v >> 3, sidx = v & 7;
#pragma unroll 1
            for (int i = 0; i < 4; ++i) {
                const int qb = (i == 0) ? 31 - sidx : (i == 1) ? 16 + sidx : (i == 2) ? 15 - sidx : sidx;
                attn_unit<ATT_PROBE>((LAS unsigned char*)lds, t512, bh >> 2, bh & 3, qb, Q, Kb, VV, ctl, subln, MIX);
            }
        }
#endif
        }
        GRID_BAR();
        { TIDS(); ret_out_units((LAS unsigned char*)lds, t512, vcu, G, BATCH * 4 * 32, RQ, RK, RV, ST, RG, MIX); __syncthreads(); }
    }
    GRID_BAR();
    GEMM_PHASE(EpiOutProj, MIX, WOUT, DM, DM, x, H, HB, rss1);
    GRID_BAR();
    GEMM_PHASE(EpiQry, HB, WQ, 2048, DM, QRY, rss1);
    GRID_BAR();
    {   TIDS();
        const int head = bx & 7, nw = G >> 3, wq = bx >> 3;
        __syncthreads();
        for (int c16 = t512; c16 < 2 * 128 * 16; c16 += NTHR) { const int row = c16 >> 4, ch = c16 & 15;
            *(LAS u32x4_t*)((LAS unsigned char*)lds + row * SKROW + 16 * ch) = *(const u32x4_t*)(SUBK + ((size_t)head * 256 + row) * 128 + 8 * ch); }
        __syncthreads();
        {   bf16x8_t qf[8]; int tb = wq + nw * wave;
            { const bf16_t* q0 = QRY + (size_t)((tb < M / 32 ? tb : 0) * 32 + (lane & 31)) * 2048 + head * 256 + 8 * (lane >> 5);
#pragma unroll
              for (int ks = 0; ks < 8; ++ks) qf[ks] = *(const bf16x8_t*)(q0 + 16 * ks); }
#pragma unroll 1
            for (; tb < M / 32; tb += nw * 8) { const int tn = tb + nw * 8 < M / 32 ? tb + nw * 8 : tb;
                peer_topk_unit(lane, tb * 32, tn * 32, head, QRY, qf, (const LAS unsigned char*)lds, (LAS unsigned char*)lds + 2 * 128 * SKROW + wave * (32 * 144), IDX, GATE); } }
        __syncthreads();
    }
    GRID_BAR();
    {   TIDS(); __syncthreads(); for (int tb = bx; tb < M / 128; tb += G) peer_sliced((LAS unsigned char*)lds, lane, wave, tb * 128, (const unsigned char*)U, (const unsigned char*)Vt, (const float*)(ws + WS_SU), (const float*)(ws + WS_SV), (const unsigned char*)(ws + WS_HB8), (const float*)(ws + WS_SH), IDX, GATE, H, HB, rss1, rss2); __syncthreads(); }
    GRID_BAR();
    GEMM_PHASE(EpiPP, PB, WP, DM, 256, PP);
    asm volatile("s_waitcnt vmcnt(0)" ::: "memory"); __syncthreads();
    GEMM_PHASE(EpiGate, HB, WG, DM, DM, HB, PP, ple_gate_b, rss2, rss3, QRY);
    GRID_BAR();
    {   TIDS(); for (size_t g = gtid; g < (size_t)M * DM / 8; g += gn) b_final(g, QRY, H, rss3, final_norm); }
}

extern "C" void kernel_launch(void* const* d_in, const int* in_sizes, int n_in, void* d_out, int out_size, void* d_ws, size_t ws_size, hipStream_t stream) {
    static int grid = 0;
    if (grid == 0) {
        int dev = 0, cus = 0;
        if (n_in != 21 || out_size != M * DM || ws_size < WS_END) { fprintf(stderr, "kernel_launch: unexpected problem shape (n_in %d out %d ws %zu)\n", n_in, out_size, ws_size); grid = -1; return; }
        if (hipGetDevice(&dev) != hipSuccess || hipDeviceGetAttribute(&cus, hipDeviceAttributeMultiprocessorCount, dev) != hipSuccess) { grid = -1; return; }
        if (hipFuncSetAttribute((const void*)mega_fwd, hipFuncAttributeMaxDynamicSharedMemorySize, LDS_BYTES) != hipSuccess) { fprintf(stderr, "kernel_launch: hipFuncSetAttribute failed\n"); grid = -1; return; }
        int per_cu = 0;
        if (hipOccupancyMaxActiveBlocksPerMultiprocessor(&per_cu, (const void*)mega_fwd, NTHR, LDS_BYTES) != hipSuccess || per_cu < 1) { fprintf(stderr, "kernel_launch: occupancy query says %d\n", per_cu); }
        (void)hipGetLastError();
        grid = cus;
    }
    if (grid < 0) return;
    if (hipMemsetAsync((char*)d_ws, 0, WS_RSS + 3 * 32768 * 4, stream) != hipSuccess) return;
    Args a{};
    for (int i = 0; i < 21; ++i) a.in[i] = (const float*)d_in[i];
    a.out = (float*)d_out; a.ws = (unsigned char*)d_ws;
    hipLaunchKernelGGL(mega_fwd, dim3(grid), dim3(NTHR), LDS_BYTES, stream, a);
}
```

```cpp
#include <hip/hip_runtime.h>
#include <cstdint>
#include <cstdio>

typedef unsigned short bf16_t;
typedef unsigned int u32;
#define LAS __attribute__((address_space(3)))

constexpr int BATCH = 8, SEQ = 4096, DM = 1024, M = BATCH * SEQ;
constexpr int INW = 3072;
constexpr int NEXP = 16384;
constexpr float LOG2E = 1.4426950408889634f;
constexpr float QSCALE = 0.125f * LOG2E;

constexpr size_t MiB = 1u << 20;
constexpr size_t WS_CTL = 0;
constexpr size_t WS_RSS = 1 * MiB;
constexpr size_t WS_CS = 2 * MiB;
constexpr size_t WS_WIN = 4 * MiB;
constexpr size_t WS_WOUT = 10 * MiB;
constexpr size_t WS_WQ = 12 * MiB;
constexpr size_t WS_WG = 16 * MiB;
constexpr size_t WS_WP = 18 * MiB;
constexpr size_t WS_SUBK = 18 * MiB + 512 * 1024;
constexpr size_t WS_U = 20 * MiB;
constexpr size_t WS_V = 52 * MiB;
constexpr size_t WS_XN = 84 * MiB;
constexpr size_t WS_PB = 148 * MiB;
constexpr size_t WS_BIG = 164 * MiB;
constexpr size_t WS_Q = WS_BIG, WS_K = WS_BIG + 32 * MiB, WS_VV = WS_BIG + 64 * MiB;
constexpr size_t WS_RQ = WS_BIG + 96 * MiB, WS_RK = WS_BIG + 112 * MiB, WS_RV = WS_BIG + 128 * MiB, WS_RG = WS_BIG + 160 * MiB;
constexpr size_t WS_QRY = WS_BIG;
constexpr size_t WS_IDX = WS_BIG + 128 * MiB;
constexpr size_t WS_GATE = WS_BIG + 144 * MiB;
constexpr size_t WS_MIX = 356 * MiB;
constexpr size_t WS_RKT = 420 * MiB;
constexpr size_t WS_KVT = 436 * MiB;
constexpr size_t WS_ST = 468 * MiB;
constexpr size_t WS_END = 484 * MiB;
constexpr size_t WS_HB8 = WS_MIX, WS_SH = WS_MIX + 32 * MiB;
constexpr size_t WS_SU = WS_U + 16 * MiB, WS_SV = WS_U + 16 * MiB + 65536;

__device__ __forceinline__ float bf2f(bf16_t v) { return __uint_as_float(((u32)v) << 16); }
__device__ __forceinline__ bf16_t f2bf(float f) { u32 u = __float_as_uint(f); return (bf16_t)((u + 0x7fffu + ((u >> 16) & 1u)) >> 16); }

__device__ __forceinline__ int lane_id() { int l; asm volatile("v_mbcnt_lo_u32_b32 %0, -1, 0\n\tv_mbcnt_hi_u32_b32 %0, -1, %0" : "=v"(l)); return l; }
__device__ __forceinline__ float wave_sum(float v) {
#pragma unroll
    for (int o = 1; o < 64; o <<= 1) v += __shfl_xor(v, o);
    return v;
}
__device__ __forceinline__ float wave_max(float v) {
#pragma unroll
    for (int o = 1; o < 64; o <<= 1) v = fmaxf(v, __shfl_xor(v, o));
    return v;
}

__host__ __device__ __forceinline__ int rot_dst_row(int n);
template <bool ROT> __device__ __forceinline__ void b_transpose_wt(int bid, int tid, char* sm, const float* __restrict__ W, int K, int N, bf16_t* __restrict__ WT, const float* __restrict__ gain) {
    float (*t)[33] = (float (*)[33])sm;
    const int nbx = N / 32; const int k0 = (bid / nbx) * 32, n0 = (bid % nbx) * 32, tx = tid & 31, ty = tid >> 5;
    __syncthreads();
    for (int i = ty; i < 32; i += 8) { float g = gain ? gain[k0 + i] : 1.f; t[i][tx] = W[(size_t)(k0 + i) * N + n0 + tx] * g; }
    __syncthreads();
    for (int i = ty; i < 32; i += 8) WT[(size_t)(ROT ? rot_dst_row(n0 + i) : (n0 + i)) * K + k0 + tx] = f2bf(t[tx][i]);
}
__device__ __forceinline__ void b_transpose_w(int bid, int tid, char* sm, const float* __restrict__ W, int K, int N, bf16_t* __restrict__ WT, const float* __restrict__ gain) {
    float (*t)[33] = (float (*)[33])sm;
    const int nbx = N / 32; const int k0 = (bid / nbx) * 32, n0 = (bid % nbx) * 32, tx = tid & 31, ty = tid >> 5;
    __syncthreads();
    for (int i = ty; i < 32; i += 8) { float g = gain ? gain[k0 + i] : 1.f; t[i][tx] = W[(size_t)(k0 + i) * N + n0 + tx] * g; }
    __syncthreads();
    for (int i = ty; i < 32; i += 8) WT[(size_t)(n0 + i) * K + k0 + tx] = f2bf(t[tx][i]);
}
__device__ __forceinline__ void b_convert(int gtid, int gn, const float* __restrict__ in, bf16_t* __restrict__ out, size_t n4, const float* __restrict__ gain, int period) {
    for (size_t i = (size_t)gtid; i < n4; i += (size_t)gn) {
        float4 v = ((const float4*)in)[i];
        if (gain) { const int c = (int)((i * 4) % period); v.x *= gain[c]; v.y *= gain[c + 1]; v.z *= gain[c + 2]; v.w *= gain[c + 3]; }
        ushort4 o; o.x = f2bf(v.x); o.y = f2bf(v.y); o.z = f2bf(v.z); o.w = f2bf(v.w);
        ((ushort4*)out)[i] = o;
    }
}
__device__ __forceinline__ void b_rmsnorm_bf16(int row, int lane, const float* __restrict__ x, const float* __restrict__ gain, bf16_t* __restrict__ out, float eps) {
    const float4* xr = (const float4*)(x + (size_t)row * DM);
    float4 v[4]; float s = 0.f;
#pragma unroll
    for (int j = 0; j < 4; ++j) { v[j] = xr[lane + 64 * j]; s += v[j].x * v[j].x + v[j].y * v[j].y + v[j].z * v[j].z + v[j].w * v[j].w; }
    s = wave_sum(s);
    const float r = rsqrtf(s * (1.f / DM) + eps);
#pragma unroll
    for (int j = 0; j < 4; ++j) {
        const float4 g = ((const float4*)gain)[lane + 64 * j];
        ushort4 o; o.x = f2bf(v[j].x * r * g.x); o.y = f2bf(v[j].y * r * g.y); o.z = f2bf(v[j].z * r * g.z); o.w = f2bf(v[j].w * r * g.w);
        ((ushort4*)(out + (size_t)row * DM))[lane + 64 * j] = o;
    }
}
__device__ __forceinline__ void sincos_acc(float ang, float& s, float& c) {
    const double x = (double)ang;
    const double k = rint(x * 0.63661977236758134308);
    double r = fma(-k, 1.57079632679489655800, x); r = fma(-k, 6.12323399573676603587e-17, r);
    const double r2 = r * r;
    double sp = r * (1.0 + r2 * (-1.0 / 6 + r2 * (1.0 / 120 + r2 * (-1.0 / 5040 + r2 * (1.0 / 362880 + r2 * (-1.0 / 39916800 + r2 * (1.0 / 6227020800.0)))))));
    double cp = 1.0 + r2 * (-0.5 + r2 * (1.0 / 24 + r2 * (-1.0 / 720 + r2 * (1.0 / 40320 + r2 * (-1.0 / 3628800 + r2 * (1.0 / 479001600.0 + r2 * (-1.0 / 87178291200.0)))))));
    const int q = ((int)(long long)k) & 3;
    double ss, cc;
    if (q == 0) { ss = sp; cc = cp; } else if (q == 1) { ss = cp; cc = -sp; } else if (q == 2) { ss = -sp; cc = -cp; } else { ss = -cp; cc = sp; }
    s = (float)ss; c = (float)cc;
}
__device__ __forceinline__ void b_tables(int gid, const float* lq1, const float* lk1, const float* lq2, const float* lk2, const float* __restrict__ rel_bias,
                                                float* __restrict__ ctl, float* __restrict__ cs) {
    if (gid == 0) {
        float a = 0.f, b = 0.f;
        for (int i = 0; i < 64; ++i) { a += lq1[i] * lk1[i]; b += lq2[i] * lk2[i]; }
        ctl[0] = expf(a) - expf(b) + 0.2f;
    }
    if (gid < 512) {
        const int h = gid >> 7, n = gid & 127;
        int bucket;
        if (n < 16) bucket = n;
        else { const float nf = (float)n; int lg = 16 + (int)(logf(nf / 16.0f) / 2.0794415416798357f * 16.0f); bucket = lg < 31 ? lg : 31; }
        ctl[64 + h * 128 + n] = rel_bias[bucket * 4 + h] * LOG2E;
    }
    if (gid < 4096 * 32) {
        const int pos = gid >> 5, i = gid & 31;
        const float freq = 1.0f / powf(10000.0f, (float)i / 32.0f);
        const float ang = (float)pos * freq;
        float s, c; sincos_acc(ang, s, c);
        cs[gid] = c; cs[4096 * 32 + gid] = s;
    }
}

namespace pg8 {
#define PG8_LAS __attribute__((address_space(3)))
typedef unsigned short bf16_t;
typedef short bf16x8 __attribute__((ext_vector_type(8)));
typedef float f32x4 __attribute__((ext_vector_type(4)));
typedef unsigned u32x4 __attribute__((ext_vector_type(4)));
constexpr int BM = 256, BK = 64, HALF = 128, HTB = HALF * BK * 2  , STAGE_BYTES = 8 * HTB, NXCD = 8, WGM = 8;

__host__ __device__ __forceinline__ int lds_byte(int r, int c) { const int st = (r >> 4) * 2 + (c >> 5), rr = r & 15, cc = c & 31, ob = rr * 64 + cc * 2; return st * 1024 + (ob ^ (((ob >> 9) & 1) << 5)); }
__host__ __device__ __forceinline__ void stage_rc(int b, int& R, int& C) { const int st = b / 1024, sb = b % 1024, swz = sb ^ (((sb >> 9) & 1) << 5); R = (st >> 1) * 16 + swz / 64; C = (st & 1) * 32 + (swz % 64) / 2; }
__host__ __device__ __forceinline__ int perm32(int rho) { const int n = rho >> 4, i = rho & 15; return 8 * (i >> 2) + 4 * n + (i & 3); }

struct Unit { int pm, pn; };
struct Gemm { const bf16_t* A; const bf16_t* Bt; int M, N, K; };

struct StaticOrder {
    int nM, nN, nwg, G, c;
    __host__ __device__ void init(int M, int N, int G_, int c_) { nM = M / BM; nN = N / BM; nwg = nM * nN; G = G_; c = c_; }
    __host__ __device__ bool next(int i, Unit& u) const {
        const long L = (long)i * G + c; if (L >= nwg) return false;
        int wgid = (int)L; { const int q = nwg / NXCD, r = nwg % NXCD, xcd = wgid % NXCD, off = wgid / NXCD; wgid = (xcd < r ? xcd * (q + 1) : r * (q + 1) + (xcd - r) * q) + off; }
        const int nig = WGM * nN, gid = wgid / nig, fm = gid * WGM, gsz = (nM - fm) < WGM ? (nM - fm) : WGM;
        u.pm = fm + ((wgid % nig) % gsz); u.pn = (wgid % nig) / gsz; return true;
    }
    __device__ __forceinline__ void a_ready(const Unit&) const {}
    __device__ __forceinline__ void done(const Unit&) const {}
};

__device__ __forceinline__ unsigned cvt_pk_bf16(float lo, float hi) { unsigned r; asm volatile("v_cvt_pk_bf16_f32 %0, %1, %2" : "=v"(r) : "v"(lo), "v"(hi)); return r; }
typedef float f32x2 __attribute__((ext_vector_type(2)));
template <class Epi, class Sched, bool ALIGN_EPI = false, bool SP2 = false>
__device__ __forceinline__ void gemm_phase(PG8_LAS unsigned char* lds, const Gemm g, const Sched& S, const Epi& E, const int tid) {
    const int wid = __builtin_amdgcn_readfirstlane(tid >> 6), lane = tid & 63, wr = wid >> 2, wc = wid & 3, fr = lane & 15, fq = lane >> 4;
    const int K = g.K, nt = K / BK;
    unsigned voffA[2], voffB[2];
#pragma unroll
    for (int i = 0; i < 2; ++i) { int R, C; stage_rc(tid * 16 + i * 8192, R, C); const int Rb = Epi::PERM ? ((R & ~31) + perm32(R & 31)) : R;
        voffA[i] = (unsigned)(R * K + C) * 2u; voffB[i] = (unsigned)(Rb * K + C) * 2u; }
    const size_t kstep = (size_t)(BK * 2);
    const size_t hstep = (size_t)HALF * K * 2;
    const size_t tstep = 2 * hstep;
    const unsigned ldsw = (unsigned)wid * 1024u;
    const int aoff = lds_byte(wr * 64 + fr, fq * 8), boff = lds_byte(wc * 32 + fr, fq * 8);
#define PG8_SA(b, h) (((b) * 2 + (h)) * HTB)
#define PG8_SB(b, h) ((4 + (b) * 2 + (h)) * HTB)
#define PG8_STAGE(bufoff, gbase, voff) do { _Pragma("unroll") for (int _i = 0; _i < 2; ++_i) \
        __builtin_amdgcn_global_load_lds((const unsigned*)((const char*)(gbase) + (voff)[_i]), (PG8_LAS unsigned*)(lds + (bufoff) + ldsw + _i * 8192), 16, 0, 0); } while (0)
#define PG8_LDA(dst, b, h) do { _Pragma("unroll") for (int m = 0; m < 4; ++m) _Pragma("unroll") for (int k = 0; k < 2; ++k) dst[m][k] = *(const PG8_LAS bf16x8*)(lds + PG8_SA(b, h) + aoff + m * 2048 + k * 1024); } while (0)
#define PG8_LDB(dst, b, h) do { _Pragma("unroll") for (int n = 0; n < 2; ++n) _Pragma("unroll") for (int k = 0; k < 2; ++k) dst[n][k] = *(const PG8_LAS bf16x8*)(lds + PG8_SB(b, h) + boff + n * 2048 + k * 1024); } while (0)
#define PG8_MMA(ai, bj, At, Bt) do { __builtin_amdgcn_s_setprio(1); _Pragma("unroll") for (int m = 0; m < 4; ++m) _Pragma("unroll") for (int n = 0; n < 2; ++n) _Pragma("unroll") for (int k = 0; k < 2; ++k) \
        acc[ai][bj][m][n] = __builtin_amdgcn_mfma_f32_16x16x32_bf16(Bt[n][k], At[m][k], acc[ai][bj][m][n], 0, 0, 0); __builtin_amdgcn_s_setprio(0); } while (0)
#define PG8_WAIT_V(n) asm volatile("s_waitcnt vmcnt(" #n ")" ::: "memory")
#define PG8_WAIT_L(n) asm volatile("s_waitcnt lgkmcnt(" #n ")" ::: "memory")
#define PG8_BAR __builtin_amdgcn_s_barrier()
#define PG8_SCHED __builtin_amdgcn_sched_barrier(0)
    Unit cur, nxt; int ui = 0;
    if (!S.next(0, cur)) return;
    f32x4 acc[2][2][4][2];
#pragma unroll
    for (int a = 0; a < 2; ++a)
#pragma unroll
        for (int b = 0; b < 2; ++b)
#pragma unroll
            for (int m = 0; m < 4; ++m)
#pragma unroll
                for (int n = 0; n < 2; ++n) acc[a][b][m][n] = (f32x4){0.f, 0.f, 0.f, 0.f};
    bf16x8 At[4][2], B0[2][2], B1[2][2];
    const char* cA = (const char*)g.A + (size_t)cur.pm * tstep; const char* cB = (const char*)g.Bt + (size_t)cur.pn * tstep;
    S.a_ready(cur);
    if constexpr (SP2) {
        PG8_STAGE(PG8_SB(0, 0), cB, voffB); PG8_STAGE(PG8_SB(0, 1), cB + hstep, voffB); PG8_STAGE(PG8_SA(0, 0), cA, voffA); PG8_STAGE(PG8_SA(0, 1), cA + hstep, voffA);
        if (wr == 1) PG8_BAR;
        PG8_WAIT_V(2); PG8_BAR;
        PG8_STAGE(PG8_SB(1, 0), cB + kstep, voffB); PG8_STAGE(PG8_SA(1, 0), cA + kstep, voffA); PG8_STAGE(PG8_SB(1, 1), cB + hstep + kstep, voffB);
        PG8_WAIT_V(6); PG8_BAR;
    } else {
        PG8_STAGE(PG8_SB(0, 0), cB, voffB); PG8_STAGE(PG8_SA(0, 0), cA, voffA); PG8_STAGE(PG8_SB(0, 1), cB + hstep, voffB); PG8_STAGE(PG8_SA(0, 1), cA + hstep, voffA);
        if (wr == 1) PG8_BAR;
        PG8_WAIT_V(4); PG8_BAR;
        PG8_STAGE(PG8_SB(1, 0), cB + kstep, voffB); PG8_STAGE(PG8_SA(1, 0), cA + kstep, voffA); PG8_STAGE(PG8_SB(1, 1), cB + hstep + kstep, voffB);
        PG8_WAIT_V(6); PG8_BAR;
    }
    for (;;) {
        const bool has_next = S.next(ui + 1, nxt);
        const char* nA = has_next ? (const char*)g.A + (size_t)nxt.pm * tstep : cA; const char* nB = has_next ? (const char*)g.Bt + (size_t)nxt.pn * tstep : cB;
        for (int t = 0; t < nt; t += 2) {
            const bool last = (t == nt - 2);
            const char* a1 = cA + (size_t)(t + 1) * kstep;
            const char* a2 = last ? nA : cA + (size_t)(t + 2) * kstep; const char* b2 = last ? nB : cB + (size_t)(t + 2) * kstep;
            const char* a3 = a2 + kstep; const char* b3 = b2 + kstep;
            if (last && has_next) S.a_ready(nxt);
            if constexpr (SP2) {
            PG8_LDB(B0, 0, 0); PG8_LDB(B1, 0, 1); PG8_SCHED; PG8_LDA(At, 0, 0); PG8_STAGE(PG8_SA(1, 1), a1 + hstep, voffA);
            PG8_WAIT_V(8); PG8_WAIT_L(0); PG8_BAR; PG8_MMA(0, 0, At, B0); PG8_MMA(0, 1, At, B1); PG8_BAR; PG8_SCHED;
            PG8_LDA(At, 0, 1); PG8_STAGE(PG8_SB(0, 0), b2, voffB); PG8_STAGE(PG8_SB(0, 1), b2 + hstep, voffB); PG8_STAGE(PG8_SA(0, 0), a2, voffA);
            PG8_WAIT_V(8); PG8_WAIT_L(0); PG8_BAR; PG8_MMA(1, 0, At, B0); PG8_MMA(1, 1, At, B1); PG8_BAR; PG8_SCHED;
            PG8_LDB(B0, 1, 0); PG8_LDB(B1, 1, 1); PG8_SCHED; PG8_LDA(At, 1, 0); PG8_STAGE(PG8_SA(0, 1), a2 + hstep, voffA);
            PG8_WAIT_V(8); PG8_WAIT_L(0); PG8_BAR; PG8_MMA(0, 0, At, B0); PG8_MMA(0, 1, At, B1); PG8_BAR; PG8_SCHED;
            PG8_LDA(At, 1, 1); PG8_STAGE(PG8_SB(1, 0), b3, voffB); PG8_STAGE(PG8_SB(1, 1), b3 + hstep, voffB); PG8_STAGE(PG8_SA(1, 0), a3, voffA);
            PG8_WAIT_V(8); PG8_WAIT_L(0); PG8_BAR; PG8_MMA(1, 0, At, B0); PG8_MMA(1, 1, At, B1); PG8_BAR; PG8_SCHED;
            } else {
            PG8_LDB(B0, 0, 0); PG8_SCHED; PG8_LDA(At, 0, 0); PG8_STAGE(PG8_SA(1, 1), a1 + hstep, voffA);
            PG8_WAIT_L(8); PG8_BAR; PG8_WAIT_L(0); PG8_MMA(0, 0, At, B0); PG8_BAR; PG8_SCHED;
            PG8_LDB(B1, 0, 1); PG8_STAGE(PG8_SB(0, 0), b2, voffB);
            PG8_BAR; PG8_WAIT_L(0); PG8_MMA(0, 1, At, B1); PG8_BAR;
            PG8_LDA(At, 0, 1); PG8_STAGE(PG8_SA(0, 0), a2, voffA);
            PG8_BAR; PG8_WAIT_L(0); PG8_MMA(1, 0, At, B0); PG8_BAR; PG8_SCHED;
            PG8_STAGE(PG8_SB(0, 1), b2 + hstep, voffB);
            PG8_WAIT_V(6); PG8_BAR; PG8_MMA(1, 1, At, B1); PG8_BAR;
            PG8_LDB(B0, 1, 0); PG8_SCHED; PG8_LDA(At, 1, 0); PG8_STAGE(PG8_SA(0, 1), a2 + hstep, voffA);
            PG8_WAIT_L(8); PG8_BAR; PG8_WAIT_L(0); PG8_MMA(0, 0, At, B0); PG8_BAR; PG8_SCHED;
            PG8_LDB(B1, 1, 1); PG8_STAGE(PG8_SB(1, 0), b3, voffB);
            PG8_BAR; PG8_WAIT_L(0); PG8_MMA(0, 1, At, B1); PG8_BAR;
            PG8_LDA(At, 1, 1); PG8_STAGE(PG8_SA(1, 0), a3, voffA);
            PG8_BAR; PG8_WAIT_L(0); PG8_MMA(1, 0, At, B0); PG8_BAR; PG8_SCHED;
            PG8_STAGE(PG8_SB(1, 1), b3 + hstep, voffB);
            PG8_WAIT_V(6); PG8_BAR; PG8_MMA(1, 1, At, B1); PG8_BAR;
            }
        }
        if constexpr (ALIGN_EPI) { if (wr == 0) PG8_BAR; }
        if constexpr (!Epi::AFTER_DRAIN) { E(acc, cur, wr, wc, fr, fq); S.done(cur); }
        if (!has_next) break;
#pragma unroll
        for (int a = 0; a < 2; ++a)
#pragma unroll
            for (int b = 0; b < 2; ++b)
#pragma unroll
                for (int m = 0; m < 4; ++m)
#pragma unroll
                    for (int n = 0; n < 2; ++n) acc[a][b][m][n] = (f32x4){0.f, 0.f, 0.f, 0.f};
        cur = nxt; cA = nA; cB = nB; ++ui;
        if constexpr (ALIGN_EPI) { if (wr == 1) PG8_BAR; }
    }
    PG8_WAIT_V(0);
    if constexpr (!ALIGN_EPI) { if (wr == 0) PG8_BAR; }
    PG8_BAR;
    if constexpr (Epi::AFTER_DRAIN) { E.fused(acc, cur, wr, wc, fr, fq, lds, wid, lane); S.done(cur); }
#undef PG8_SA
#undef PG8_SB
#undef PG8_STAGE
#undef PG8_LDA
#undef PG8_LDB
#undef PG8_MMA
#undef PG8_WAIT_V
#undef PG8_WAIT_L
#undef PG8_BAR
#undef PG8_SCHED
}
}

template <class E> struct EpiRow8 {
    static constexpr bool PERM = true, AFTER_DRAIN = false;
    E e;
    __device__ __forceinline__ void operator()(const pg8::f32x4 (&acc)[2][2][4][2], const pg8::Unit& u, int wr, int wc, int fr, int fq) const {
        const int row0 = u.pm * 256 + wr * 64 + fr, col0 = u.pn * 256 + wc * 32 + 8 * fq;
#pragma unroll
        for (int ai = 0; ai < 2; ++ai)
#pragma unroll
            for (int m = 0; m < 4; ++m) {
                const int row = row0 + ai * 128 + m * 16; float s = 0.f;
#pragma unroll
                for (int bj = 0; bj < 2; ++bj) {
                    const float v[8] = {acc[ai][bj][m][0][0], acc[ai][bj][m][0][1], acc[ai][bj][m][0][2], acc[ai][bj][m][0][3], acc[ai][bj][m][1][0], acc[ai][bj][m][1][1], acc[ai][bj][m][1][2], acc[ai][bj][m][1][3]};
                    s += e.row8(row, col0 + bj * 128, v);
                }
                if (E::ROWSUM) { s += __shfl_xor(s, 16); s += __shfl_xor(s, 32); if (fq == 0) e.rowsum(row, s); }
            }
    }
};
__device__ __forceinline__ uint4 pack8_asm(const float* w) { uint4 o; o.x = pg8::cvt_pk_bf16(w[0], w[1]); o.y = pg8::cvt_pk_bf16(w[2], w[3]); o.z = pg8::cvt_pk_bf16(w[4], w[5]); o.w = pg8::cvt_pk_bf16(w[6], w[7]); return o; }

template <class Epi>
__device__ __forceinline__ void b_gemm(int bid, int tid, char* sm, int nbx, const bf16_t* __restrict__ A, const bf16_t* __restrict__ Bt, int K, const Epi& epi) {
    float (*As)[132] = (float (*)[132])sm;
    float (*Bs)[132] = (float (*)[132])(sm + 16 * 132 * 4);
    const int tx = tid & 15, ty = tid >> 4;
    const int row0 = (bid / nbx) * 128, col0 = (bid % nbx) * 128;
    const int lr = tid >> 1, lk = (tid & 1) * 8;
    const bf16_t* ap = A + (size_t)(row0 + lr) * K + lk;
    const bf16_t* bp = Bt + (size_t)(col0 + lr) * K + lk;
    float acc[8][8];
#pragma unroll
    for (int i = 0; i < 8; ++i)
#pragma unroll
        for (int j = 0; j < 8; ++j) acc[i][j] = 0.f;
    for (int k0 = 0; k0 < K; k0 += 16) {
        const uint4 av = *(const uint4*)(ap + k0), bv = *(const uint4*)(bp + k0);
        __syncthreads();
        const u32 aw[4] = {av.x, av.y, av.z, av.w}, bw[4] = {bv.x, bv.y, bv.z, bv.w};
#pragma unroll
        for (int j = 0; j < 4; ++j) {
            As[lk + 2 * j][lr] = __uint_as_float(aw[j] << 16); As[lk + 2 * j + 1][lr] = __uint_as_float(aw[j] & 0xffff0000u);
            Bs[lk + 2 * j][lr] = __uint_as_float(bw[j] << 16); Bs[lk + 2 * j + 1][lr] = __uint_as_float(bw[j] & 0xffff0000u);
        }
        __syncthreads();
#pragma unroll 2
        for (int k = 0; k < 16; ++k) {
            float a[8], b[8];
            const float4 a0 = *(const float4*)&As[k][ty * 8], a1 = *(const float4*)&As[k][ty * 8 + 4];
            const float4 b0 = *(const float4*)&Bs[k][tx * 8], b1 = *(const float4*)&Bs[k][tx * 8 + 4];
            a[0] = a0.x; a[1] = a0.y; a[2] = a0.z; a[3] = a0.w; a[4] = a1.x; a[5] = a1.y; a[6] = a1.z; a[7] = a1.w;
            b[0] = b0.x; b[1] = b0.y; b[2] = b0.z; b[3] = b0.w; b[4] = b1.x; b[5] = b1.y; b[6] = b1.z; b[7] = b1.w;
#pragma unroll
            for (int i = 0; i < 8; ++i)
#pragma unroll
                for (int j = 0; j < 8; ++j) acc[i][j] = fmaf(a[i], b[j], acc[i][j]);
        }
    }
#pragma unroll
    for (int i = 0; i < 8; ++i) { const float s_ = epi.row8(row0 + ty * 8 + i, col0 + tx * 8, acc[i]); if (Epi::ROWSUM) epi.rowsum(row0 + ty * 8 + i, s_); }
}

struct EpiInProj {
    static constexpr bool ROWSUM = false;
    __device__ __forceinline__ void rowsum(int, float) const {}
    bf16_t *Q, *Kb, *V, *RQ, *RK, *RV, *RG; const float* cs;
    __device__ __forceinline__ float row8(int row, int col, const float* v) const {
        bf16_t* dst; float sc = 1.f; int c = col; bool silu = false;
        if (col < 512) { dst = Q + (size_t)row * 512; sc = QSCALE; }
        else if (col < 1024) { dst = Kb + (size_t)row * 512; c = col - 512; }
        else if (col < 1536) { dst = V + (size_t)row * 512; c = col - 1024; }
        else if (col < 1792) { dst = RQ + (size_t)row * 256; c = col - 1536; }
        else if (col < 2048) { dst = RK + (size_t)row * 256; c = col - 1792; }
        else if (col < 2560) { dst = RV + (size_t)row * 512; c = col - 2048; }
        else { dst = RG + (size_t)row * 512; c = col - 2560; silu = true; }
        const bool rot = (col >= 1536 && col < 2048);
        if (rot) {
            float* raw = rawrot + (size_t)row * 512 + (col - 1536);
#pragma unroll
            for (int j = 0; j < 8; ++j) raw[j] = v[j];
            return 0.f;
        }
        ushort4 o0, o1; float w[8];
#pragma unroll
        for (int j = 0; j < 8; ++j) { float x = v[j] * sc; if (silu) x = x / (1.f + __expf(-x)); w[j] = x; }
        o0.x = f2bf(w[0]); o0.y = f2bf(w[1]); o0.z = f2bf(w[2]); o0.w = f2bf(w[3]); o1.x = f2bf(w[4]); o1.y = f2bf(w[5]); o1.z = f2bf(w[6]); o1.w = f2bf(w[7]);
        *(ushort4*)(dst + c) = o0; *(ushort4*)(dst + c + 4) = o1;
        return 0.f;
    }
    float* rawrot;
};
__device__ __forceinline__ void b_rotary(size_t gid, const float* __restrict__ raw, const float* __restrict__ cs, bf16_t* __restrict__ RQ, bf16_t* __restrict__ RK) {
    const int row = (int)(gid >> 9), c = (int)(gid & 511);
    const int which = c >> 8, cc = c & 255, d = cc & 63, i = d & 31, pos = row & (SEQ - 1);
    const float co = cs[pos * 32 + i], si = cs[4096 * 32 + pos * 32 + i];
    const float* r = raw + (size_t)row * 512 + which * 256 + (cc & ~63);
    const float x1 = r[i], x2 = r[i + 32];
    float o = (d < 32) ? (x1 * co - x2 * si) : (x1 * si + x2 * co);
    if (which) { o *= 0.125f; RK[(size_t)row * 256 + cc] = f2bf(o); } else RQ[(size_t)row * 256 + cc] = f2bf(o);
}

__device__ __forceinline__ void b_mix_naive(int bid, int tid, char* sm, const bf16_t* __restrict__ Q, const bf16_t* __restrict__ Kb, const bf16_t* __restrict__ V,
                                                   const bf16_t* __restrict__ RQ, const bf16_t* __restrict__ RK, const bf16_t* __restrict__ RV, const bf16_t* __restrict__ RG,
                                                   const float* __restrict__ ctl, const float* __restrict__ subln, bf16_t* __restrict__ MIX, int mode) {
    float* q1 = (float*)sm; float* q2 = q1 + 64; float* w = q2 + 64; float* w2 = w + SEQ; float* red = w2 + SEQ; float* part = red + 8;
    const int lane = tid & 63, wid = (tid >> 6) & 3;
    __syncthreads();
    const int h = bid & 3, row = bid >> 2, t = row & (SEQ - 1), rb = row - t;
    if (mode == 0) { if (tid < 64) { q1[tid] = bf2f(Q[(size_t)row * 512 + h * 64 + tid]); q2[tid] = bf2f(Q[(size_t)row * 512 + 256 + h * 64 + tid]); } }
    else { if (tid < 64) q1[tid] = bf2f(RQ[(size_t)row * 256 + h * 64 + tid]); }
    __syncthreads();
    float m1 = -INFINITY, m2 = -INFINITY;
    const float lg = (mode == 1) ? log2f(1.0f - exp2f(-5.0f - (float)h)) : 0.f;
    for (int j = tid; j <= t; j += 256) {
        if (mode == 0) {
            const bf16_t* k1 = Kb + (size_t)(rb + j) * 512 + h * 64; const bf16_t* k2 = k1 + 256;
            float s1 = 0.f, s2 = 0.f;
            for (int d = 0; d < 64; d += 8) {
                const uint4 a = *(const uint4*)(k1 + d), b2 = *(const uint4*)(k2 + d);
                const u32 aw[4] = {a.x, a.y, a.z, a.w}, bw[4] = {b2.x, b2.y, b2.z, b2.w};
#pragma unroll
                for (int e = 0; e < 4; ++e) {
                    s1 += q1[d + 2 * e] * __uint_as_float(aw[e] << 16) + q1[d + 2 * e + 1] * __uint_as_float(aw[e] & 0xffff0000u);
                    s2 += q2[d + 2 * e] * __uint_as_float(bw[e] << 16) + q2[d + 2 * e + 1] * __uint_as_float(bw[e] & 0xffff0000u);
                }
            }
            int dist = t - j; if (dist > 127) dist = 127;
            const float b = ctl[64 + h * 128 + dist];
            s1 += b; s2 += b; w[j] = s1; w2[j] = s2; m1 = fmaxf(m1, s1); m2 = fmaxf(m2, s2);
        } else {
            const bf16_t* k1 = RK + (size_t)(rb + j) * 256 + h * 64;
            float s1 = 0.f;
            for (int d = 0; d < 64; d += 8) {
                const uint4 a = *(const uint4*)(k1 + d);
                const u32 aw[4] = {a.x, a.y, a.z, a.w};
#pragma unroll
                for (int e = 0; e < 4; ++e) s1 += q1[d + 2 * e] * __uint_as_float(aw[e] << 16) + q1[d + 2 * e + 1] * __uint_as_float(aw[e] & 0xffff0000u);
            }
            w[j] = s1 * exp2f((float)(t - j) * lg);
        }
    }
    if (mode == 0) {
        m1 = wave_max(m1); m2 = wave_max(m2);
        if (lane == 0) { red[wid] = m1; red[4 + wid] = m2; }
        __syncthreads();
        m1 = fmaxf(fmaxf(red[0], red[1]), fmaxf(red[2], red[3])); m2 = fmaxf(fmaxf(red[4], red[5]), fmaxf(red[6], red[7]));
        __syncthreads();
        float l1 = 0.f, l2 = 0.f;
        for (int j = tid; j <= t; j += 256) { const float e1 = exp2f(w[j] - m1), e2 = exp2f(w2[j] - m2); w[j] = e1; w2[j] = e2; l1 += e1; l2 += e2; }
        l1 = wave_sum(l1); l2 = wave_sum(l2);
        if (lane == 0) { red[wid] = l1; red[4 + wid] = l2; }
        __syncthreads();
        l1 = red[0] + red[1] + red[2] + red[3]; l2 = red[4] + red[5] + red[6] + red[7];
        const float lam = ctl[0];
        const float i1 = 1.f / l1, i2 = lam / l2;
        for (int j = tid; j <= t; j += 256) w[j] = w[j] * i1 - w2[j] * i2;
    }
    __syncthreads();
    const bf16_t* vs = (mode == 0 ? V : RV) + (size_t)rb * 512 + h * 128 + (tid & 127);
    float acc = 0.f;
    for (int j = (tid >> 7); j <= t; j += 2) acc += w[j] * bf2f(vs[(size_t)j * 512]);
    if (tid >= 128) part[tid - 128] = acc;
    __syncthreads();
    float o = 0.f, ss = 0.f;
    if (tid < 128) { o = acc + part[tid]; ss = o * o; }
    ss = wave_sum(ss);
    if (lane == 0) red[wid] = ss;
    __syncthreads();
    if (tid < 128) {
        const float tot = red[0] + red[1];
        float r;
        if (mode == 0) { r = o * rsqrtf(tot * (1.f / 128) + 1e-5f) * subln[tid] * 0.8f; MIX[(size_t)row * DM + h * 128 + tid] = f2bf(r); }
        else { r = o * rsqrtf(tot * (1.f / 128) + 1e-6f) * bf2f(RG[(size_t)row * 512 + h * 128 + tid]); MIX[(size_t)row * DM + 512 + h * 128 + tid] = f2bf(r); }
    }
}

typedef float f32x2c_t __attribute__((ext_vector_type(2)));
typedef __bf16 bf16x2c_t __attribute__((ext_vector_type(2)));
__device__ __forceinline__ u32 pk2f(float lo, float hi) { const f32x2c_t v = {lo, hi}; return __builtin_bit_cast(u32, __builtin_convertvector(v, bf16x2c_t)); }
__device__ __forceinline__ uint4 pack8(const float* w) { uint4 o; o.x = pk2f(w[0], w[1]); o.y = pk2f(w[2], w[3]); o.z = pk2f(w[4], w[5]); o.w = pk2f(w[6], w[7]); return o; }
template <bool ROT> __device__ __forceinline__ void wave_transpose_item(const float* __restrict__ W, int K, int N, bf16_t* __restrict__ WT, const float* __restrict__ gain, LAS float* scr, int item, int lane) {
    const int nblk = N / 32, kb = item / nblk, nb = item % nblk, k0 = 64 * kb, n0 = 32 * nb;
#pragma unroll 8
    for (int i = 0; i < 32; ++i) { const int kk = 2 * i + (lane >> 5); const float g = gain ? gain[k0 + kk] : 1.f; scr[kk * 33 + (lane & 31)] = W[(size_t)(k0 + kk) * N + n0 + (lane & 31)] * g; }
    asm volatile("s_waitcnt lgkmcnt(0)" ::: "memory");
    const int c = lane & 7;
#pragma unroll
    for (int j = 0; j < 4; ++j) { const int n = (lane >> 3) + 8 * j; const LAS float* sp = scr + (8 * c) * 33 + n;
        uint4 o; o.x = pk2f(sp[0 * 33], sp[1 * 33]); o.y = pk2f(sp[2 * 33], sp[3 * 33]); o.z = pk2f(sp[4 * 33], sp[5 * 33]); o.w = pk2f(sp[6 * 33], sp[7 * 33]);
        *(uint4*)(WT + (size_t)(ROT ? rot_dst_row(n0 + n) : (n0 + n)) * K + k0 + 8 * c) = o; }
    asm volatile("s_waitcnt lgkmcnt(0)" ::: "memory");
}
typedef short bf16x8_t __attribute__((ext_vector_type(8)));
typedef float f32x16_t __attribute__((ext_vector_type(16)));
typedef unsigned u32x4_t __attribute__((ext_vector_type(4)));
typedef unsigned u32x2_t __attribute__((ext_vector_type(2)));
typedef float f32x4_t __attribute__((ext_vector_type(4)));
#define MFMA32(a, b, c) __builtin_amdgcn_mfma_f32_32x32x16_bf16((a), (b), (c), 0, 0, 0)
__device__ __forceinline__ int crow(int r, int hi) { return (r & 3) + 8 * (r >> 2) + 4 * hi; }
__device__ __forceinline__ bf16x8_t pack_p(const f32x16_t& p, int s) {
    u32x4_t w; w.x = pk2f(p[8 * s + 0], p[8 * s + 1]); w.y = pk2f(p[8 * s + 2], p[8 * s + 3]); w.z = pk2f(p[8 * s + 4], p[8 * s + 5]); w.w = pk2f(p[8 * s + 6], p[8 * s + 7]);
    return __builtin_bit_cast(bf16x8_t, w);
}
constexpr int KROW = 144;
constexpr int VROW = 144;
constexpr int AL_K = 0;
constexpr int AL_V = AL_K + 2 * 2 * 64 * KROW;
constexpr int AL_X = 0;
constexpr int AL_ALS = AL_V + 2 * 128 * VROW;
constexpr int AL_TAB = AL_ALS + 8 * 32 * 4;
constexpr int AL_Q = AL_TAB + 1536;
constexpr int AL_END = AL_Q + 8 * 32 * KROW;
static_assert(AL_ALS >= 65536 && AL_END <= 131072, "attention LDS map");

template <int MODE>
__device__ __forceinline__ void attn_unit(LAS unsigned char* lds, int tid, int b, int h, int qb, const bf16_t* __restrict__ Q, const bf16_t* __restrict__ Kb, const bf16_t* __restrict__ VT,
                                          const float* __restrict__ ctl, const float* __restrict__ subln, bf16_t* __restrict__ MIX) {
    asm volatile("" : "+v"(tid));
    const int lane = tid & 63, wave = __builtin_amdgcn_readfirstlane(tid >> 6), map = wave >> 2, qs = wave & 3, ql = lane & 31, hi = lane >> 5;
    const int q0 = qb * 128, q0w = q0 + 32 * qs, nt = 2 * (qb + 1);
    const size_t rowbase = (size_t)b * SEQ;
    LAS float* als = (LAS float*)(lds + AL_ALS) + wave * 32;
    LAS float* tab = (LAS float*)(lds + AL_TAB);
    if (tid < 384) { const int d_ = tid - 128; tab[tid] = d_ < 0 ? 0.f : ctl[64 + h * 128 + (d_ > 127 ? 127 : d_)] - ctl[64 + h * 128 + 127]; }
    LAS unsigned char* qlds = lds + AL_Q + wave * (32 * KROW) + ql * KROW + 16 * hi;
    {
        const bf16_t* qp = Q + (rowbase + q0w + ql) * 512 + map * 256 + h * 64 + 8 * hi;
        bf16x8_t qtmp[4];
#pragma unroll
        for (int ks = 0; ks < 4; ++ks) qtmp[ks] = *(const bf16x8_t*)(qp + 16 * ks);
#pragma unroll
        for (int ks = 0; ks < 4; ++ks) *(LAS bf16x8_t*)(qlds + 32 * ks) = qtmp[ks];
    }
    const int kkey = (tid >> 3) & 63, kc = tid & 7;
    const bf16_t* kg = Kb + (rowbase + kkey) * 512 + h * 64 + 8 * kc;
    const bf16_t* vg = VT + ((size_t)(b * 4 + h) * 128 + (tid >> 3)) * SEQ + 8 * kc;
    const int klds = AL_K + kkey * KROW + 16 * kc, vlds = AL_V + (tid >> 3) * VROW + 16 * kc;
    u32x4_t sk0, sk1, sv0, sv1;
#define ATT_LOADK(t) do { sk0 = *(const u32x4_t*)(kg + (size_t)(t) * 64 * 512); sk1 = *(const u32x4_t*)(kg + (size_t)(t) * 64 * 512 + 256); } while (0)
#define ATT_LOADV(t) do { sv0 = *(const u32x4_t*)(vg + (t) * 64); sv1 = *(const u32x4_t*)(vg + (size_t)64 * SEQ + (t) * 64); } while (0)
#define ATT_STOREK(buf) do { *(LAS u32x4_t*)(lds + klds + (buf) * (2 * 64 * KROW)) = sk0; *(LAS u32x4_t*)(lds + klds + (buf) * (2 * 64 * KROW) + 64 * KROW) = sk1; } while (0)
#define ATT_STOREV(buf) do { *(LAS u32x4_t*)(lds + vlds + (buf) * (128 * VROW)) = sv0; *(LAS u32x4_t*)(lds + vlds + (buf) * (128 * VROW) + 64 * VROW) = sv1; } while (0)
#define ATT_QK(P_, KB_, C0_) do { const LAS unsigned char* kb_ = lds + AL_K + (KB_) * (2 * 64 * KROW) + map * (64 * KROW) + ql * KROW + 16 * hi; \
        _Pragma("unroll") for (int blk = 0; blk < 2; ++blk) { \
            _Pragma("unroll") for (int ks = 0; ks < 4; ++ks) { const bf16x8_t a_ = *(const LAS bf16x8_t*)(kb_ + blk * 32 * KROW + 32 * ks); const bf16x8_t q_ = *(const LAS bf16x8_t*)(qlds + 32 * ks); \
                if (ks == 0) P_[blk] = MFMA32(a_, q_, C0_); else P_[blk] = MFMA32(a_, q_, P_[blk]); } } } while (0)
#define ATT_VLD(W_, VB_, G_) do { const LAS unsigned char* vq_ = lds + AL_V + (VB_) * (128 * VROW) + ql * VROW + 16 * hi + 32 * (G_); \
        _Pragma("unroll") for (int cb = 0; cb < 4; ++cb) W_[cb] = *(const LAS u32x4_t*)(vq_ + cb * 32 * VROW); } while (0)
#define ATT_EXPC(P_, G_, C_, W_) do { const float x0_ = P_[(G_) >> 1][8 * ((G_) & 1) + 2 * (C_)], x1_ = P_[(G_) >> 1][8 * ((G_) & 1) + 2 * (C_) + 1]; \
        const float a_ = (MODE & 4) ? x0_ : __builtin_amdgcn_exp2f(x0_), b_ = (MODE & 4) ? x1_ : __builtin_amdgcn_exp2f(x1_); \
        W_[C_] = pk2f(a_, b_); ls0_ += a_; ls1_ += b_; } while (0)
#define ATT_SLOT(P_, G_, CB_, WC_, VC_, WN_) do { \
        if (!(MODE & 16)) o[CB_] = MFMA32(__builtin_bit_cast(bf16x8_t, WC_), __builtin_bit_cast(bf16x8_t, VC_[CB_]), o[CB_]); \
        if ((G_) < 3) { ATT_EXPC(P_, ((G_) + 1) & 3, CB_, WN_); asm volatile("" : "+v"(ls0_), "+v"(ls1_)); }        \
        __builtin_amdgcn_sched_barrier(0); } while (0)
#define ATT_SMPV(P_, PN_, KT_, VB_) do { \
        u32x4_t vA_[4], vB_[4]; \
        ATT_VLD(vA_, VB_, 0); \
        if ((KT_) + 4 >= nt) { const int db_ = q0w + ql - 64 * (KT_) - 4 * hi;        \
            const LAS float* tp_ = tab + (128 - 59) + db_; \
            _Pragma("unroll") for (int blk = 0; blk < 2; ++blk) { float bs_[16]; \
                _Pragma("unroll") for (int r = 0; r < 16; ++r) bs_[r] = tp_[59 - (32 * blk + (r & 3) + 8 * (r >> 2))]; \
                _Pragma("unroll") for (int r = 0; r < 16; ++r) asm volatile("" : "+v"(bs_[r])); \
                _Pragma("unroll") for (int r = 0; r < 16; ++r) P_[blk][r] = db_ < (32 * blk + (r & 3) + 8 * (r >> 2)) ? -INFINITY : P_[blk][r] + bs_[r]; } } \
        float rm_ = P_[0][0]; \
        _Pragma("unroll") for (int r = 1; r < 16; ++r) rm_ = fmaxf(rm_, P_[0][r]); \
        _Pragma("unroll") for (int r = 0; r < 16; ++r) rm_ = fmaxf(rm_, P_[1][r]); \
        rm_ = fmaxf(rm_, __shfl_xor(rm_, 32)); \
          \
          \
        if (__any(rm_ > 8.0f || ((KT_) == 0 && rm_ < -8.0f))) { \
            const float dl_ = (KT_) == 0 ? rm_ : fmaxf(rm_, 0.f); \
            const float alpha_ = __builtin_amdgcn_exp2f(-dl_); \
            l *= alpha_; \
            if (hi == 0) als[ql] = alpha_; \
            asm volatile("s_waitcnt lgkmcnt(0)" ::: "memory"); \
            float al_[16]; \
            _Pragma("unroll") for (int r = 0; r < 16; ++r) al_[r] = als[crow(r, hi)]; \
            _Pragma("unroll") for (int cb = 0; cb < 4; ++cb) _Pragma("unroll") for (int r = 0; r < 16; ++r) o[cb][r] *= al_[r]; \
            _Pragma("unroll") for (int blk = 0; blk < 2; ++blk) _Pragma("unroll") for (int r = 0; r < 16; ++r) { P_[blk][r] -= dl_; PN_[blk][r] -= dl_; } \
            _Pragma("unroll") for (int r = 0; r < 16; ++r) negm[r] -= dl_; } \
        float ls0_ = 0.f, ls1_ = 0.f; \
        u32x4_t wE_, wO_;        \
        ATT_EXPC(P_, 0, 0, wE_); ATT_EXPC(P_, 0, 1, wE_); ATT_EXPC(P_, 0, 2, wE_); ATT_EXPC(P_, 0, 3, wE_); ATT_VLD(vB_, VB_, 1); \
        __builtin_amdgcn_sched_barrier(0); \
        ATT_SLOT(P_, 0, 0, wE_, vA_, wO_); ATT_SLOT(P_, 0, 1, wE_, vA_, wO_); ATT_SLOT(P_, 0, 2, wE_, vA_, wO_); ATT_SLOT(P_, 0, 3, wE_, vA_, wO_); \
        ATT_VLD(vA_, VB_, 2); \
        ATT_SLOT(P_, 1, 0, wO_, vB_, wE_); ATT_SLOT(P_, 1, 1, wO_, vB_, wE_); ATT_SLOT(P_, 1, 2, wO_, vB_, wE_); ATT_SLOT(P_, 1, 3, wO_, vB_, wE_); \
        ATT_VLD(vB_, VB_, 3); \
        ATT_SLOT(P_, 2, 0, wE_, vA_, wO_); ATT_SLOT(P_, 2, 1, wE_, vA_, wO_); ATT_SLOT(P_, 2, 2, wE_, vA_, wO_); ATT_SLOT(P_, 2, 3, wE_, vA_, wO_); \
        ATT_SLOT(P_, 3, 0, wO_, vB_, wE_); ATT_SLOT(P_, 3, 1, wO_, vB_, wE_); ATT_SLOT(P_, 3, 2, wO_, vB_, wE_); ATT_SLOT(P_, 3, 3, wO_, vB_, wE_); \
        l += ls0_ + ls1_; } while (0)
#define ATT_ITER(PC_, PN_, KT_) do { \
        { const int tk_ = (KT_) + 2 < nt ? (KT_) + 2 : nt - 1, tv_ = (KT_) + 1 < nt ? (KT_) + 1 : nt - 1;     \
          if (!(MODE & 8)) { ATT_LOADK(tk_); ATT_LOADV(tv_); } }                                                                  \
        if (!(MODE & 32)) ATT_QK(PN_, ((KT_) + 1) & 1, negm); \
        __builtin_amdgcn_sched_barrier(0); \
        ATT_SMPV(PC_, PN_, (KT_), (KT_) & 1); \
        if (!(MODE & 8)) { ATT_STOREK((KT_) & 1); ATT_STOREV(((KT_) + 1) & 1); } \
        if (!(MODE & 2)) __syncthreads(); } while (0)
    ATT_LOADK(0); ATT_LOADV(0);
    __syncthreads();
    ATT_STOREK(0); ATT_STOREV(0);
    ATT_LOADK(1);
    ATT_STOREK(1);
    __syncthreads();
    f32x16_t o[4];
#pragma unroll
    for (int cb = 0; cb < 4; ++cb) o[cb] = (f32x16_t){0.f, 0.f, 0.f, 0.f, 0.f, 0.f, 0.f, 0.f, 0.f, 0.f, 0.f, 0.f, 0.f, 0.f, 0.f, 0.f};
    float l = 0.f;
    f32x16_t pA[2], pB[2];
    f32x16_t negm;
    {
        const f32x16_t zero16 = (f32x16_t){0.f, 0.f, 0.f, 0.f, 0.f, 0.f, 0.f, 0.f, 0.f, 0.f, 0.f, 0.f, 0.f, 0.f, 0.f, 0.f};
        ATT_QK(pA, 0, zero16);
        float m0 = pA[0][0];
#pragma unroll
        for (int r = 1; r < 16; ++r) m0 = fmaxf(m0, pA[0][r]);
#pragma unroll
        for (int r = 0; r < 16; ++r) m0 = fmaxf(m0, pA[1][r]);
        m0 = fmaxf(m0, __shfl_xor(m0, 32));
#pragma unroll
        for (int r = 0; r < 16; ++r) { pA[0][r] -= m0; pA[1][r] -= m0; negm[r] = -m0; }
    }
#pragma unroll 1
    for (int kt = 0; kt < nt; kt += 2) {
        ATT_ITER(pA, pB, kt);
        ATT_ITER(pB, pA, kt + 1);
    }
#undef ATT_LOADK
#undef ATT_LOADV
#undef ATT_STOREK
#undef ATT_STOREV
#undef ATT_QK
#undef ATT_SMPV
#undef ATT_VLD
#undef ATT_EXPC
#undef ATT_SLOT
#undef ATT_ITER
    l += __shfl_xor(l, 32);
    if (hi == 0) als[ql] = 1.0f / l;
    asm volatile("s_waitcnt lgkmcnt(0)" ::: "memory");
    float il[16];
#pragma unroll
    for (int r = 0; r < 16; ++r) il[r] = als[crow(r, hi)];
    LAS float* xo = (LAS float*)(lds + AL_X) + qs * (32 * 128);
    if (map == 1) {
#pragma unroll
        for (int cb = 0; cb < 4; ++cb)
#pragma unroll
            for (int r = 0; r < 16; ++r) xo[crow(r, hi) * 128 + 32 * cb + ql] = o[cb][r] * il[r];
    }
    __syncthreads();
    if (map == 0) {
        const float lam = ctl[0];
        float ss[16];
#pragma unroll
        for (int r = 0; r < 16; ++r) ss[r] = 0.f;
#pragma unroll
        for (int cb = 0; cb < 4; ++cb)
#pragma unroll
            for (int r = 0; r < 16; ++r) { const float d = o[cb][r] * il[r] - lam * xo[crow(r, hi) * 128 + 32 * cb + ql]; o[cb][r] = d; ss[r] += d * d; }
#pragma unroll
        for (int r = 0; r < 16; ++r) {
            float s = ss[r];
            s += __shfl_xor(s, 1); s += __shfl_xor(s, 2); s += __shfl_xor(s, 4); s += __shfl_xor(s, 8); s += __shfl_xor(s, 16);
            ss[r] = rsqrtf(s * (1.f / 128) + 1e-5f) * 0.8f;
        }
#pragma unroll
        for (int cb = 0; cb < 4; ++cb) {
            const float g = subln[32 * cb + ql];
#pragma unroll
            for (int r = 0; r < 16; ++r) if (!(MODE & 1)) MIX[(rowbase + q0w + crow(r, hi)) * DM + h * 128 + 32 * cb + ql] = f2bf(o[cb][r] * ss[r] * g);
        }
    }
    __syncthreads();
}

__device__ __forceinline__ void ret_kv_unit(int tid, int bh, int n, const bf16_t* __restrict__ RVT, const bf16_t* __restrict__ RKT, float* __restrict__ KVT) {
    const int lane = tid & 63, wave = tid >> 6, rb = wave & 3, cbk = wave >> 2, ql = lane & 31, hi = lane >> 5, h = bh & 3;
    const float lg = log2f(1.0f - exp2f(-5.0f - (float)h));
    const bf16_t* ap = RVT + ((size_t)bh * 128 + 32 * rb + ql) * SEQ + 128 * n + 8 * hi;
    const bf16_t* bp = RKT + ((size_t)bh * 64 + 32 * cbk + ql) * SEQ + 128 * n + 8 * hi;
    f32x16_t acc = (f32x16_t){0.f, 0.f, 0.f, 0.f, 0.f, 0.f, 0.f, 0.f, 0.f, 0.f, 0.f, 0.f, 0.f, 0.f, 0.f, 0.f};
#pragma unroll
    for (int s = 0; s < 8; ++s) {
        const bf16x8_t a = *(const bf16x8_t*)(ap + 16 * s);
        const uint4 kw = *(const uint4*)(bp + 16 * s);
        const u32 kk[4] = {kw.x, kw.y, kw.z, kw.w};
        u32x4_t w;
        u32 ww[4];
#pragma unroll
        for (int e = 0; e < 4; ++e) {
            const int key = 16 * s + 8 * hi + 2 * e;
            const float z0 = exp2f((float)(127 - key) * lg), z1 = exp2f((float)(126 - key) * lg);
            ww[e] = pk2f(__uint_as_float(kk[e] << 16) * z0, __uint_as_float(kk[e] & 0xffff0000u) * z1);
        }
        w.x = ww[0]; w.y = ww[1]; w.z = ww[2]; w.w = ww[3];
        acc = MFMA32(a, __builtin_bit_cast(bf16x8_t, w), acc);
    }
    float* out = KVT + ((size_t)(bh * 32 + n) * 128 + 32 * rb) * 64 + 32 * cbk + ql;
#pragma unroll
    for (int r = 0; r < 16; ++r) out[crow(r, hi) * 64] = acc[r];
}
__device__ __forceinline__ void ret_scan(int e, const float* __restrict__ KVT, bf16_t* __restrict__ ST) {
    const int bh = e >> 13, idx = e & 8191, h = bh & 3;
    const float cd = exp2f(128.0f * log2f(1.0f - exp2f(-5.0f - (float)h)));
    float s = 0.f;
    for (int n = 0; n < 32; ++n) {
        ST[((size_t)(bh * 32 + n) << 13) + idx] = f2bf(s);
        s = s * cd + KVT[((size_t)(bh * 32 + n) << 13) + idx];
    }
}
constexpr int RVROW = 272;
constexpr int RL_K = 0;
constexpr int RL_V = RL_K + 128 * KROW;
constexpr int RL_S = RL_V + 128 * RVROW;
constexpr int RL_DT = RL_S + 128 * KROW;
constexpr int RL_BUF = RL_DT + 512;
constexpr int RL_SS = 2 * RL_BUF;
constexpr int RL_END = RL_SS + 4 * 2 * 32 * 4;
static_assert(RL_END <= 147456 - 256, "retention LDS map");
__device__ __forceinline__ void ret_out_units(LAS unsigned char* lds0, int tid, int u0, int ustep, int nunits, const bf16_t* __restrict__ RQ, const bf16_t* __restrict__ RK, const bf16_t* __restrict__ RVT,
                                              const bf16_t* __restrict__ ST, const bf16_t* __restrict__ RG, bf16_t* __restrict__ MIX) {
    asm volatile("" : "+v"(tid));
    const int lane = tid & 63, wave = __builtin_amdgcn_readfirstlane(tid >> 6), qs = wave & 3, dvh = wave >> 2, ql = lane & 31, hi = lane >> 5;
    u32x4_t rk[2], rv[4], rs[2];
#define RL_LOAD(U_) do { const int bh_ = (U_) >> 5, n_ = (U_) & 31; const size_t r0_ = (size_t)(bh_ >> 2) * SEQ + 128 * n_; \
        _Pragma("unroll") for (int q = 0; q < 2; ++q) { const int i_ = tid + 512 * q, key = i_ >> 3, c = i_ & 7; rk[q] = *(const u32x4_t*)(RK + (r0_ + key) * 256 + (bh_ & 3) * 64 + 8 * c); } \
        _Pragma("unroll") for (int q = 0; q < 4; ++q) { const int i_ = tid + 512 * q, dv = i_ >> 4, c = i_ & 15; rv[q] = *(const u32x4_t*)(RVT + ((size_t)bh_ * 128 + dv) * SEQ + 128 * n_ + 8 * c); } \
        _Pragma("unroll") for (int q = 0; q < 2; ++q) { const int i_ = tid + 512 * q, dv = i_ >> 3, c = i_ & 7; rs[q] = *(const u32x4_t*)(ST + ((size_t)(U_) << 13) + dv * 64 + 8 * c); } } while (0)
#define RL_STORE(L_) do { \
        _Pragma("unroll") for (int q = 0; q < 2; ++q) { const int i_ = tid + 512 * q, key = i_ >> 3, c = i_ & 7; *(LAS u32x4_t*)((L_) + RL_K + key * KROW + 16 * c) = rk[q]; } \
        _Pragma("unroll") for (int q = 0; q < 4; ++q) { const int i_ = tid + 512 * q, dv = i_ >> 4, c = i_ & 15; *(LAS u32x4_t*)((L_) + RL_V + dv * RVROW + 16 * c) = rv[q]; } \
        _Pragma("unroll") for (int q = 0; q < 2; ++q) { const int i_ = tid + 512 * q, dv = i_ >> 3, c = i_ & 7; *(LAS u32x4_t*)((L_) + RL_S + dv * KROW + 16 * c) = rs[q]; } } while (0)
    RL_LOAD(u0 < nunits ? u0 : 0);
    int it = 0;
#pragma unroll 1
  for (int u = u0; u < nunits; u += ustep, ++it) {
    LAS unsigned char* lds = lds0 + (it & 1) * RL_BUF;
    const int bh = u >> 5, n = u & 31, b = bh >> 2, h = bh & 3;
    const size_t row0 = (size_t)b * SEQ + 128 * n;
    const float lg = log2f(1.0f - exp2f(-5.0f - (float)h));
    __syncthreads();
    RL_STORE(lds);
    if (tid < 128) ((LAS float*)(lds + RL_DT))[tid] = exp2f((float)tid * lg);
    bf16x8_t qf[4];
    {
        const bf16_t* qp = RQ + (row0 + 32 * qs + ql) * 256 + h * 64 + 8 * hi;
#pragma unroll
        for (int ks = 0; ks < 4; ++ks) qf[ks] = *(const bf16x8_t*)(qp + 16 * ks);
    }
    __syncthreads();
    { const int un_ = u + ustep < nunits ? u + ustep : u; RL_LOAD(un_); }
    const LAS float* dt = (const LAS float*)(lds + RL_DT);
    f32x16_t o[2];
    o[0] = (f32x16_t){0.f, 0.f, 0.f, 0.f, 0.f, 0.f, 0.f, 0.f, 0.f, 0.f, 0.f, 0.f, 0.f, 0.f, 0.f, 0.f}; o[1] = o[0];
    const int qloc = 32 * qs + ql;
    for (int kb = 0; kb <= qs; ++kb) {
        f32x16_t p = (f32x16_t){0.f, 0.f, 0.f, 0.f, 0.f, 0.f, 0.f, 0.f, 0.f, 0.f, 0.f, 0.f, 0.f, 0.f, 0.f, 0.f};
        const LAS unsigned char* kp = lds + RL_K + (32 * kb + ql) * KROW + 16 * hi;
#pragma unroll
        for (int ks = 0; ks < 4; ++ks) { const bf16x8_t a = *(const LAS bf16x8_t*)(kp + 32 * ks); p = MFMA32(a, qf[ks], p); }
#pragma unroll
        for (int r = 0; r < 16; ++r) { const int dist = qloc - (32 * kb + crow(r, hi)); p[r] = dist < 0 ? 0.f : p[r] * dt[dist < 0 ? 0 : dist]; }
#pragma unroll
        for (int s = 0; s < 2; ++s) {
            const bf16x8_t pa = pack_p(p, s);
#pragma unroll
            for (int cbl = 0; cbl < 2; ++cbl) {
                const LAS unsigned char* vp = lds + RL_V + (64 * dvh + 32 * cbl + ql) * RVROW + (32 * kb + 16 * s) * 2 + 8 * hi;
                const u32x2_t lo = *(const LAS u32x2_t*)vp, hi2 = *(const LAS u32x2_t*)(vp + 16);
                u32x4_t w; w.x = lo.x; w.y = lo.y; w.z = hi2.x; w.w = hi2.y;
                o[cbl] = MFMA32(pa, __builtin_bit_cast(bf16x8_t, w), o[cbl]);
            }
        }
    }
    if (n > 0) {
        const float xi = exp2f((float)(qloc + 1) * lg);
#pragma unroll
        for (int ks = 0; ks < 4; ++ks) {
            u32x4_t qw = __builtin_bit_cast(u32x4_t, qf[ks]);
            u32 qq[4] = {qw.x, qw.y, qw.z, qw.w};
#pragma unroll
            for (int e = 0; e < 4; ++e) qq[e] = pk2f(__uint_as_float(qq[e] << 16) * xi, __uint_as_float(qq[e] & 0xffff0000u) * xi);
            qw.x = qq[0]; qw.y = qq[1]; qw.z = qq[2]; qw.w = qq[3];
            const bf16x8_t qx = __builtin_bit_cast(bf16x8_t, qw);
#pragma unroll
            for (int cbl = 0; cbl < 2; ++cbl) {
                const bf16x8_t bs = *(const LAS bf16x8_t*)(lds + RL_S + (64 * dvh + 32 * cbl + ql) * KROW + 32 * ks + 16 * hi);
                o[cbl] = MFMA32(qx, bs, o[cbl]);
            }
        }
    }
    float ss[16];
#pragma unroll
    for (int r = 0; r < 16; ++r) {
        float s = o[0][r] * o[0][r] + o[1][r] * o[1][r];
        s += __shfl_xor(s, 1); s += __shfl_xor(s, 2); s += __shfl_xor(s, 4); s += __shfl_xor(s, 8); s += __shfl_xor(s, 16);
        ss[r] = s;
    }
    LAS float* sx = (LAS float*)(lds0 + RL_SS);
    if (ql == 0) {
#pragma unroll
        for (int r = 0; r < 16; ++r) sx[(qs * 2 + dvh) * 32 + crow(r, hi)] = ss[r];
    }
    __syncthreads();
#pragma unroll
    for (int r = 0; r < 16; ++r) ss[r] = rsqrtf((sx[(qs * 2) * 32 + crow(r, hi)] + sx[(qs * 2 + 1) * 32 + crow(r, hi)]) * (1.f / 128) + 1e-6f);
    {
        LAS float* wt = (LAS float*)(lds + wave * 8704);
#pragma unroll
        for (int cbl = 0; cbl < 2; ++cbl)
#pragma unroll
            for (int r = 0; r < 16; ++r) wt[crow(r, hi) * 68 + 32 * cbl + ql] = o[cbl][r] * ss[r];
#pragma unroll
        for (int ps = 0; ps < 4; ++ps) {
            const int rr = 8 * ps + (lane >> 3), c8 = 8 * (lane & 7);
            const f32x4_t a0 = *(const LAS f32x4_t*)(wt + rr * 68 + c8), a1 = *(const LAS f32x4_t*)(wt + rr * 68 + c8 + 4);
            const size_t row = row0 + 32 * qs + rr; const int col = h * 128 + 64 * dvh + c8;
            const uint4 gw = *(const uint4*)(RG + row * 512 + col);
            const float w8[8] = {a0[0] * __uint_as_float(gw.x << 16), a0[1] * __uint_as_float(gw.x & 0xffff0000u), a0[2] * __uint_as_float(gw.y << 16), a0[3] * __uint_as_float(gw.y & 0xffff0000u),
                                 a1[0] * __uint_as_float(gw.z << 16), a1[1] * __uint_as_float(gw.z & 0xffff0000u), a1[2] * __uint_as_float(gw.w << 16), a1[3] * __uint_as_float(gw.w & 0xffff0000u)};
            *(uint4*)(MIX + row * DM + 512 + col) = pack8(w8);
        }
    }
  }
#undef RL_LOAD
#undef RL_STORE
}
__host__ __device__ __forceinline__ int rot_dst_row(int n) {
    if (n < 1536 || n >= 2048) return n;
    const int o = (n - 1536) & 255, base = n - o, head = o >> 6, d = o & 63, half = d >> 5, p = d & 31;
    return base + 8 * (head * 8 + (p >> 2)) + (p & 3) + 4 * half;
}
struct EpiInProjT {
    static constexpr bool PERM = true, AFTER_DRAIN = false;
    unsigned char* ws; const float* cs;
#define EPI_FOREACH(...) _Pragma("unroll") for (int ai = 0; ai < 2; ++ai) _Pragma("unroll") for (int m = 0; m < 4; ++m) { const int row = row0 + ai * 128 + m * 16; \
        _Pragma("unroll") for (int bj = 0; bj < 2; ++bj) { const int lc = lc0 + bj * 128; \
            const float v[8] = {acc[ai][bj][m][0][0], acc[ai][bj][m][0][1], acc[ai][bj][m][0][2], acc[ai][bj][m][0][3], acc[ai][bj][m][1][0], acc[ai][bj][m][1][1], acc[ai][bj][m][1][2], acc[ai][bj][m][1][3]}; __VA_ARGS__ } \
        asm volatile("" ::: "memory"); }
    __device__ __forceinline__ void operator()(const pg8::f32x4 (&acc)[2][2][4][2], const pg8::Unit& u, int wr, int wc, int fr, int fq) const {
        const int pn = __builtin_amdgcn_readfirstlane(u.pn);
        const int row0 = u.pm * 256 + wr * 64 + fr, lc0 = wc * 32 + 8 * fq;
        if (pn < 4) {
            const float sc = pn < 2 ? QSCALE : 1.f;
            bf16_t* base = (bf16_t*)(ws + (pn < 2 ? WS_Q : WS_K)) + (pn & 1) * 256;
            EPI_FOREACH({ const float w[8] = {v[0] * sc, v[1] * sc, v[2] * sc, v[3] * sc, v[4] * sc, v[5] * sc, v[6] * sc, v[7] * sc}; *(uint4*)(base + (size_t)row * 512 + lc) = pack8(w); })
        } else if (pn == 6 || pn == 7) {
            const bool isk = pn == 7; const float sc = isk ? 0.125f : 1.f;
            bf16_t* base = (bf16_t*)(ws + (isk ? WS_RK : WS_RQ));
            EPI_FOREACH({ const int j = lc >> 3, head = j >> 3, p = 4 * (j & 7), pos = row & (SEQ - 1);
                const float4 co = *(const float4*)(cs + pos * 32 + p), si = *(const float4*)(cs + 4096 * 32 + pos * 32 + p);
                uint2 a, b;
                a.x = pk2f((v[0] * co.x - v[4] * si.x) * sc, (v[1] * co.y - v[5] * si.y) * sc); a.y = pk2f((v[2] * co.z - v[6] * si.z) * sc, (v[3] * co.w - v[7] * si.w) * sc);
                b.x = pk2f((v[0] * si.x + v[4] * co.x) * sc, (v[1] * si.y + v[5] * co.y) * sc); b.y = pk2f((v[2] * si.z + v[6] * co.z) * sc, (v[3] * si.w + v[7] * co.w) * sc);
                bf16_t* dst = base + (size_t)row * 256 + head * 64 + p;
                *(uint2*)dst = a; *(uint2*)(dst + 32) = b;
                if (isk) {
                    bf16_t* kt = (bf16_t*)(ws + WS_RKT) + ((size_t)((row >> 12) * 4 + head) * 64 + p) * SEQ + pos;
                    const u32 wv[4] = {a.x, a.y, b.x, b.y};
                    _Pragma("unroll") for (int q = 0; q < 4; ++q) { *kt = (bf16_t)wv[q]; kt += SEQ; asm volatile("" : "+v"(kt)); *kt = (bf16_t)(wv[q] >> 16); kt += (q == 1 ? (size_t)29 * SEQ : (size_t)SEQ); asm volatile("" : "+v"(kt)); }
                } })
        } else if (pn >= 10) {
            bf16_t* base = (bf16_t*)(ws + WS_RG) + (pn - 10) * 256;
            EPI_FOREACH({ float w[8]; _Pragma("unroll") for (int q = 0; q < 8; ++q) w[q] = v[q] / (1.f + __expf(-v[q])); *(uint4*)(base + (size_t)row * 512 + lc) = pack8(w); })
        } else {
            bf16_t* base = (bf16_t*)(ws + (pn >= 8 ? WS_RV : WS_VV));
            const int cb = (pn & 1) * 256;
            EPI_FOREACH({ const int c = cb + lc, tp = row & (SEQ - 1), tq = pn >= 8 ? tp : ((tp & ~12) | ((tp & 4) << 1) | ((tp & 8) >> 1));
                bf16_t* vt = base + ((size_t)((row >> 12) * 4 + (c >> 7)) * 128 + (c & 127)) * SEQ + tq;
                _Pragma("unroll") for (int q = 0; q < 8; q += 2) { const u32 w = pk2f(v[q], v[q + 1]); *vt = (bf16_t)w; vt += SEQ; asm volatile("" : "+v"(vt)); *vt = (bf16_t)(w >> 16); vt += SEQ; asm volatile("" : "+v"(vt)); } })
        }
    }
#undef EPI_FOREACH
};

struct EpiOutProj {
    static constexpr bool ROWSUM = true;
    const float* x; float* H; bf16_t* HB; float* rss;
    __device__ __forceinline__ void rowsum(int row, float s) const { atomicAdd(rss + row, s); }
    __device__ __forceinline__ float row8(int row, int col, const float* v) const {
        const float4 x0 = *(const float4*)(x + (size_t)row * DM + col), x1 = *(const float4*)(x + (size_t)row * DM + col + 4);
        const float hh[8] = {x0.x + v[0], x0.y + v[1], x0.z + v[2], x0.w + v[3], x1.x + v[4], x1.y + v[5], x1.z + v[6], x1.w + v[7]};
        *(uint4*)(HB + (size_t)row * DM + col) = pack8(hh);
        float s = 0.f;
#pragma unroll
        for (int j = 0; j < 8; ++j) s += hh[j] * hh[j];
        return s;
    }
};
struct EpiQry {
    static constexpr bool ROWSUM = false;
    bf16_t* QRY; const float* rss;
    __device__ __forceinline__ void rowsum(int, float) const {}
    __device__ __forceinline__ float row8(int row, int col, const float* v) const {
        const float r = rsqrtf(rss[row] * (1.f / DM) + 1e-6f);
        const float w[8] = {v[0] * r, v[1] * r, v[2] * r, v[3] * r, v[4] * r, v[5] * r, v[6] * r, v[7] * r};
        *(uint4*)(QRY + (size_t)row * 2048 + col) = pack8(w);
        return 0.f;
    }
};
struct EpiPP {
    static constexpr bool ROWSUM = false;
    bf16_t* PP;
    __device__ __forceinline__ void rowsum(int, float) const {}
    __device__ __forceinline__ float row8(int row, int col, const float* v) const { *(uint4*)(PP + (size_t)row * DM + col) = pack8(v); return 0.f; }
};
struct EpiGate {
    static constexpr bool ROWSUM = true;
    const bf16_t* HBr; const bf16_t* PP; const float* bg; const float* rss2; float* rss3; bf16_t* H3B;
    __device__ __forceinline__ void rowsum(int row, float s) const { atomicAdd(rss3 + row, s); }
    __device__ __forceinline__ float row8(int row, int col, const float* v) const {
        const float r = rsqrtf(rss2[row] * (1.f / DM) + 1e-6f);
        const uint4 pw = *(const uint4*)(PP + (size_t)row * DM + col), hw = *(const uint4*)(HBr + (size_t)row * DM + col);
        const float4 b0 = *(const float4*)(bg + col), b1 = *(const float4*)(bg + col + 4);
        const float hv[8] = {__uint_as_float(hw.x << 16), __uint_as_float(hw.x & 0xffff0000u), __uint_as_float(hw.y << 16), __uint_as_float(hw.y & 0xffff0000u),
                             __uint_as_float(hw.z << 16), __uint_as_float(hw.z & 0xffff0000u), __uint_as_float(hw.w << 16), __uint_as_float(hw.w & 0xffff0000u)};
        const float bb[8] = {b0.x, b0.y, b0.z, b0.w, b1.x, b1.y, b1.z, b1.w};
        const float pp[8] = {__uint_as_float(pw.x << 16), __uint_as_float(pw.x & 0xffff0000u), __uint_as_float(pw.y << 16), __uint_as_float(pw.y & 0xffff0000u),
                             __uint_as_float(pw.z << 16), __uint_as_float(pw.z & 0xffff0000u), __uint_as_float(pw.w << 16), __uint_as_float(pw.w & 0xffff0000u)};
        float o[8], s = 0.f;
#pragma unroll
        for (int j = 0; j < 8; ++j) { const float g = 1.f / (1.f + __expf(-(v[j] * r + bb[j]))); o[j] = hv[j] + g * pp[j]; s += o[j] * o[j]; }
        *(uint4*)(H3B + (size_t)row * DM + col) = pack8(o);
        return s;
    }
};

__device__ __forceinline__ void b_peer_topk(int tok, int tid, char* sm, const bf16_t* __restrict__ QRY, const bf16_t* __restrict__ SUBK, int* __restrict__ IDX, float* __restrict__ GATE) {
    float* q = (float*)sm; float* sc = q + 2048; float (*tv)[16] = (float (*)[16])(sc + 2048); int (*ti)[16] = (int (*)[16])(sc + 2048 + 256);
    __syncthreads();
    for (int i = tid; i < 2048; i += 256) q[i] = bf2f(QRY[(size_t)tok * 2048 + i]);
    __syncthreads();
    for (int s = tid; s < 2048; s += 256) {
        const int hc = s >> 7;
        const bf16_t* kr = SUBK + (size_t)s * 128; const float* qq = q + hc * 128;
        float a = 0.f;
        for (int d = 0; d < 128; ++d) a += qq[d] * bf2f(kr[d]);
        sc[s] = a;
    }
    __syncthreads();
    if (tid < 16) {
        float* s = sc + tid * 128;
        for (int r = 0; r < 16; ++r) {
            float best = -INFINITY; int bi = 0;
            for (int k = 0; k < 128; ++k) { const float x = s[k]; if (x > best) { best = x; bi = k; } }
            tv[tid][r] = best; ti[tid][r] = bi; s[bi] = -INFINITY;
        }
    }
    __syncthreads();
    if (tid < 8) {
        const int h = tid;
        unsigned used[8] = {0, 0, 0, 0, 0, 0, 0, 0};
        float ts[16]; int te[16];
        for (int r = 0; r < 16; ++r) {
            float best = -INFINITY; int bc = 0;
            for (int c = 0; c < 256; ++c) {
                if (used[c >> 5] & (1u << (c & 31))) continue;
                const float x = tv[2 * h][c >> 4] + tv[2 * h + 1][c & 15];
                if (x > best) { best = x; bc = c; }
            }
            used[bc >> 5] |= 1u << (bc & 31);
            ts[r] = best; te[r] = ti[2 * h][bc >> 4] * 128 + ti[2 * h + 1][bc & 15];
        }
        float mx = ts[0], sum = 0.f;
        for (int r = 0; r < 16; ++r) { ts[r] = __expf(ts[r] - mx); sum += ts[r]; }
        for (int r = 0; r < 16; ++r) { IDX[(size_t)tok * 128 + h * 16 + r] = te[r]; GATE[(size_t)tok * 128 + h * 16 + r] = ts[r] / sum; }
    }
}
__device__ __forceinline__ void b_peer_gather(int tok, int tid, char* sm, const bf16_t* __restrict__ U, const bf16_t* __restrict__ Vt, const int* __restrict__ IDX, const float* __restrict__ GATE,
                                                     float* __restrict__ H, bf16_t* __restrict__ HB, const float* __restrict__ rss1, float* __restrict__ rss2) {
    float* hrow = (float*)sm; float* a = hrow + 1024; int* ex = (int*)(a + 128); float* red = (float*)(ex + 128);
    const int lane = tid & 63, wid = (tid >> 6) & 3;
    __syncthreads();
    for (int i = tid; i < 1024; i += 256) hrow[i] = bf2f(HB[(size_t)tok * DM + i]);
    if (tid < 128) ex[tid] = IDX[(size_t)tok * 128 + tid];
    __syncthreads();
    const float r1 = rsqrtf(rss1[tok] * (1.f / DM) + 1e-6f);
    for (int e = wid * 32; e < wid * 32 + 32; ++e) {
        const bf16_t* ur = U + (size_t)ex[e] * DM + lane * 16;
        float d = 0.f;
#pragma unroll
        for (int j = 0; j < 16; ++j) d += bf2f(ur[j]) * hrow[lane * 16 + j];
        d = wave_sum(d);
        if (lane == 0) { const float z = d * r1; a[e] = 0.5f * z * (1.f + erff(z * 0.70710678118654752f)) * GATE[(size_t)tok * 128 + e]; }
    }
    __syncthreads();
    float acc[4] = {0.f, 0.f, 0.f, 0.f};
    for (int e = 0; e < 128; ++e) {
        const ushort4 v = *(const ushort4*)(Vt + (size_t)ex[e] * DM + tid * 4);
        const float ae = a[e];
        acc[0] += ae * bf2f(v.x); acc[1] += ae * bf2f(v.y); acc[2] += ae * bf2f(v.z); acc[3] += ae * bf2f(v.w);
    }
    float4 hv = *(float4*)(H + (size_t)tok * DM + tid * 4);
    hv.x += acc[0]; hv.y += acc[1]; hv.z += acc[2]; hv.w += acc[3];
    *(float4*)(H + (size_t)tok * DM + tid * 4) = hv;
    ushort4 o; o.x = f2bf(hv.x); o.y = f2bf(hv.y); o.z = f2bf(hv.z); o.w = f2bf(hv.w);
    __syncthreads();
    *(ushort4*)(HB + (size_t)tok * DM + tid * 4) = o;
    float s = hv.x * hv.x + hv.y * hv.y + hv.z * hv.z + hv.w * hv.w;
    s = wave_sum(s);
    if (lane == 0) red[wid] = s;
    __syncthreads();
    if (tid == 0) rss2[tok] = red[0] + red[1] + red[2] + red[3];
}
__device__ __forceinline__ void b_final(size_t i, const bf16_t* __restrict__ H3B, float* __restrict__ OUT, const float* __restrict__ rss3, const float* __restrict__ gain) {
    const int row = (int)(i >> 7), c = (int)(i & 127) * 8;
    const float r = rsqrtf(rss3[row] * (1.f / DM) + 1e-6f);
    const uint4 w = ((const uint4*)H3B)[i]; const float4 g0 = *(const float4*)(gain + c), g1 = *(const float4*)(gain + c + 4);
    float4 a, b2;
    a.x = __uint_as_float(w.x << 16) * r * g0.x; a.y = __uint_as_float(w.x & 0xffff0000u) * r * g0.y; a.z = __uint_as_float(w.y << 16) * r * g0.z; a.w = __uint_as_float(w.y & 0xffff0000u) * r * g0.w;
    b2.x = __uint_as_float(w.z << 16) * r * g1.x; b2.y = __uint_as_float(w.z & 0xffff0000u) * r * g1.y; b2.z = __uint_as_float(w.w << 16) * r * g1.z; b2.w = __uint_as_float(w.w & 0xffff0000u) * r * g1.w;
    ((float4*)OUT)[2 * i] = a; ((float4*)OUT)[2 * i + 1] = b2;
}

__device__ __forceinline__ u32 f2ord(float x) { const u32 u = __float_as_uint(x); return (u & 0x80000000u) ? ~u : (u | 0x80000000u); }
__device__ __forceinline__ float ord2f(u32 o) { const u32 u = (o & 0x80000000u) ? (o & 0x7fffffffu) : ~o; return __uint_as_float(u); }
__device__ __forceinline__ u32 umax3(u32 a, u32 b, u32 c) { return max(max(a, b), c); }
#define CE_(a_, b_) do { const u32 hi_ = max(a_, b_), lo_ = min(a_, b_); a_ = hi_; b_ = lo_; } while (0)
#define TOPK_NET() do { CE_(k[0], k[13]); CE_(k[1], k[12]); CE_(k[2], k[15]); CE_(k[3], k[14]); CE_(k[4], k[8]); CE_(k[5], k[6]); CE_(k[7], k[11]); CE_(k[9], k[10]); CE_(k[16], k[29]); CE_(k[17], k[28]); CE_(k[18], k[31]); CE_(k[19], k[30]); CE_(k[20], k[24]); CE_(k[21], k[22]); CE_(k[23], k[27]); CE_(k[25], k[26]); CE_(k[32], k[45]); CE_(k[33], k[44]); CE_(k[34], k[47]); CE_(k[35], k[46]); CE_(k[36], k[40]); CE_(k[37], k[38]); CE_(k[39], k[43]); CE_(k[41], k[42]); CE_(k[48], k[61]); CE_(k[49], k[60]); CE_(k[50], k[63]); CE_(k[51], k[62]); CE_(k[52], k[56]); CE_(k[53], k[54]); CE_(k[55], k[59]); CE_(k[57], k[58]); CE_(k[0], k[5]); CE_(k[1], k[7]); CE_(k[2], k[9]); CE_(k[3], k[4]); CE_(k[6], k[13]); CE_(k[8], k[14]); CE_(k[10], k[15]); CE_(k[11], k[12]); CE_(k[16], k[21]); CE_(k[17], k[23]); CE_(k[18], k[25]); CE_(k[19], k[20]); CE_(k[22], k[29]); CE_(k[24], k[30]); CE_(k[26], k[31]); CE_(k[27], k[28]); CE_(k[32], k[37]); CE_(k[33], k[39]); CE_(k[34], k[41]); CE_(k[35], k[36]); CE_(k[38], k[45]); CE_(k[40], k[46]); CE_(k[42], k[47]); CE_(k[43], k[44]); CE_(k[48], k[53]); CE_(k[49], k[55]); CE_(k[50], k[57]); CE_(k[51], k[52]); CE_(k[54], k[61]); CE_(k[56], k[62]); CE_(k[58], k[63]); CE_(k[59], k[60]); CE_(k[0], k[1]); CE_(k[2], k[3]); CE_(k[4], k[5]); CE_(k[6], k[8]); CE_(k[7], k[9]); CE_(k[10], k[11]); CE_(k[12], k[13]); CE_(k[14], k[15]); CE_(k[16], k[17]); CE_(k[18], k[19]); CE_(k[20], k[21]); CE_(k[22], k[24]); CE_(k[23], k[25]); CE_(k[26], k[27]); CE_(k[28], k[29]); CE_(k[30], k[31]); CE_(k[32], k[33]); CE_(k[34], k[35]); CE_(k[36], k[37]); CE_(k[38], k[40]); CE_(k[39], k[41]); CE_(k[42], k[43]); CE_(k[44], k[45]); CE_(k[46], k[47]); CE_(k[48], k[49]); CE_(k[50], k[51]); CE_(k[52], k[53]); CE_(k[54], k[56]); CE_(k[55], k[57]); CE_(k[58], k[59]); CE_(k[60], k[61]); CE_(k[62], k[63]); CE_(k[0], k[2]); CE_(k[1], k[3]); CE_(k[4], k[10]); CE_(k[5], k[11]); CE_(k[6], k[7]); CE_(k[8], k[9]); CE_(k[12], k[14]); CE_(k[13], k[15]); CE_(k[16], k[18]); CE_(k[17], k[19]); CE_(k[20], k[26]); CE_(k[21], k[27]); CE_(k[22], k[23]); CE_(k[24], k[25]); CE_(k[28], k[30]); CE_(k[29], k[31]); CE_(k[32], k[34]); CE_(k[33], k[35]); CE_(k[36], k[42]); CE_(k[37], k[43]); CE_(k[38], k[39]); CE_(k[40], k[41]); CE_(k[44], k[46]); CE_(k[45], k[47]); CE_(k[48], k[50]); CE_(k[49], k[51]); CE_(k[52], k[58]); CE_(k[53], k[59]); CE_(k[54], k[55]); CE_(k[56], k[57]); CE_(k[60], k[62]); CE_(k[61], k[63]); CE_(k[1], k[2]); CE_(k[3], k[12]); CE_(k[4], k[6]); CE_(k[5], k[7]); CE_(k[8], k[10]); CE_(k[9], k[11]); CE_(k[13], k[14]); CE_(k[17], k[18]); CE_(k[19], k[28]); CE_(k[20], k[22]); CE_(k[21], k[23]); CE_(k[24], k[26]); CE_(k[25], k[27]); CE_(k[29], k[30]); CE_(k[33], k[34]); CE_(k[35], k[44]); CE_(k[36], k[38]); CE_(k[37], k[39]); CE_(k[40], k[42]); CE_(k[41], k[43]); CE_(k[45], k[46]); CE_(k[49], k[50]); CE_(k[51], k[60]); CE_(k[52], k[54]); CE_(k[53], k[55]); CE_(k[56], k[58]); CE_(k[57], k[59]); CE_(k[61], k[62]); CE_(k[1], k[4]); CE_(k[2], k[6]); CE_(k[5], k[8]); CE_(k[7], k[10]); CE_(k[9], k[13]); CE_(k[11], k[14]); CE_(k[17], k[20]); CE_(k[18], k[22]); CE_(k[21], k[24]); CE_(k[23], k[26]); CE_(k[25], k[29]); CE_(k[27], k[30]); CE_(k[33], k[36]); CE_(k[34], k[38]); CE_(k[37], k[40]); CE_(k[39], k[42]); CE_(k[41], k[45]); CE_(k[43], k[46]); CE_(k[49], k[52]); CE_(k[50], k[54]); CE_(k[53], k[56]); CE_(k[55], k[58]); CE_(k[57], k[61]); CE_(k[59], k[62]); CE_(k[2], k[4]); CE_(k[3], k[6]); CE_(k[9], k[12]); CE_(k[11], k[13]); CE_(k[18], k[20]); CE_(k[19], k[22]); CE_(k[25], k[28]); CE_(k[27], k[29]); CE_(k[34], k[36]); CE_(k[35], k[38]); CE_(k[41], k[44]); CE_(k[43], k[45]); CE_(k[50], k[52]); CE_(k[51], k[54]); CE_(k[57], k[60]); CE_(k[59], k[61]); CE_(k[3], k[5]); CE_(k[6], k[8]); CE_(k[7], k[9]); CE_(k[10], k[12]); CE_(k[19], k[21]); CE_(k[22], k[24]); CE_(k[23], k[25]); CE_(k[26], k[28]); CE_(k[35], k[37]); CE_(k[38], k[40]); CE_(k[39], k[41]); CE_(k[42], k[44]); CE_(k[51], k[53]); CE_(k[54], k[56]); CE_(k[55], k[57]); CE_(k[58], k[60]); CE_(k[3], k[4]); CE_(k[5], k[6]); CE_(k[7], k[8]); CE_(k[9], k[10]); CE_(k[11], k[12]); CE_(k[19], k[20]); CE_(k[21], k[22]); CE_(k[23], k[24]); CE_(k[25], k[26]); CE_(k[27], k[28]); CE_(k[35], k[36]); CE_(k[37], k[38]); CE_(k[39], k[40]); CE_(k[41], k[42]); CE_(k[43], k[44]); CE_(k[51], k[52]); CE_(k[53], k[54]); CE_(k[55], k[56]); CE_(k[57], k[58]); CE_(k[59], k[60]); CE_(k[6], k[7]); CE_(k[8], k[9]); CE_(k[22], k[23]); CE_(k[24], k[25]); CE_(k[38], k[39]); CE_(k[40], k[41]); CE_(k[54], k[55]); CE_(k[56], k[57]); k[0] = max(k[0], k[31]); k[1] = max(k[1], k[30]); k[2] = max(k[2], k[29]); k[3] = max(k[3], k[28]); k[4] = max(k[4], k[27]); k[5] = max(k[5], k[26]); k[6] = max(k[6], k[25]); k[7] = max(k[7], k[24]); k[8] = max(k[8], k[23]); k[9] = max(k[9], k[22]); k[10] = max(k[10], k[21]); k[11] = max(k[11], k[20]); k[12] = max(k[12], k[19]); k[13] = max(k[13], k[18]); k[14] = max(k[14], k[17]); k[15] = max(k[15], k[16]); CE_(k[0], k[8]); CE_(k[1], k[9]); CE_(k[2], k[10]); CE_(k[3], k[11]); CE_(k[4], k[12]); CE_(k[5], k[13]); CE_(k[6], k[14]); CE_(k[7], k[15]); CE_(k[0], k[4]); CE_(k[1], k[5]); CE_(k[2], k[6]); CE_(k[3], k[7]); CE_(k[8], k[12]); CE_(k[9], k[13]); CE_(k[10], k[14]); CE_(k[11], k[15]); CE_(k[0], k[2]); CE_(k[1], k[3]); CE_(k[4], k[6]); CE_(k[5], k[7]); CE_(k[8], k[10]); CE_(k[9], k[11]); CE_(k[12], k[14]); CE_(k[13], k[15]); CE_(k[0], k[1]); CE_(k[2], k[3]); CE_(k[4], k[5]); CE_(k[6], k[7]); CE_(k[8], k[9]); CE_(k[10], k[11]); CE_(k[12], k[13]); CE_(k[14], k[15]); k[32] = max(k[32], k[63]); k[33] = max(k[33], k[62]); k[34] = max(k[34], k[61]); k[35] = max(k[35], k[60]); k[36] = max(k[36], k[59]); k[37] = max(k[37], k[58]); k[38] = max(k[38], k[57]); k[39] = max(k[39], k[56]); k[40] = max(k[40], k[55]); k[41] = max(k[41], k[54]); k[42] = max(k[42], k[53]); k[43] = max(k[43], k[52]); k[44] = max(k[44], k[51]); k[45] = max(k[45], k[50]); k[46] = max(k[46], k[49]); k[47] = max(k[47], k[48]); CE_(k[32], k[40]); CE_(k[33], k[41]); CE_(k[34], k[42]); CE_(k[35], k[43]); CE_(k[36], k[44]); CE_(k[37], k[45]); CE_(k[38], k[46]); CE_(k[39], k[47]); CE_(k[32], k[36]); CE_(k[33], k[37]); CE_(k[34], k[38]); CE_(k[35], k[39]); CE_(k[40], k[44]); CE_(k[41], k[45]); CE_(k[42], k[46]); CE_(k[43], k[47]); CE_(k[32], k[34]); CE_(k[33], k[35]); CE_(k[36], k[38]); CE_(k[37], k[39]); CE_(k[40], k[42]); CE_(k[41], k[43]); CE_(k[44], k[46]); CE_(k[45], k[47]); CE_(k[32], k[33]); CE_(k[34], k[35]); CE_(k[36], k[37]); CE_(k[38], k[39]); CE_(k[40], k[41]); CE_(k[42], k[43]); CE_(k[44], k[45]); CE_(k[46], k[47]); k[0] = max(k[0], k[47]); k[1] = max(k[1], k[46]); k[2] = max(k[2], k[45]); k[3] = max(k[3], k[44]); k[4] = max(k[4], k[43]); k[5] = max(k[5], k[42]); k[6] = max(k[6], k[41]); k[7] = max(k[7], k[40]); k[8] = max(k[8], k[39]); k[9] = max(k[9], k[38]); k[10] = max(k[10], k[37]); k[11] = max(k[11], k[36]); k[12] = max(k[12], k[35]); k[13] = max(k[13], k[34]); k[14] = max(k[14], k[33]); k[15] = max(k[15], k[32]); CE_(k[0], k[8]); CE_(k[1], k[9]); CE_(k[2], k[10]); CE_(k[3], k[11]); CE_(k[4], k[12]); CE_(k[5], k[13]); CE_(k[6], k[14]); CE_(k[7], k[15]); CE_(k[0], k[4]); CE_(k[1], k[5]); CE_(k[2], k[6]); CE_(k[3], k[7]); CE_(k[8], k[12]); CE_(k[9], k[13]); CE_(k[10], k[14]); CE_(k[11], k[15]); CE_(k[0], k[2]); CE_(k[1], k[3]); CE_(k[4], k[6]); CE_(k[5], k[7]); CE_(k[8], k[10]); CE_(k[9], k[11]); CE_(k[12], k[14]); CE_(k[13], k[15]); CE_(k[0], k[1]); CE_(k[2], k[3]); CE_(k[4], k[5]); CE_(k[6], k[7]); CE_(k[8], k[9]); CE_(k[10], k[11]); CE_(k[12], k[13]); CE_(k[14], k[15]); } while (0)
#define TOPK_XMERGE(T_) do { u32 pp_[16]; _Pragma("unroll") for (int i_ = 0; i_ < 16; ++i_) pp_[i_] = (u32)__shfl_xor((int)k[i_], 32); T_[0] = max(k[0], pp_[15]); T_[1] = max(k[1], pp_[14]); T_[2] = max(k[2], pp_[13]); T_[3] = max(k[3], pp_[12]); T_[4] = max(k[4], pp_[11]); T_[5] = max(k[5], pp_[10]); T_[6] = max(k[6], pp_[9]); T_[7] = max(k[7], pp_[8]); T_[8] = max(k[8], pp_[7]); T_[9] = max(k[9], pp_[6]); T_[10] = max(k[10], pp_[5]); T_[11] = max(k[11], pp_[4]); T_[12] = max(k[12], pp_[3]); T_[13] = max(k[13], pp_[2]); T_[14] = max(k[14], pp_[1]); T_[15] = max(k[15], pp_[0]); CE_(T_[0], T_[8]); CE_(T_[1], T_[9]); CE_(T_[2], T_[10]); CE_(T_[3], T_[11]); CE_(T_[4], T_[12]); CE_(T_[5], T_[13]); CE_(T_[6], T_[14]); CE_(T_[7], T_[15]); CE_(T_[0], T_[4]); CE_(T_[1], T_[5]); CE_(T_[2], T_[6]); CE_(T_[3], T_[7]); CE_(T_[8], T_[12]); CE_(T_[9], T_[13]); CE_(T_[10], T_[14]); CE_(T_[11], T_[15]); CE_(T_[0], T_[2]); CE_(T_[1], T_[3]); CE_(T_[4], T_[6]); CE_(T_[5], T_[7]); CE_(T_[8], T_[10]); CE_(T_[9], T_[11]); CE_(T_[12], T_[14]); CE_(T_[13], T_[15]); CE_(T_[0], T_[1]); CE_(T_[2], T_[3]); CE_(T_[4], T_[5]); CE_(T_[6], T_[7]); CE_(T_[8], T_[9]); CE_(T_[10], T_[11]); CE_(T_[12], T_[13]); CE_(T_[14], T_[15]); } while (0)
constexpr int SKROW = 272;
__device__ __forceinline__ void peer_topk_unit(int lane, int tok0, int tokn, int head, const bf16_t* __restrict__ QRY, bf16x8_t (&qf)[8], const LAS unsigned char* sk, LAS unsigned char* tl, int* __restrict__ IDX, float* __restrict__ GATE) {
    const int ql = lane & 31, hi = lane >> 5;
    bool bad = false; (void)bad;
    u32 top[2][16];
#pragma unroll
    for (int c = 0; c < 2; ++c) {
        const LAS unsigned char* kp = sk + (c * 128 + ql) * SKROW + 16 * hi;
        f32x16_t sc[4];
#pragma unroll
        for (int kb = 0; kb < 4; ++kb) sc[kb] = (f32x16_t){0.f, 0.f, 0.f, 0.f, 0.f, 0.f, 0.f, 0.f, 0.f, 0.f, 0.f, 0.f, 0.f, 0.f, 0.f, 0.f};
#pragma unroll
        for (int ks = 0; ks < 8; ++ks) {
#pragma unroll
            for (int kb = 0; kb < 4; ++kb) { const bf16x8_t a = *(const LAS bf16x8_t*)(kp + kb * 32 * SKROW + 32 * ks); sc[kb] = MFMA32(a, qf[ks], sc[kb]); }
        }
        {
            const bf16_t* qn = QRY + (size_t)((c == 0 ? tok0 : tokn) + ql) * 2048 + head * 256 + (c == 0 ? 128 : 0) + 8 * hi;
#pragma unroll
            for (int ks = 0; ks < 8; ++ks) qf[ks] = *(const bf16x8_t*)(qn + 16 * ks);
        }
        u32 k[64];
#pragma unroll
        for (int kb = 0; kb < 4; ++kb)
#pragma unroll
            for (int r = 0; r < 16; ++r) k[kb * 16 + r] = (f2ord(sc[kb][r]) & ~127u) | (u32)(127 - (32 * kb + crow(r, hi)));
#ifdef PROBE_TOPK_CHECK
        u32 k2[64];
#pragma unroll
        for (int i = 0; i < 64; ++i) k2[i] = k[i];
        u32 told[16];
#pragma unroll
        for (int rd = 0; rd < 16; ++rd) {
            u32 b = umax3(k2[0], k2[1], k2[2]);
#pragma unroll
            for (int i = 3; i + 1 < 64; i += 2) b = umax3(b, k2[i], k2[i + 1]);
            b = max(b, k2[63]);
            const u32 g = max(b, (u32)__shfl_xor((int)b, 32));
            told[rd] = g;
#pragma unroll
            for (int i = 0; i < 64; ++i) k2[i] = (k2[i] == g) ? 0u : k2[i];
        }
#endif
        TOPK_NET();
        TOPK_XMERGE(top[c]);
#ifdef PROBE_TOPK_CHECK
#pragma unroll
        for (int rd = 0; rd < 16; ++rd) bad |= (told[rd] != top[c][rd]);
#endif
    }
    float va[16], vb[16];
#pragma unroll
    for (int i = 0; i < 16; ++i) { va[i] = ord2f(top[0][i] & ~127u); vb[i] = ord2f(top[1][i] & ~127u); }
    LAS u32* tlr = (LAS u32*)(tl + ql * 144);
    {
        u32 w_[16];
#pragma unroll
        for (int i = 0; i < 16; ++i) w_[i] = hi ? top[1][i] : top[0][i];
#pragma unroll
        for (int q = 0; q < 4; ++q) { u32x4_t t4; t4.x = w_[4 * q]; t4.y = w_[4 * q + 1]; t4.z = w_[4 * q + 2]; t4.w = w_[4 * q + 3]; *(LAS u32x4_t*)(tlr + 16 * hi + 4 * q) = t4; }
    }
    float sv[16]; u32 oe[8];
    {
        u32 k[64];
#pragma unroll
        for (int t = 0; t < 25; ++t) {
            constexpr int CI[50] = {0, 0, 0, 0, 0, 0, 0, 0, 0, 0, 0, 0, 0, 0, 0, 0, 1, 1, 1, 1, 1, 1, 1, 1, 2, 2, 2, 2, 2, 3, 3, 3, 3, 4, 4, 4, 5, 5, 6, 6, 7, 7, 8, 9, 10, 11, 12, 13, 14, 15};
            constexpr int CJ[50] = {0, 1, 2, 3, 4, 5, 6, 7, 8, 9, 10, 11, 12, 13, 14, 15, 0, 1, 2, 3, 4, 5, 6, 7, 0, 1, 2, 3, 4, 0, 1, 2, 3, 0, 1, 2, 0, 1, 0, 1, 0, 1, 0, 0, 0, 0, 0, 0, 0, 0};
            const int i0 = CI[2 * t], j0 = CJ[2 * t], i1 = CI[2 * t + 1], j1 = CJ[2 * t + 1];
            const u32 key0 = (f2ord(va[i0] + vb[j0]) & ~255u) | (u32)(255 - (i0 * 16 + j0)), key1 = (f2ord(va[i1] + vb[j1]) & ~255u) | (u32)(255 - (i1 * 16 + j1));
            k[t] = hi ? key1 : key0;
        }
#pragma unroll
        for (int t = 25; t < 64; ++t) k[t] = 0u;
        TOPK_NET();
        u32 g[16];
        TOPK_XMERGE(g);
#pragma unroll
        for (int rd = 0; rd < 16; ++rd) sv[rd] = ord2f(g[rd] & ~255u);
#pragma unroll
        for (int q = 0; q < 8; ++q) {
            const u32 key = hi ? g[8 + q] : g[q], ci = 255u - (key & 255u);
            const u32 e1 = 127u - (tlr[ci >> 4] & 127u), e2 = 127u - (tlr[16 + (ci & 15u)] & 127u);
            oe[q] = e1 * 128u + e2;
        }
    }
    const float mx = sv[0]; float sum = 0.f;
#pragma unroll
    for (int rd = 0; rd < 16; ++rd) { sv[rd] = __expf(sv[rd] - mx); sum += sv[rd]; }
    const float inv = 1.0f / sum;
    float og[8];
#pragma unroll
    for (int q = 0; q < 8; ++q) og[q] = (hi ? sv[8 + q] : sv[q]) * inv;
    const size_t o = (size_t)(tok0 + ql) * 128 + head * 16 + 8 * hi;
    *(uint4*)(IDX + o) = make_uint4(oe[0], oe[1], oe[2], oe[3]); *(uint4*)(IDX + o + 4) = make_uint4(oe[4], oe[5], oe[6], oe[7]);
#ifdef PROBE_TOPK_CHECK
    if (bad) { og[0] = __builtin_nanf(""); }
#endif
    *(float4*)(GATE + o) = make_float4(og[0], og[1], og[2], og[3]); *(float4*)(GATE + o + 4) = make_float4(og[4], og[5], og[6], og[7]);
}

#define MFMA16(a, b, c) __builtin_amdgcn_mfma_f32_16x16x32_bf16((a), (b), (c), 0, 0, 0)
__device__ __forceinline__ void peer_token(int lane, int tok, const bf16_t* __restrict__ U, const bf16_t* __restrict__ Vt, const int* __restrict__ IDX, const float* __restrict__ GATE,
                                           float* __restrict__ H, bf16_t* __restrict__ HB, const float* __restrict__ rss1, float* __restrict__ rss2, const bool wr = true) {
    const int r = lane & 15, kq = lane >> 4;
    int ev[8];
#pragma unroll
    for (int g = 0; g < 8; ++g) ev[g] = IDX[(size_t)tok * 128 + 16 * g + r];
    const float r1 = rsqrtf(rss1[tok] * (1.f / DM) + 1e-6f);
    const bf16_t* hrow = HB + (size_t)tok * DM + 8 * kq;
    f32x4_t acc[8];
#pragma unroll
    for (int g = 0; g < 8; ++g) acc[g] = (f32x4_t){0.f, 0.f, 0.f, 0.f};
    const char* ub = (const char*)U + 16 * kq;
#pragma unroll 4
    for (int ks = 0; ks < 32; ++ks) {
        const bf16x8_t bfr = *(const bf16x8_t*)(hrow + 32 * ks);
#pragma unroll
        for (int g = 0; g < 8; ++g) { const bf16x8_t a = *(const bf16x8_t*)(ub + (size_t)(unsigned)ev[g] * 2048u + 64 * ks); acc[g] = MFMA16(a, bfr, acc[g]); }
    }
#pragma unroll
    for (int g = 0; g < 8; ++g) {
        const float4 gt = *(const float4*)(GATE + (size_t)tok * 128 + 16 * g + 4 * kq);
        const float gg[4] = {gt.x, gt.y, gt.z, gt.w};
#pragma unroll
        for (int i = 0; i < 4; ++i) { const float z = acc[g][i] * r1; acc[g][i] = 0.5f * z * (1.f + erff(z * 0.70710678118654752f)) * gg[i]; }
    }
    float o[16];
#pragma unroll
    for (int j = 0; j < 16; ++j) o[j] = 0.f;
    const char* vb = (const char*)Vt + 16 * lane;
#pragma unroll
    for (int g = 0; g < 8; ++g) {
#pragma unroll
        for (int rr = 0; rr < 16; rr += 4) {
            u32x4_t w0[4], w1[4]; float ae[4];
#pragma unroll
            for (int q = 0; q < 4; ++q) {
                const int e = __builtin_amdgcn_readlane(ev[g], rr + q);
                ae[q] = __int_as_float(__builtin_amdgcn_readlane(__float_as_int(acc[g][(rr + q) & 3]), 16 * ((rr + q) >> 2)));
                const char* vp = vb + (size_t)(unsigned)e * 2048u;
                w0[q] = *(const u32x4_t*)vp; w1[q] = *(const u32x4_t*)(vp + 1024);
            }
#pragma unroll
            for (int q = 0; q < 4; ++q) {
                const float a = ae[q];
                const u32 ww[8] = {w0[q].x, w0[q].y, w0[q].z, w0[q].w, w1[q].x, w1[q].y, w1[q].z, w1[q].w};
#pragma unroll
                for (int j = 0; j < 8; ++j) { o[2 * j] = fmaf(a, __uint_as_float(ww[j] << 16), o[2 * j]); o[2 * j + 1] = fmaf(a, __uint_as_float(ww[j] & 0xffff0000u), o[2 * j + 1]); }
            }
        }
    }
    float* hp = H + (size_t)tok * DM + 8 * lane;
    float4 h0 = *(float4*)hp, h1 = *(float4*)(hp + 4), h2 = *(float4*)(hp + 512), h3 = *(float4*)(hp + 516);
    h0.x += o[0]; h0.y += o[1]; h0.z += o[2]; h0.w += o[3]; h1.x += o[4]; h1.y += o[5]; h1.z += o[6]; h1.w += o[7];
    h2.x += o[8]; h2.y += o[9]; h2.z += o[10]; h2.w += o[11]; h3.x += o[12]; h3.y += o[13]; h3.z += o[14]; h3.w += o[15];
    if (wr) { *(float4*)hp = h0; *(float4*)(hp + 4) = h1; *(float4*)(hp + 512) = h2; *(float4*)(hp + 516) = h3; }
    const float wa[8] = {h0.x, h0.y, h0.z, h0.w, h1.x, h1.y, h1.z, h1.w}, wb[8] = {h2.x, h2.y, h2.z, h2.w, h3.x, h3.y, h3.z, h3.w};
    bf16_t* hb = HB + (size_t)tok * DM + 8 * lane;
    float s = 0.f;
#pragma unroll
    for (int j = 0; j < 8; ++j) s += wa[j] * wa[j] + wb[j] * wb[j];
    s = wave_sum(s);
    if (wr) { *(uint4*)hb = pack8(wa); *(uint4*)(hb + 512) = pack8(wb); }
    if (lane == 0) { if (wr) rss2[tok] = s; else if (s == 123.456f) rss2[tok] = s; }
}
template <bool I8>
__device__ __forceinline__ void b_rowquant(int row, int lane, const float* __restrict__ src, const float* __restrict__ gain, unsigned char* __restrict__ dst8, float* __restrict__ scale) {
    const float4* sp = (const float4*)(src + (size_t)row * DM + 16 * lane);
    float v[16];
#pragma unroll
    for (int j = 0; j < 4; ++j) { const float4 t = sp[j]; v[4 * j] = t.x; v[4 * j + 1] = t.y; v[4 * j + 2] = t.z; v[4 * j + 3] = t.w; }
    if (gain) {
#pragma unroll
        for (int j = 0; j < 16; ++j) v[j] *= gain[16 * lane + j];
    }
    float am = 0.f;
#pragma unroll
    for (int j = 0; j < 16; ++j) am = fmaxf(am, fabsf(v[j]));
    am = wave_max(am);
    const float sc = am > 0.f ? am * (I8 ? (1.0f / 127.0f) : (1.0f / 440.0f)) : 1.0f, inv = 1.0f / sc;
    int w[4];
#pragma unroll
    for (int j = 0; j < 4; ++j) {
        if (I8) { const int q0 = __float2int_rn(v[4 * j] * inv), q1 = __float2int_rn(v[4 * j + 1] * inv), q2 = __float2int_rn(v[4 * j + 2] * inv), q3 = __float2int_rn(v[4 * j + 3] * inv);
                  w[j] = (q0 & 255) | ((q1 & 255) << 8) | ((q2 & 255) << 16) | (q3 << 24); }
        else { int t = 0; t = __builtin_amdgcn_cvt_pk_fp8_f32(v[4 * j] * inv, v[4 * j + 1] * inv, t, false); t = __builtin_amdgcn_cvt_pk_fp8_f32(v[4 * j + 2] * inv, v[4 * j + 3] * inv, t, true); w[j] = t; }
    }
    *(uint4*)(dst8 + ((size_t)(lane >> 3) * NEXP + row) * 128 + 16 * (lane & 7)) = make_uint4((u32)w[0], (u32)w[1], (u32)w[2], (u32)w[3]);
    if (lane == 0) scale[row] = sc;
}
__device__ __forceinline__ float gelu_as(float v) {
    const float av = fabsf(v), t = __builtin_amdgcn_rcpf(av * 0.2316418882f + 1.0f);
    float q = t * 0.5307027145f + (-0.7265760135f); q = q * t + 0.7107068705f; q = q * t + (-0.142248368f); q = q * t + 0.127414796f; q = q * t;
    const float e = __builtin_amdgcn_exp2f((v * v) * (-0.72134752044f));
    const float m = v * (q * e);
    return v < 0.f ? m : v - m;
}
typedef float f32x2_t __attribute__((ext_vector_type(2)));
#define MFMA8(a, b, c) __builtin_amdgcn_mfma_f32_16x16x32_fp8_fp8((a), (b), (c), 0, 0, 0)
__device__ __forceinline__ void peer_token8(int lane, int tok, LAS unsigned char* wb, const unsigned char* __restrict__ U8, const unsigned char* __restrict__ V8, const float* __restrict__ SU, const float* __restrict__ SV,
                                            const int* __restrict__ IDX, const float* __restrict__ GATE, float* __restrict__ H, bf16_t* __restrict__ HB, const float* __restrict__ rss1, float* __restrict__ rss2) {
    const int r = lane & 15, kq = lane >> 4;
    int ev[8];
#pragma unroll
    for (int g = 0; g < 8; ++g) ev[g] = IDX[(size_t)tok * 128 + 16 * g + r];
    const float r1 = rsqrtf(rss1[tok] * (1.f / DM) + 1e-6f);
    float sh;
    {
        const uint4 a0 = *(const uint4*)(HB + (size_t)tok * DM + 16 * lane), a1 = *(const uint4*)(HB + (size_t)tok * DM + 16 * lane + 8);
        const u32 ww[8] = {a0.x, a0.y, a0.z, a0.w, a1.x, a1.y, a1.z, a1.w};
        float v[16]; float am = 0.f;
#pragma unroll
        for (int j = 0; j < 8; ++j) { v[2 * j] = __uint_as_float(ww[j] << 16); v[2 * j + 1] = __uint_as_float(ww[j] & 0xffff0000u); am = fmaxf(am, fmaxf(fabsf(v[2 * j]), fabsf(v[2 * j + 1]))); }
        am = wave_max(am);
        sh = am > 0.f ? am * (1.0f / 440.0f) : 1.0f;
        const float inv = 1.0f / sh;
        u32x4_t w;
        { int t = 0; t = __builtin_amdgcn_cvt_pk_fp8_f32(v[0] * inv, v[1] * inv, t, false); t = __builtin_amdgcn_cvt_pk_fp8_f32(v[2] * inv, v[3] * inv, t, true); w.x = (u32)t; }
        { int t = 0; t = __builtin_amdgcn_cvt_pk_fp8_f32(v[4] * inv, v[5] * inv, t, false); t = __builtin_amdgcn_cvt_pk_fp8_f32(v[6] * inv, v[7] * inv, t, true); w.y = (u32)t; }
        { int t = 0; t = __builtin_amdgcn_cvt_pk_fp8_f32(v[8] * inv, v[9] * inv, t, false); t = __builtin_amdgcn_cvt_pk_fp8_f32(v[10] * inv, v[11] * inv, t, true); w.z = (u32)t; }
        { int t = 0; t = __builtin_amdgcn_cvt_pk_fp8_f32(v[12] * inv, v[13] * inv, t, false); t = __builtin_amdgcn_cvt_pk_fp8_f32(v[14] * inv, v[15] * inv, t, true); w.w = (u32)t; }
        *(LAS u32x4_t*)(wb + 16 * lane) = w;
    }
    f32x4_t acc[8];
#pragma unroll
    for (int g = 0; g < 8; ++g) acc[g] = (f32x4_t){0.f, 0.f, 0.f, 0.f};
    const unsigned char* ub = U8 + 16 * kq;
#pragma unroll 2
    for (int c = 0; c < 16; ++c) {
        const u32x4_t bq = *(const LAS u32x4_t*)(wb + 64 * c + 16 * kq);
        const long b0 = (long)(((unsigned long long)bq.y << 32) | bq.x), b1 = (long)(((unsigned long long)bq.w << 32) | bq.z);
#pragma unroll
        for (int g = 0; g < 8; ++g) {
            const u32x4_t a = *(const u32x4_t*)(ub + (size_t)(unsigned)ev[g] * 1024u + 64 * c);
            const long a0 = (long)(((unsigned long long)a.y << 32) | a.x), a1 = (long)(((unsigned long long)a.w << 32) | a.z);
            acc[g] = MFMA8(a0, b0, acc[g]); acc[g] = MFMA8(a1, b1, acc[g]);
        }
    }
    const float zs = sh * r1;
#pragma unroll
    for (int g = 0; g < 8; ++g) {
        const float4 gt = *(const float4*)(GATE + (size_t)tok * 128 + 16 * g + 4 * kq);
        const int4 ei = *(const int4*)(IDX + (size_t)tok * 128 + 16 * g + 4 * kq);
        const float gg[4] = {gt.x, gt.y, gt.z, gt.w}; const int ee[4] = {ei.x, ei.y, ei.z, ei.w};
#pragma unroll
        for (int i = 0; i < 4; ++i) { const float z = acc[g][i] * zs * SU[ee[i]]; acc[g][i] = gelu_as(z) * gg[i] * SV[ee[i]]; }
    }
    float o[16];
#pragma unroll
    for (int j = 0; j < 16; ++j) o[j] = 0.f;
    const unsigned char* vb = V8 + 16 * lane;
#pragma unroll
    for (int g = 0; g < 8; ++g) {
#pragma unroll
        for (int rr = 0; rr < 16; rr += 4) {
            u32x4_t w[4]; float ae[4];
#pragma unroll
            for (int q = 0; q < 4; ++q) {
                const int e = __builtin_amdgcn_readlane(ev[g], rr + q);
                ae[q] = __int_as_float(__builtin_amdgcn_readlane(__float_as_int(acc[g][(rr + q) & 3]), 16 * ((rr + q) >> 2)));
                w[q] = *(const u32x4_t*)(vb + (size_t)(unsigned)e * 1024u);
            }
#pragma unroll
            for (int q = 0; q < 4; ++q) {
                const float a = ae[q];
                const u32 ww[4] = {w[q].x, w[q].y, w[q].z, w[q].w};
#pragma unroll
                for (int j = 0; j < 4; ++j) {
                    const f32x2_t lo = __builtin_amdgcn_cvt_pk_f32_fp8((int)ww[j], false), hi2 = __builtin_amdgcn_cvt_pk_f32_fp8((int)ww[j], true);
                    o[4 * j] = fmaf(a, lo[0], o[4 * j]); o[4 * j + 1] = fmaf(a, lo[1], o[4 * j + 1]); o[4 * j + 2] = fmaf(a, hi2[0], o[4 * j + 2]); o[4 * j + 3] = fmaf(a, hi2[1], o[4 * j + 3]);
                }
            }
        }
    }
    float* hp = H + (size_t)tok * DM + 16 * lane;
    float hv[16]; float s = 0.f;
#pragma unroll
    for (int j = 0; j < 4; ++j) { const float4 t = *(const float4*)(hp + 4 * j); hv[4 * j] = t.x + o[4 * j]; hv[4 * j + 1] = t.y + o[4 * j + 1]; hv[4 * j + 2] = t.z + o[4 * j + 2]; hv[4 * j + 3] = t.w + o[4 * j + 3]; }
#pragma unroll
    for (int j = 0; j < 4; ++j) *(float4*)(hp + 4 * j) = make_float4(hv[4 * j], hv[4 * j + 1], hv[4 * j + 2], hv[4 * j + 3]);
#pragma unroll
    for (int j = 0; j < 16; ++j) s += hv[j] * hv[j];
    s = wave_sum(s);
    bf16_t* hb = HB + (size_t)tok * DM + 16 * lane;
    *(uint4*)hb = pack8(hv); *(uint4*)(hb + 8) = pack8(hv + 8);
    if (lane == 0) rss2[tok] = s;
}
constexpr int PL_ZP = 0;
constexpr int PL_EI = 65536;
constexpr int PL_SS = 131072;
__device__ __forceinline__ void b_tokquant(int tok, int lane, const bf16_t* __restrict__ HB, unsigned char* __restrict__ HB8, float* __restrict__ SH) {
    const uint4 a0 = *(const uint4*)(HB + (size_t)tok * DM + 16 * lane), a1 = *(const uint4*)(HB + (size_t)tok * DM + 16 * lane + 8);
    const u32 ww[8] = {a0.x, a0.y, a0.z, a0.w, a1.x, a1.y, a1.z, a1.w};
    float v[16]; float am = 0.f;
#pragma unroll
    for (int j = 0; j < 8; ++j) { v[2 * j] = __uint_as_float(ww[j] << 16); v[2 * j + 1] = __uint_as_float(ww[j] & 0xffff0000u); am = fmaxf(am, fmaxf(fabsf(v[2 * j]), fabsf(v[2 * j + 1]))); }
    am = wave_max(am);
    const float sh = am > 0.f ? am * (1.0f / 440.0f) : 1.0f, inv = 1.0f / sh;
    int w[4];
#pragma unroll
    for (int j = 0; j < 4; ++j) { int t = 0; t = __builtin_amdgcn_cvt_pk_fp8_f32(v[4 * j] * inv, v[4 * j + 1] * inv, t, false); t = __builtin_amdgcn_cvt_pk_fp8_f32(v[4 * j + 2] * inv, v[4 * j + 3] * inv, t, true); w[j] = t; }
    *(uint4*)(HB8 + (size_t)tok * DM + 16 * lane) = make_uint4((u32)w[0], (u32)w[1], (u32)w[2], (u32)w[3]);
    if (lane == 0) SH[tok] = sh;
}
__device__ __forceinline__ void peer_sliced(LAS unsigned char* lds, int lane, int wave, int tok0, const unsigned char* __restrict__ U8, const unsigned char* __restrict__ V8, const float* __restrict__ SU, const float* __restrict__ SV,
                                            const unsigned char* __restrict__ HB8, const float* __restrict__ SH, const int* __restrict__ IDX, const float* __restrict__ GATE,
                                            float* __restrict__ H, bf16_t* __restrict__ HB, const float* __restrict__ rss1, float* __restrict__ rss2) {
    LAS float* zp = (LAS float*)(lds + PL_ZP) + wave * (16 * 128);
    LAS int* ei = (LAS int*)(lds + PL_EI) + wave * (16 * 128);
    LAS float* ssl = (LAS float*)(lds + PL_SS) + wave * 16;
    const int tw = tok0 + 16 * wave;
#pragma unroll
    for (int i = 0; i < 8; ++i) { const int o = i * 256 + 4 * lane; *(LAS u32x4_t*)(ei + o) = *(const u32x4_t*)(IDX + (size_t)tw * 128 + o); }
    if (lane < 16) ssl[lane] = 0.f;
    const int r = lane & 15, kq = lane >> 4;
    {
        int lane_u = lane;
#define UV_LOAD(W_, TG_, EB_) do { \
        _Pragma("unroll") for (int q = 0; q < 2; ++q) { const u32x4_t ev_ = *(const LAS u32x4_t*)(ei + (8 * (TG_) + ju) * 128 + 8 * (EB_) + 4 * q); \
            W_[4 * q] = *(const u32x4_t*)(ub_ + (ev_.x * 128u + (unsigned)(16 * du))); W_[4 * q + 1] = *(const u32x4_t*)(ub_ + (ev_.y * 128u + (unsigned)(16 * du))); \
            W_[4 * q + 2] = *(const u32x4_t*)(ub_ + (ev_.z * 128u + (unsigned)(16 * du))); W_[4 * q + 3] = *(const u32x4_t*)(ub_ + (ev_.w * 128u + (unsigned)(16 * du))); } } while (0)
#define UV_DOT(W_, TG_, EB_) do { int v_[8]; \
        _Pragma("unroll") for (int k = 0; k < 8; ++k) { int d_ = __builtin_amdgcn_sdot4((int)W_[k].x, hq_[0], 0, false); d_ = __builtin_amdgcn_sdot4((int)W_[k].y, hq_[1], d_, false); \
            d_ = __builtin_amdgcn_sdot4((int)W_[k].z, hq_[2], d_, false); v_[k] = __builtin_amdgcn_sdot4((int)W_[k].w, hq_[3], d_, false); }        \
        _Pragma("unroll") for (int k = 0; k < 4; ++k) { const int snd_ = (du & 4) ? v_[k] : v_[k + 4], kp_ = (du & 4) ? v_[k + 4] : v_[k]; v_[k] = kp_ + __shfl_xor(snd_, 4); } \
        _Pragma("unroll") for (int k = 0; k < 2; ++k) { const int snd_ = (du & 2) ? v_[k] : v_[k + 2], kp_ = (du & 2) ? v_[k + 2] : v_[k]; v_[k] = kp_ + __shfl_xor(snd_, 2); } \
        { const int snd_ = (du & 1) ? v_[0] : v_[1], kp_ = (du & 1) ? v_[1] : v_[0]; v_[0] = kp_ + __shfl_xor(snd_, 1); } \
        { LAS float* zq_ = zp + (8 * (TG_) + ju) * 128 + 8 * (EB_) + du; const float f_ = (float)v_[0] * sch_; if (s_ == 0) *zq_ = f_; else *zq_ += f_; } \
        asm volatile("" ::: "memory"); } while (0)
#define UV_TG(TG_) do { int hq_[4]; float sch_; \
            { const bf16_t* hp_ = HB + (size_t)(tw + 8 * (TG_) + ju) * DM + 128 * s_ + 16 * du;        \
              const u32x4_t hq0 = *(const u32x4_t*)hp_, hq1 = *(const u32x4_t*)(hp_ + 8); \
              const u32 hw[8] = {hq0.x, hq0.y, hq0.z, hq0.w, hq1.x, hq1.y, hq1.z, hq1.w}; float hv[16], am_ = 0.f; \
              _Pragma("unroll") for (int q = 0; q < 8; ++q) { hv[2 * q] = __uint_as_float(hw[q] << 16); hv[2 * q + 1] = __uint_as_float(hw[q] & 0xffff0000u); am_ = fmaxf(am_, fmaxf(fabsf(hv[2 * q]), fabsf(hv[2 * q + 1]))); } \
              am_ = fmaxf(am_, __shfl_xor(am_, 1)); am_ = fmaxf(am_, __shfl_xor(am_, 2)); am_ = fmaxf(am_, __shfl_xor(am_, 4));        \
              sch_ = am_ > 0.f ? am_ * (1.0f / 127.0f) : 1.0f; const float inv_ = 1.0f / sch_; \
              _Pragma("unroll") for (int q = 0; q < 4; ++q) { const int q0 = __float2int_rn(hv[4 * q] * inv_), q1 = __float2int_rn(hv[4 * q + 1] * inv_), q2 = __float2int_rn(hv[4 * q + 2] * inv_), q3 = __float2int_rn(hv[4 * q + 3] * inv_); \
                  hq_[q] = (q0 & 255) | ((q1 & 255) << 8) | ((q2 & 255) << 16) | (q3 << 24); } } \
            u32x4_t wA[8], wB[8]; \
            UV_LOAD(wA, TG_, 0); \
            UV_LOAD(wB, TG_, 1);  UV_DOT(wA, TG_, 0);  UV_LOAD(wA, TG_, 2);  UV_DOT(wB, TG_, 1); \
            UV_LOAD(wB, TG_, 3);  UV_DOT(wA, TG_, 2);  UV_LOAD(wA, TG_, 4);  UV_DOT(wB, TG_, 3); \
            UV_LOAD(wB, TG_, 5);  UV_DOT(wA, TG_, 4);  UV_LOAD(wA, TG_, 6);  UV_DOT(wB, TG_, 5); \
            UV_LOAD(wB, TG_, 7);  UV_DOT(wA, TG_, 6);  UV_LOAD(wA, TG_, 8);  UV_DOT(wB, TG_, 7); \
            UV_LOAD(wB, TG_, 9);  UV_DOT(wA, TG_, 8);  UV_LOAD(wA, TG_, 10); UV_DOT(wB, TG_, 9); \
            UV_LOAD(wB, TG_, 11); UV_DOT(wA, TG_, 10); UV_LOAD(wA, TG_, 12); UV_DOT(wB, TG_, 11); \
            UV_LOAD(wB, TG_, 13); UV_DOT(wA, TG_, 12); UV_LOAD(wA, TG_, 14); UV_DOT(wB, TG_, 13); \
            UV_LOAD(wB, TG_, 15); UV_DOT(wA, TG_, 14); UV_DOT(wB, TG_, 15); } while (0)
#pragma unroll 1
        for (int s_ = 0; s_ < 8; ++s_) {
            asm volatile("" : "+v"(lane_u));
            const int ju = lane_u >> 3, du = lane_u & 7;
            const unsigned char* ub_ = U8 + (size_t)s_ * NEXP * 128;
            UV_TG(0);
            UV_TG(1);
        }
#undef UV_TG
#undef UV_LOAD
#undef UV_DOT
    }
#pragma unroll 1
    for (int i0 = 0; i0 < 16; i0 += 4) {
        float su_[8], sv_[8], gt_[8], zs_[4];
#pragma unroll
        for (int q = 0; q < 8; ++q) { const int i = i0 + (q >> 1), k = lane + 64 * (q & 1), e = ei[i * 128 + k]; su_[q] = SU[e]; sv_[q] = SV[e]; gt_[q] = GATE[(size_t)(tw + i) * 128 + k]; }
#pragma unroll
        for (int q = 0; q < 4; ++q) zs_[q] = rsqrtf(rss1[tw + i0 + q] * (1.f / DM) + 1e-6f);
#pragma unroll
        for (int q = 0; q < 8; ++q) { const int i = i0 + (q >> 1), k = lane + 64 * (q & 1);
            const float z = zp[i * 128 + k] * zs_[q >> 1] * su_[q];
            zp[i * 128 + k] = gelu_as(z) * gt_[q] * sv_[q]; }
    }
    const int j = lane >> 3, d = lane & 7;
#define V_LOAD(W_, st_) do { const int eb_ = (st_) & 15, tg_ = ((st_) >> 4) & 1, s_ = (st_) >> 5; const unsigned char* vb_ = V8 + (size_t)s_ * NEXP * 128; \
        _Pragma("unroll") for (int q = 0; q < 2; ++q) { const u32x4_t ev_ = *(const LAS u32x4_t*)(ei + (8 * tg_ + j) * 128 + 8 * eb_ + 4 * q); \
            W_[4 * q] = *(const u32x4_t*)(vb_ + (ev_.x * 128u + (unsigned)(16 * d))); W_[4 * q + 1] = *(const u32x4_t*)(vb_ + (ev_.y * 128u + (unsigned)(16 * d))); \
            W_[4 * q + 2] = *(const u32x4_t*)(vb_ + (ev_.z * 128u + (unsigned)(16 * d))); W_[4 * q + 3] = *(const u32x4_t*)(vb_ + (ev_.w * 128u + (unsigned)(16 * d))); } } while (0)
#define V_FMA(W_, st_) do { const int eb_ = (st_) & 15, tg_ = ((st_) >> 4) & 1; \
        float a_[8]; \
        _Pragma("unroll") for (int q = 0; q < 2; ++q) { const f32x4_t av_ = *(const LAS f32x4_t*)(zp + (8 * tg_ + j) * 128 + 8 * eb_ + 4 * q); a_[4 * q] = av_[0]; a_[4 * q + 1] = av_[1]; a_[4 * q + 2] = av_[2]; a_[4 * q + 3] = av_[3]; } \
        _Pragma("unroll") for (int k = 0; k < 8; ++k) { const u32 ww_[4] = {W_[k].x, W_[k].y, W_[k].z, W_[k].w}; \
            _Pragma("unroll") for (int q = 0; q < 4; ++q) { \
                const f32x2_t lo_ = __builtin_amdgcn_cvt_pk_f32_fp8((int)ww_[q], false), hi_ = __builtin_amdgcn_cvt_pk_f32_fp8((int)ww_[q], true); \
                o_[4 * q] = fmaf(a_[k], lo_[0], o_[4 * q]); o_[4 * q + 1] = fmaf(a_[k], lo_[1], o_[4 * q + 1]); o_[4 * q + 2] = fmaf(a_[k], hi_[0], o_[4 * q + 2]); o_[4 * q + 3] = fmaf(a_[k], hi_[1], o_[4 * q + 3]); } } } while (0)
#define V_HBLD(sg_) do { const int tg_ = (sg_) & 1, s_ = (sg_) >> 1; const bf16_t* hb_ = HB + (size_t)(tw + 8 * tg_ + j) * DM + 128 * s_ + 16 * d; \
        hbA_ = *(const u32x4_t*)hb_; hbB_ = *(const u32x4_t*)(hb_ + 8); } while (0)
#define V_FIN(sg_) do { const int tg_ = (sg_) & 1, s_ = (sg_) >> 1, i_ = 8 * tg_ + j, t_ = tw + i_; \
        bf16_t* hb_ = HB + (size_t)t_ * DM + 128 * s_ + 16 * d; \
        { \
            const u32 gw_[8] = {hbA_.x, hbA_.y, hbA_.z, hbA_.w, hbB_.x, hbB_.y, hbB_.z, hbB_.w};        \
            float hv_[16]; \
            _Pragma("unroll") for (int q = 0; q < 8; ++q) { hv_[2 * q] = __uint_as_float(gw_[q] << 16) + o_[2 * q]; hv_[2 * q + 1] = __uint_as_float(gw_[q] & 0xffff0000u) + o_[2 * q + 1]; } \
            *(uint4*)hb_ = pack8(hv_); *(uint4*)(hb_ + 8) = pack8(hv_ + 8); \
            float ss_ = 0.f; \
            _Pragma("unroll") for (int q = 0; q < 16; ++q) ss_ += hv_[q] * hv_[q]; \
            ss_ += __shfl_xor(ss_, 1); ss_ += __shfl_xor(ss_, 2); ss_ += __shfl_xor(ss_, 4); \
            if (d == 0) ssl[i_] += ss_; } \
        _Pragma("unroll") for (int q = 0; q < 16; ++q) o_[q] = 0.f; } while (0)
    {
        u32x4_t wA[8], wB[8], hbA_, hbB_; float o_[16];
#pragma unroll
        for (int q = 0; q < 16; ++q) o_[q] = 0.f;
        V_LOAD(wA, 0);
#pragma unroll 1
        for (int sg = 0; sg < 16; ++sg) {
            V_HBLD(sg);
#pragma unroll 1
            for (int eb = 0; eb < 16; eb += 2) {
                const int st = sg * 16 + eb;
                V_LOAD(wB, st + 1);
                V_FMA(wA, st);
                V_LOAD(wA, (st + 2 < 256 ? st + 2 : 255));
                V_FMA(wB, st + 1);
            }
            V_FIN(sg);
        }
    }
#undef V_LOAD
#undef V_FMA
#undef V_FIN
#undef V_HBLD
    if (lane < 16) rss2[tw + lane] = ssl[lane];
}
#define XB_TMO      128
#define XB_XCNT(j)  (256  + 64 * (j))
#define XB_XSUB(j)  (1280 + 64 * (j))
#define XB_XGEN(j)  (2304 + 64 * (j))
#define XB_TOP      3328
#define XB_TOPGEN   3392
#define XCD_BAR_WORDS 3456
#define XB_SPIN_CAP (1u << 28)
__device__ __forceinline__ unsigned xb_ld(unsigned* p)              { return __hip_atomic_load(p, __ATOMIC_RELAXED, __HIP_MEMORY_SCOPE_AGENT); }
__device__ __forceinline__ unsigned xb_add(unsigned* p, unsigned v) { return __hip_atomic_fetch_add(p, v, __ATOMIC_RELAXED, __HIP_MEMORY_SCOPE_AGENT); }
__device__ __forceinline__ unsigned xb_xcc_id() { return (unsigned)__builtin_amdgcn_s_getreg((3 << 11) | 20) & 0xFu; }
#define XB_SPIN(cond, bar) do { unsigned _sp = 0; while (cond) { __builtin_amdgcn_s_sleep(1); \
    if ((++_sp & 255u) == 0u) { if (xb_ld(&(bar)[XB_TMO])) break; if (_sp > XB_SPIN_CAP) { atomicAdd(&(bar)[XB_TMO], 1u); break; } } } } while (0)
struct XcdBarrier { unsigned* bar; unsigned x; volatile LAS unsigned* st; };
__device__ __forceinline__ XcdBarrier xcd_barrier_post(unsigned* bar, volatile LAS unsigned* st) {
    XcdBarrier b; b.bar = bar; b.x = xb_xcc_id(); b.st = st;
    if (threadIdx.x == 0) (void)xb_add(&bar[XB_XCNT(b.x)], 1u);
    return b;
}
__device__ __forceinline__ void xcd_barrier_complete(unsigned* bar, unsigned x, unsigned& nloc, unsigned& nx) {
    const unsigned G = gridDim.x * gridDim.y * gridDim.z;
    unsigned sum, cnt, mine, sp = 0u;
    for (;;) {
        sum = 0u; cnt = 0u; mine = 0u;
#pragma unroll
        for (unsigned j = 0; j < 16; ++j) { const unsigned c = xb_ld(&bar[XB_XCNT(j)]); sum += c; cnt += (c > 0u) ? 1u : 0u; mine = (j == x) ? c : mine; }
        if (sum == G) break;
        __builtin_amdgcn_s_sleep(1);
        if ((++sp & 255u) == 0u) { if (xb_ld(&bar[XB_TMO])) break; if (sp > XB_SPIN_CAP) { atomicAdd(&bar[XB_TMO], 1u); break; } }
    }
    nloc = mine > 0u ? mine : 1u; nx = cnt > 0u ? cnt : 1u;
}
__device__ __forceinline__ void xcd_barrier(const XcdBarrier& b) {
    asm volatile("s_waitcnt vmcnt(0)" ::: "memory");
    __syncthreads();
    if (threadIdx.x == 0) {
        unsigned* bar = b.bar;
        __builtin_amdgcn_s_waitcnt(0);
        unsigned nloc = b.st[0], nx = b.st[1];
        if (nloc == 0u) { xcd_barrier_complete(bar, b.x, nloc, nx); b.st[0] = nloc; b.st[1] = nx; }
        const unsigned old = xb_add(&bar[XB_XSUB(b.x)], 1u);
        const unsigned gen = old / nloc;
        if (old + 1u == (gen + 1u) * nloc) {
            __builtin_amdgcn_fence(__ATOMIC_RELEASE, "agent");
            asm volatile("s_waitcnt vmcnt(0)" ::: "memory");
            const unsigned og = xb_add(&bar[XB_TOP], 1u);
            const unsigned tg = og / nx;
            if (og + 1u == (tg + 1u) * nx) xb_add(&bar[XB_TOPGEN], 1u);
            else XB_SPIN(xb_ld(&bar[XB_TOPGEN]) == tg, bar);
            __builtin_amdgcn_fence(__ATOMIC_ACQUIRE, "agent");
            xb_add(&bar[XB_XGEN(b.x)], 1u);
            asm volatile("s_waitcnt vmcnt(0)" ::: "memory");
        } else {
            XB_SPIN(xb_ld(&bar[XB_XGEN(b.x)]) == gen, bar);
            __builtin_amdgcn_fence(__ATOMIC_ACQUIRE, "agent");
            asm volatile("s_waitcnt vmcnt(0)" ::: "memory");
        }
    }
    __syncthreads();
}

constexpr int NTHR = 512;
constexpr int LDS_BYTES = 147456;
constexpr int LDS_MISC = 147456 - 256;
constexpr size_t CTL_BAR_OFF = 65536;
struct Args { const float* in[21]; float* out; unsigned char* ws; };

__global__ void __launch_bounds__(NTHR, 2) mega_fwd(Args a) {
    extern __shared__ __attribute__((aligned(16))) unsigned char lds[];
    const float* x = a.in[0]; const float* p = a.in[1]; const float* attn_norm = a.in[2]; const float* w_in = a.in[3];
    const float* lq1 = a.in[4]; const float* lk1 = a.in[5]; const float* lq2 = a.in[6]; const float* lk2 = a.in[7];
    const float* subln = a.in[8]; const float* w_out = a.in[9]; const float* rel_bias = a.in[10]; const float* ffn_norm = a.in[11];
    const float* peer_query = a.in[12]; const float* peer_subkeys = a.in[13]; const float* peer_u = a.in[14]; const float* peer_v = a.in[15];
    const float* ple_norm = a.in[16]; const float* ple_gate_w = a.in[17]; const float* ple_gate_b = a.in[18]; const float* ple_proj = a.in[19];
    const float* final_norm = a.in[20];
    unsigned char* ws = a.ws;
    float* H = a.out;
    float* ctl = (float*)(ws + WS_CTL); float* rss = (float*)(ws + WS_RSS); float* cs = (float*)(ws + WS_CS);
    float* rss1 = rss, *rss2 = rss + 32768, *rss3 = rss + 65536;
    bf16_t* WIN = (bf16_t*)(ws + WS_WIN); bf16_t* WOUT = (bf16_t*)(ws + WS_WOUT); bf16_t* WQ = (bf16_t*)(ws + WS_WQ); bf16_t* WG = (bf16_t*)(ws + WS_WG); bf16_t* WP = (bf16_t*)(ws + WS_WP);
    bf16_t* SUBK = (bf16_t*)(ws + WS_SUBK); bf16_t* U = (bf16_t*)(ws + WS_U); bf16_t* Vt = (bf16_t*)(ws + WS_V);
    bf16_t* XN = (bf16_t*)(ws + WS_XN); bf16_t* HB = XN; bf16_t* PB = (bf16_t*)(ws + WS_PB);
    bf16_t* Q = (bf16_t*)(ws + WS_Q); bf16_t* Kb = (bf16_t*)(ws + WS_K); bf16_t* VV = (bf16_t*)(ws + WS_VV);
    bf16_t* RQ = (bf16_t*)(ws + WS_RQ); bf16_t* RK = (bf16_t*)(ws + WS_RK); bf16_t* RV = (bf16_t*)(ws + WS_RV); bf16_t* RG = (bf16_t*)(ws + WS_RG);
    bf16_t* QRY = (bf16_t*)(ws + WS_QRY); int* IDX = (int*)(ws + WS_IDX); float* GATE = (float*)(ws + WS_GATE);
    bf16_t* MIX = (bf16_t*)(ws + WS_MIX); bf16_t* PP = MIX;
    float* RAWROT = (float*)(ws + WS_MIX);

    const int G = gridDim.x, bx = blockIdx.x, wave_s = __builtin_amdgcn_readfirstlane(threadIdx.x >> 6), gn = G * NTHR;
#define TIDS() const int lane = lane_id(), wave = wave_s, t512 = wave_s * 64 + lane, half = wave_s >> 2, tid = t512 & 255, gtid = bx * NTHR + t512; (void)gtid; (void)tid; (void)wave; (void)half
#define sm ((char*)lds + half * 65536)
    volatile LAS unsigned* misc = (volatile LAS unsigned*)((LAS unsigned char*)lds + LDS_MISC);
    if (threadIdx.x < 64) misc[threadIdx.x] = 0u;
    __syncthreads();
    XcdBarrier bar = xcd_barrier_post((unsigned*)(ws + WS_CTL + CTL_BAR_OFF), misc + 8);
#define VLOOP(NBLK) for (int base_ = 2 * bx, bid = base_ + half; base_ < (NBLK); base_ += 2 * G, bid = base_ + half)
#define GRID_BAR() xcd_barrier(bar)

#define GEMM_PHASE(EPI, A_, B_, N_, K_, ...) do { int k_ = K_; asm volatile("" : "+s"(k_)); pg8::Gemm g_{A_, B_, M, N_, k_}; pg8::StaticOrder S_; S_.init(M, N_, G, bx); EpiRow8<EPI> E_{EPI{__VA_ARGS__}}; \
        pg8::gemm_phase<EpiRow8<EPI>, pg8::StaticOrder, true, true>((PG8_LAS unsigned char*)lds, g_, S_, E_, wave_s * 64 + lane_id()); } while (0)
    {   TIDS();
    for (int g = gtid; g < 4096 * 32; g += gn) b_tables(g, lq1, lk1, lq2, lk2, rel_bias, ctl, cs);
    {
        LAS float* scr = (LAS float*)((LAS unsigned char*)lds + wave * 16384);
        const int gw = bx * 8 + wave, ngw = G * 8;
        constexpr int I1 = (DM / 64) * (INW / 32), I2 = (DM / 64) * (DM / 32), I3 = (DM / 64) * (2048 / 32), I4 = I2, I5 = (256 / 64) * (DM / 32);
        for (int it = gw; it < I1 + I2 + I3 + I4 + I5; it += ngw) {
            int q = it;
            if (q < I1) { wave_transpose_item<true>(w_in, DM, INW, WIN, nullptr, scr, q, lane); continue; } q -= I1;
            if (q < I2) { wave_transpose_item<false>(w_out, DM, DM, WOUT, nullptr, scr, q, lane); continue; } q -= I2;
            if (q < I3) { wave_transpose_item<false>(peer_query, DM, 2048, WQ, ffn_norm, scr, q, lane); continue; } q -= I3;
            if (q < I4) { wave_transpose_item<false>(ple_gate_w, DM, DM, WG, ple_norm, scr, q, lane); continue; } q -= I4;
            wave_transpose_item<false>(ple_proj, 256, DM, WP, nullptr, scr, q, lane);
        }
    }
    b_convert(gtid, gn, peer_subkeys, SUBK, (size_t)16 * 128 * 128 / 4, nullptr, 1024);
    for (int row = bx * 8 + wave; row < NEXP; row += G * 8) { b_rowquant<true>(row, lane, peer_u, ffn_norm, (unsigned char*)U, (float*)(ws + WS_SU)); b_rowquant<false>(row, lane, peer_v, nullptr, (unsigned char*)Vt, (float*)(ws + WS_SV)); }
    b_convert(gtid, gn, p, PB, (size_t)M * 256 / 4, nullptr, 256);
    for (int row = bx * 8 + wave; row < M; row += G * 8) b_rmsnorm_bf16(row, lane, x, attn_norm, XN, 1e-6f);
    }
    GRID_BAR();
    { int k_ = DM; asm volatile("" : "+s"(k_)); pg8::Gemm g_{XN, WIN, M, INW, k_}; pg8::StaticOrder S_; S_.init(M, INW, G, bx); EpiInProjT E_{ws, cs};
      pg8::gemm_phase<EpiInProjT, pg8::StaticOrder, true, true>((PG8_LAS unsigned char*)lds, g_, S_, E_, wave_s * 64 + lane_id()); }
    GRID_BAR();
    {
        const int vcu = (G & 7) ? bx : (bx & 7) * (G >> 3) + (bx >> 3);
        bf16_t* RKT = (bf16_t*)(ws + WS_RKT); float* KVT = (float*)(ws + WS_KVT); bf16_t* ST = (bf16_t*)(ws + WS_ST);
        { TIDS(); for (int u = vcu; u < BATCH * 4 * 32; u += G) ret_kv_unit(t512, u >> 5, u & 31, RV, RKT, KVT); }
        GRID_BAR();
        { TIDS(); for (int e = gtid; e < BATCH * 4 * 8192; e += gn) ret_scan(e, KVT, ST);
        for (int v = vcu; v < 256; v += G) {
            const int bh = v >> 3, sidx = v & 7;
#pragma unroll 1
            for (int i = 0; i < 4; ++i) {
                const int qb = (i == 0) ? 31 - sidx : (i == 1) ? 16 + sidx : (i == 2) ? 15 - sidx : sidx;
                attn_unit<0>((LAS unsigned char*)lds, t512, bh >> 2, bh & 3, qb, Q, Kb, VV, ctl, subln, MIX);
            }
        }
#ifdef ATT_PROBE
        for (int v = vcu; v < 256; v += G) {
            const int bh = v >> 3, sidx = v & 7;
#pragma unroll 1
            for (int i = 0; i < 4; ++i) {
                const int qb = (i == 0) ? 31 - sidx : (i == 1) ? 16 + sidx : (i == 2) ? 15 - sidx : sidx;
                attn_unit<ATT_PROBE>((LAS unsigned char*)lds, t512, bh >> 2, bh & 3, qb, Q, Kb, VV, ctl, subln, MIX);
            }
        }
#endif
        }
        GRID_BAR();
        { TIDS(); ret_out_units((LAS unsigned char*)lds, t512, vcu, G, BATCH * 4 * 32, RQ, RK, RV, ST, RG, MIX); __syncthreads(); }
    }
    GRID_BAR();
    GEMM_PHASE(EpiOutProj, MIX, WOUT, DM, DM, x, H, HB, rss1);
    GRID_BAR();
    GEMM_PHASE(EpiQry, HB, WQ, 2048, DM, QRY, rss1);
    GRID_BAR();
    {   TIDS();
        const int head = bx & 7, nw = G >> 3, wq = bx >> 3;
        __syncthreads();
        for (int c16 = t512; c16 < 2 * 128 * 16; c16 += NTHR) { const int row = c16 >> 4, ch = c16 & 15;
            *(LAS u32x4_t*)((LAS unsigned char*)lds + row * SKROW + 16 * ch) = *(const u32x4_t*)(SUBK + ((size_t)head * 256 + row) * 128 + 8 * ch); }
        __syncthreads();
        {   bf16x8_t qf[8]; int tb = wq + nw * wave;
            { const bf16_t* q0 = QRY + (size_t)((tb < M / 32 ? tb : 0) * 32 + (lane & 31)) * 2048 + head * 256 + 8 * (lane >> 5);
#pragma unroll
              for (int ks = 0; ks < 8; ++ks) qf[ks] = *(const bf16x8_t*)(q0 + 16 * ks); }
#pragma unroll 1
            for (; tb < M / 32; tb += nw * 8) { const int tn = tb + nw * 8 < M / 32 ? tb + nw * 8 : tb;
                peer_topk_unit(lane, tb * 32, tn * 32, head, QRY, qf, (const LAS unsigned char*)lds, (LAS unsigned char*)lds + 2 * 128 * SKROW + wave * (32 * 144), IDX, GATE); } }
        __syncthreads();
    }
    GRID_BAR();
    {   TIDS(); __syncthreads(); for (int tb = bx; tb < M / 128; tb += G) peer_sliced((LAS unsigned char*)lds, lane, wave, tb * 128, (const unsigned char*)U, (const unsigned char*)Vt, (const float*)(ws + WS_SU), (const float*)(ws + WS_SV), (const unsigned char*)(ws + WS_HB8), (const float*)(ws + WS_SH), IDX, GATE, H, HB, rss1, rss2); __syncthreads(); }
    GRID_BAR();
    GEMM_PHASE(EpiPP, PB, WP, DM, 256, PP);
    asm volatile("s_waitcnt vmcnt(0)" ::: "memory"); __syncthreads();
    GEMM_PHASE(EpiGate, HB, WG, DM, DM, HB, PP, ple_gate_b, rss2, rss3, QRY);
    GRID_BAR();
    {   TIDS(); for (size_t g = gtid; g < (size_t)M * DM / 8; g += gn) b_final(g, QRY, H, rss3, final_norm); }
}

extern "C" void kernel_launch(void* const* d_in, const int* in_sizes, int n_in, void* d_out, int out_size, void* d_ws, size_t ws_size, hipStream_t stream) {
    static int grid = 0;
    if (grid == 0) {
        int dev = 0, cus = 0;
        if (n_in != 21 || out_size != M * DM || ws_size < WS_END) { fprintf(stderr, "kernel_launch: unexpected problem shape (n_in %d out %d ws %zu)\n", n_in, out_size, ws_size); grid = -1; return; }
        if (hipGetDevice(&dev) != hipSuccess || hipDeviceGetAttribute(&cus, hipDeviceAttributeMultiprocessorCount, dev) != hipSuccess) { grid = -1; return; }
        if (hipFuncSetAttribute((const void*)mega_fwd, hipFuncAttributeMaxDynamicSharedMemorySize, LDS_BYTES) != hipSuccess) { fprintf(stderr, "kernel_launch: hipFuncSetAttribute failed\n"); grid = -1; return; }
        int per_cu = 0;
        if (hipOccupancyMaxActiveBlocksPerMultiprocessor(&per_cu, (const void*)mega_fwd, NTHR, LDS_BYTES) != hipSuccess || per_cu < 1) { fprintf(stderr, "kernel_launch: occupancy query says %d\n", per_cu); }
        (void)hipGetLastError();
        grid = cus;
    }
    if (grid < 0) return;
    if (hipMemsetAsync((char*)d_ws, 0, WS_RSS + 3 * 32768 * 4, stream) != hipSuccess) return;
    Args a{};
    for (int i = 0; i < 21; ++i) a.in[i] = (const float*)d_in[i];
    a.out = (float*)d_out; a.ws = (unsigned char*)d_ws;
    hipLaunchKernelGGL(mega_fwd, dim3(grid), dim3(NTHR), LDS_BYTES, stream, a);
}
```
